# Optimizing an MI355X kernel written in HIP

```python
import jax, jax.numpy as jnp
from jax import lax
import numpy as np

D_MODEL = 1024
BATCH = 16
SEQ = 2048
DEPTH = 2

CTX_LEN = 256
GRID_W = 64
RET_DK = 128
RET_DV = 128
RET_HEADS = D_MODEL // RET_DK
RET_CHUNK = 128
NA_DH = 64
NA_HEADS = D_MODEL // NA_DH
NA_KH = 8
NA_KW = 16
LRU_W = D_MODEL
LRU_BLOCKS = 8
LRU_BS = LRU_W // LRU_BLOCKS
LRU_CONV = 4
LRU_C = 8.0
N_EXPERTS = 32
TOP_K = 4
D_EXPERT = D_MODEL
SWIGLU_LIMIT = 7.0
SWIGLU_ALPHA = 1.702
ROPE_BASE = 10000.0
NORM_EPS = 1e-6
N_BRANCH = 3
RET_W = RET_HEADS * RET_DK
RET_VW = RET_HEADS * RET_DV
NA_W = NA_HEADS * NA_DH
IN_SPLITS = (RET_W, RET_W, RET_VW, RET_VW, NA_W, NA_W, NA_W, LRU_W, LRU_W, D_MODEL, D_MODEL, D_MODEL)
IN_W = sum(IN_SPLITS)

kernel_name = "hybrid_retention_natten_rglru_moe_dit"


def _rmsnorm(t, g):
    tf = t.astype(jnp.float32)
    y = tf * lax.rsqrt(jnp.mean(tf * tf, axis=-1, keepdims=True) + NORM_EPS)
    return (y * g.astype(jnp.float32)).astype(t.dtype)


def _modulate(t, g, shift, scale):
    return _rmsnorm(t, g) * (1.0 + scale) + shift


def _split_cols(p):
    return jnp.split(p, np.cumsum(IN_SPLITS)[:-1].tolist(), axis=-1)


def _heads(t, n):
    b, tl, _ = t.shape
    return t.reshape(b, tl, n, -1).transpose(0, 2, 1, 3)


def _merge_heads(t):
    b, n, tl, d = t.shape
    return t.transpose(0, 2, 1, 3).reshape(b, tl, n * d)


def _rope_1d(u, pos):
    nf = u.shape[-1] // 2
    inv = ROPE_BASE ** (-jnp.arange(nf, dtype=jnp.float32) / nf)
    ang = pos.astype(jnp.float32)[:, None] * inv
    cos, sin = jnp.cos(ang).astype(u.dtype), jnp.sin(ang).astype(u.dtype)
    u1, u2 = u[..., :nf], u[..., nf:]
    return jnp.concatenate([u1 * cos - u2 * sin, u1 * sin + u2 * cos], axis=-1)


def _axial_rope(t, rows, cols):
    half = t.shape[-1] // 2
    return jnp.concatenate([_rope_1d(t[..., :half], rows), _rope_1d(t[..., half:], cols)], axis=-1)


def _retention_chunks(q, k, v, log_g, state0, include_diag):
    b, h, tl, dk = q.shape
    dv = v.shape[-1]
    n = tl // RET_CHUNK
    qc = q.reshape(b, h, n, RET_CHUNK, dk)
    kc = k.reshape(b, h, n, RET_CHUNK, dk)
    vc = v.reshape(b, h, n, RET_CHUNK, dv)
    pos = jnp.arange(RET_CHUNK, dtype=jnp.float32)
    diff = pos[:, None] - pos[None, :]
    mask = (diff >= 0) if include_diag else (diff > 0)
    decay = jnp.where(mask[None], jnp.exp(jnp.maximum(diff, 0.0)[None] * log_g[:, None, None]), 0.0)
    s = jnp.einsum('bhnid,bhnjd->bhnij', qc, kc) * decay[:, None]
    intra = jnp.einsum('bhnij,bhnje->bhnie', s, vc)
    zeta = jnp.exp((RET_CHUNK - 1.0 - pos)[None] * log_g[:, None])
    u = jnp.einsum('bhnjd,bhnje->nbhde', kc * zeta[:, None, :, None], vc)
    g_chunk = jnp.exp(RET_CHUNK * log_g)[:, None, None]

    def step(carry, u_n):
        return g_chunk * carry + u_n, carry

    _, s_prev = lax.scan(step, state0, u)
    xi = jnp.exp((pos + 1.0)[None] * log_g[:, None])
    cross = jnp.einsum('bhnid,nbhde->bhnie', qc * xi[:, None, :, None], s_prev)
    return (intra + cross).reshape(b, h, tl, dv)


def _retention_state(k, v, log_g):
    tl = k.shape[2]
    w = jnp.exp((tl - 1.0 - jnp.arange(tl, dtype=jnp.float32))[None] * log_g[:, None])
    return jnp.einsum('bhtd,bhte->bhde', k * w[None, :, :, None], v)


def _retention(qc, kc, vc, ql, kl, vl, logit_f, logit_b, ctx_out):
    lg_f = jax.nn.log_sigmoid(logit_f.astype(jnp.float32))
    lg_b = jax.nn.log_sigmoid(logit_b.astype(jnp.float32))
    fl = lambda t: jnp.flip(t, axis=2)
    s_f = _retention_state(kc, vc, lg_f)
    s_b = _retention_state(fl(kc), fl(vc), lg_b)
    yl = (_retention_chunks(ql, kl, vl, lg_f, s_f, True)
          + fl(_retention_chunks(fl(ql), fl(kl), fl(vl), lg_b, s_b, False)))
    yc = None
    if ctx_out:
        z = jnp.zeros_like(s_f)
        yc = (_retention_chunks(qc, kc, vc, lg_f, z, True)
              + fl(_retention_chunks(fl(qc), fl(kc), fl(vc), lg_b, z, False)))
    return yl, yc


def _head_rms(t):
    return t * lax.rsqrt(jnp.mean(t * t, axis=-1, keepdims=True) + NORM_EPS)


def _neighbourhood_attention(q, k, v, kc, vc, rpb, n_rows):
    b, h, tl, dh = q.shape
    kh, kw = min(NA_KH, n_rows), NA_KW
    grid = lambda t: t.reshape(b, h, n_rows, GRID_W, dh)
    qg, kg, vg = grid(q), grid(k), grid(v)
    cols = jnp.arange(GRID_W)
    col_idx = jnp.clip(cols - kw // 2, 0, GRID_W - kw)[:, None] + jnp.arange(kw)
    dc = col_idx - cols[:, None] + (NA_KW - 1)

    def row_block(r):
        r0 = jnp.clip(r - kh // 2, 0, n_rows - kh)
        kb = lax.dynamic_slice_in_dim(kg, r0, kh, axis=2)[:, :, :, col_idx]
        vb = lax.dynamic_slice_in_dim(vg, r0, kh, axis=2)[:, :, :, col_idx]
        qr = lax.dynamic_index_in_dim(qg, r, axis=2, keepdims=False)
        dr = r0 + jnp.arange(kh) - r + (NA_KH - 1)
        bias = rpb[:, dr[:, None, None], dc[None]].transpose(0, 2, 1, 3)
        s_loc = (jnp.einsum('bhwd,bhrwkd->bhwrk', qr, kb) + bias[None]).reshape(b, h, GRID_W, kh * kw)
        s_ctx = jnp.einsum('bhwd,bhmd->bhwm', qr, kc)
        p = jax.nn.softmax(jnp.concatenate([s_loc, s_ctx], axis=-1).astype(jnp.float32), axis=-1).astype(v.dtype)
        p_loc = p[..., :kh * kw].reshape(b, h, GRID_W, kh, kw)
        return (jnp.einsum('bhwrk,bhrwkd->bhwd', p_loc, vb)
                + jnp.einsum('bhwm,bhmd->bhwd', p[..., kh * kw:], vc))

    o = lax.map(row_block, jnp.arange(n_rows))
    return o.transpose(1, 2, 0, 3, 4).reshape(b, h, tl, dh)


def _ctx_attention(q, k, v):
    s = jnp.einsum('bhqd,bhkd->bhqk', q, k).astype(jnp.float32)
    p = jax.nn.softmax(s, axis=-1).astype(v.dtype)
    return jnp.einsum('bhqk,bhkd->bhqd', p, v)


def _centred_dwconv(t, w, bias):
    out = lax.conv_general_dilated(t, w[:, None, :], window_strides=(1,),
                                   padding=[((LRU_CONV - 1) // 2, LRU_CONV // 2)],
                                   dimension_numbers=('NWC', 'WIO', 'NWC'),
                                   feature_group_count=t.shape[-1])
    return out + bias


def _lin_combine(lhs, rhs):
    a1, b1 = lhs
    a2, b2 = rhs
    return a1 * a2, a2 * b1 + b2


def _rglru_scan(u, wa, ba, wx, bx, lam, h0):
    b, tl, _ = u.shape
    ub = u.reshape(b, tl, LRU_BLOCKS, LRU_BS)
    r = jax.nn.sigmoid(jnp.einsum('btkc,kcd->btkd', ub, wa).reshape(b, tl, LRU_W) + ba)
    i = jax.nn.sigmoid(jnp.einsum('btkc,kcd->btkd', ub, wx).reshape(b, tl, LRU_W) + bx)
    log_a = -LRU_C * r * jax.nn.softplus(-lam)
    a = jnp.exp(log_a)
    bterm = jnp.sqrt(-jnp.expm1(2.0 * log_a)) * (i * u)
    a_cum, h = lax.associative_scan(_lin_combine, (a, bterm), axis=1)
    return h + a_cum * h0[:, None, :]


def _rglru_mixer(xc, xl, conv_w, conv_b, wa, ba, wx, bx, lam, ctx_out):
    f32 = jnp.float32
    uc = _centred_dwconv(xc, conv_w, conv_b).astype(f32)
    ul = _centred_dwconv(xl, conv_w, conv_b).astype(f32)
    wa, ba, wx, bx, lam = (t.astype(f32) for t in (wa, ba, wx, bx, lam))
    fl = lambda t: jnp.flip(t, axis=1)
    z = jnp.zeros((xl.shape[0], LRU_W), f32)
    hc_f = _rglru_scan(uc, wa[0], ba[0], wx[0], bx[0], lam[0], z)
    hc_b = _rglru_scan(fl(uc), wa[1], ba[1], wx[1], bx[1], lam[1], z)
    hl = (_rglru_scan(ul, wa[0], ba[0], wx[0], bx[0], lam[0], hc_f[:, -1])
          + fl(_rglru_scan(fl(ul), wa[1], ba[1], wx[1], bx[1], lam[1], hc_b[:, -1])))
    hc = (hc_f + fl(hc_b)) if ctx_out else None
    return hl, hc


def _moe(t, w_router, b_router, w_up, b_up, w_down, b_down):
    logits = (t @ w_router + b_router).astype(jnp.float32)
    top_v, top_i = lax.top_k(logits, TOP_K)
    top_w = jax.nn.softmax(top_v, axis=-1)
    gates = jnp.einsum('nk,nke->ne', top_w, jax.nn.one_hot(top_i, N_EXPERTS, dtype=jnp.float32)).astype(t.dtype)
    out = jnp.zeros_like(t)
    for e in range(N_EXPERTS):
        hu = t @ w_up[e] + b_up[e]
        glu = jnp.minimum(hu[:, 0::2], SWIGLU_LIMIT)
        lin = jnp.clip(hu[:, 1::2], -SWIGLU_LIMIT, SWIGLU_LIMIT)
        act = glu * jax.nn.sigmoid(SWIGLU_ALPHA * glu) * (lin + 1.0)
        out = out + gates[:, e:e + 1] * (act @ w_down[e] + b_down[e])
    return out


def _layer(x, xc, c, c_ctx, w_mod, b_mod, norm1_g, norm2_g, w_mix_in, ret_decay_fwd, ret_decay_bwd,
           na_rel_bias, lru_conv_w, lru_conv_b, lru_gate_a_w, lru_gate_a_b, lru_gate_x_w, lru_gate_x_b,
           lru_lambda, w_branch, w_mix_out, w_router, b_router, w_expert_up, b_expert_up,
           w_expert_down, b_expert_down, last):
    f32 = jnp.float32
    b, tl, d = x.shape
    n_rows = tl // GRID_W
    tok = jnp.arange(tl)
    rows, cols = tok // GRID_W, tok % GRID_W
    need_ctx = not last

    mod = (jax.nn.silu(c) @ w_mod + b_mod)[:, None, :]
    mod_c = (jax.nn.silu(c_ctx) @ w_mod + b_mod)[None, None, :]
    sh1, sc1, g1, sh2, sc2, g2 = jnp.split(mod, 6, axis=-1)
    sh1c, sc1c, g1c, sh2c, sc2c, g2c = jnp.split(mod_c, 6, axis=-1)

    rq, rk, rv, rg, nq, nk, nv, lx, ly, ga, gb, gc = _split_cols(_modulate(x, norm1_g, sh1, sc1) @ w_mix_in)
    rqc, rkc, rvc, rgc, nqc, nkc, nvc, lxc, lyc, gac, gbc, gcc = _split_cols(
        _modulate(xc, norm1_g, sh1c, sc1c) @ w_mix_in)

    k_scale = RET_DK ** -0.5
    ret_l, ret_c = _retention(
        _heads(rqc, RET_HEADS).astype(f32), (_heads(rkc, RET_HEADS) * k_scale).astype(f32),
        _heads(rvc, RET_HEADS).astype(f32),
        _axial_rope(_heads(rq, RET_HEADS), rows, cols).astype(f32),
        (_axial_rope(_heads(rk, RET_HEADS), rows, cols) * k_scale).astype(f32),
        _heads(rv, RET_HEADS).astype(f32),
        ret_decay_fwd, ret_decay_bwd, need_ctx)

    q_scale = NA_DH ** -0.5
    kc_na, vc_na = _heads(nkc, NA_HEADS), _heads(nvc, NA_HEADS)
    na_l = _neighbourhood_attention(_heads(nq, NA_HEADS) * q_scale, _heads(nk, NA_HEADS), _heads(nv, NA_HEADS),
                                    kc_na, vc_na, na_rel_bias, n_rows)

    lru_l, lru_c = _rglru_mixer(lxc, lx, lru_conv_w, lru_conv_b, lru_gate_a_w, lru_gate_a_b,
                                lru_gate_x_w, lru_gate_x_b, lru_lambda, need_ctx)

    def merge(ret, rgate, na, lru, ygate, gate_a, gate_b, gate_c):
        out_a = (_merge_heads(_head_rms(ret)).astype(rgate.dtype) * jax.nn.silu(rgate)) @ w_branch[0]
        out_b = _merge_heads(na) @ w_branch[1]
        out_c = (lru.astype(ygate.dtype) * jax.nn.gelu(ygate)) @ w_branch[2]
        mixed = (jax.nn.sigmoid(gate_a) * out_a + jax.nn.sigmoid(gate_b) * out_b
                 + jax.nn.sigmoid(gate_c) * out_c)
        return mixed @ w_mix_out

    x = x + g1 * merge(ret_l, rg, na_l, lru_l, ly, ga, gb, gc)
    if need_ctx:
        na_c = _ctx_attention(_heads(nqc, NA_HEADS) * q_scale, kc_na, vc_na)
        xc = xc + g1c * merge(ret_c, rgc, _merge_heads(na_c).reshape(na_c.shape[0], NA_HEADS, -1, NA_DH) if False else na_c,
                              lru_c, lyc, gac, gbc, gcc)

    moe = lambda t: _moe(t, w_router, b_router, w_expert_up, b_expert_up, w_expert_down, b_expert_down)
    h2 = _modulate(x, norm2_g, sh2, sc2)
    if not need_ctx:
        return x + g2 * moe(h2.reshape(b * tl, d)).reshape(b, tl, d), xc
    h2c = _modulate(xc, norm2_g, sh2c, sc2c)
    n_ctx = xc.shape[1]
    y = moe(jnp.concatenate([h2c, h2], axis=1).reshape(-1, d)).reshape(b, n_ctx + tl, d)
    return x + g2 * y[:, n_ctx:], xc + g2c * y[:, :n_ctx]


def setup_inputs(seed: int = 0) -> dict:
    key = jax.random.key(seed)
    ks = jax.random.split(key, 32)
    f32 = jnp.float32
    nrm = lambda k, shape, scale: jax.random.normal(k, shape, f32) * scale
    d = D_MODEL
    ret_init = jnp.log(2.0 ** (5.0 + jnp.arange(RET_HEADS, dtype=f32)) - 1.0)
    u = jax.random.uniform(ks[18], (DEPTH, 2, LRU_W), f32, 0.9, 0.999)
    s = u ** (1.0 / LRU_C)
    return {
        "x": nrm(ks[0], (BATCH, SEQ, d), 1.0),
        "c": nrm(ks[1], (BATCH, d), 1.0),
        "ctx": nrm(ks[2], (BATCH, CTX_LEN, d), 1.0),
        "c_ctx": nrm(ks[3], (d,), 1.0),
        "w_mod": nrm(ks[4], (DEPTH, d, 6 * d), 0.5 * d ** -0.5),
        "b_mod": nrm(ks[5], (DEPTH, 6 * d), 0.02),
        "norm1_g": 1.0 + nrm(ks[6], (DEPTH, d), 0.01),
        "norm2_g": 1.0 + nrm(ks[7], (DEPTH, d), 0.01),
        "w_mix_in": nrm(ks[8], (DEPTH, d, IN_W), d ** -0.5),
        "ret_decay_fwd": ret_init + nrm(ks[9], (DEPTH, RET_HEADS), 0.01),
        "ret_decay_bwd": ret_init + nrm(ks[10], (DEPTH, RET_HEADS), 0.01),
        "na_rel_bias": nrm(ks[11], (DEPTH, NA_HEADS, 2 * NA_KH - 1, 2 * NA_KW - 1), 0.02),
        "lru_conv_w": nrm(ks[12], (DEPTH, LRU_CONV, LRU_W), LRU_CONV ** -0.5),
        "lru_conv_b": nrm(ks[13], (DEPTH, LRU_W), 0.01),
        "lru_gate_a_w": nrm(ks[14], (DEPTH, 2, LRU_BLOCKS, LRU_BS, LRU_BS), LRU_BS ** -0.5),
        "lru_gate_a_b": nrm(ks[15], (DEPTH, 2, LRU_W), 0.01),
        "lru_gate_x_w": nrm(ks[16], (DEPTH, 2, LRU_BLOCKS, LRU_BS, LRU_BS), LRU_BS ** -0.5),
        "lru_gate_x_b": nrm(ks[17], (DEPTH, 2, LRU_W), 0.01),
        "lru_lambda": jnp.log(s) - jnp.log1p(-s),
        "w_branch": nrm(ks[19], (DEPTH, N_BRANCH, d, d), d ** -0.5),
        "w_mix_out": nrm(ks[20], (DEPTH, d, d), d ** -0.5),
        "w_router": nrm(ks[21], (DEPTH, d, N_EXPERTS), d ** -0.5),
        "b_router": nrm(ks[22], (DEPTH, N_EXPERTS), 0.01),
        "w_expert_up": nrm(ks[23], (DEPTH, N_EXPERTS, d, 2 * D_EXPERT), d ** -0.5),
        "b_expert_up": nrm(ks[24], (DEPTH, N_EXPERTS, 2 * D_EXPERT), 0.01),
        "w_expert_down": nrm(ks[25], (DEPTH, N_EXPERTS, D_EXPERT, d), D_EXPERT ** -0.5),
        "b_expert_down": nrm(ks[26], (DEPTH, N_EXPERTS, d), 0.01),
        "final_norm_g": 1.0 + nrm(ks[27], (d,), 0.01),
    }


def reference(x, c, ctx, c_ctx, w_mod, b_mod, norm1_g, norm2_g, w_mix_in, ret_decay_fwd, ret_decay_bwd,
              na_rel_bias, lru_conv_w, lru_conv_b, lru_gate_a_w, lru_gate_a_b, lru_gate_x_w, lru_gate_x_b,
              lru_lambda, w_branch, w_mix_out, w_router, b_router, w_expert_up, b_expert_up,
              w_expert_down, b_expert_down, final_norm_g):
    xc = ctx
    for l in range(DEPTH):
        x, xc = _layer(x, xc, c, c_ctx, w_mod[l], b_mod[l], norm1_g[l], norm2_g[l], w_mix_in[l],
                       ret_decay_fwd[l], ret_decay_bwd[l], na_rel_bias[l], lru_conv_w[l], lru_conv_b[l],
                       lru_gate_a_w[l], lru_gate_a_b[l], lru_gate_x_w[l], lru_gate_x_b[l], lru_lambda[l],
                       w_branch[l], w_mix_out[l], w_router[l], b_router[l], w_expert_up[l], b_expert_up[l],
                       w_expert_down[l], b_expert_down[l], l == DEPTH - 1)
    return _rmsnorm(x, final_norm_g)
```

```cpp
#include <hip/hip_runtime.h>
#include <cstdio>
#include <cstdint>

#define GAS __attribute__((address_space(1)))
#define LAS __attribute__((address_space(3)))
typedef unsigned short bf16;
typedef short bf16x8 __attribute__((ext_vector_type(8)));
typedef float f32x4 __attribute__((ext_vector_type(4)));
typedef float f32x2 __attribute__((ext_vector_type(2)));
typedef unsigned u32x4 __attribute__((ext_vector_type(4)));
typedef unsigned u32x2 __attribute__((ext_vector_type(2)));
typedef GAS unsigned gu32;

constexpr int D = 1024, NB = 16, SEQ = 2048, CTXL = 256, SROW = CTXL + SEQ, NROWS = NB * SROW, DEPTH = 2;
constexpr int INW = 12288, NEXP = 32, DEXP = 1024;
constexpr size_t PSTR = (size_t)NROWS * 1024;
constexpr int MAXSORT = NROWS * 4 + NEXP * 256;
constexpr float NORM_EPS = 1e-6f;
constexpr float LOG2E = 1.4426950408889634f;

constexpr size_t MiB = 1u << 20;
constexpr size_t WS_CTL = 0, CTL_ZERO_BYTES = 1 * MiB;
constexpr size_t WS_MODV = 1 * MiB;
constexpr size_t WS_ROPE = 2 * MiB;
constexpr size_t WS_TOKE = 3 * MiB, WS_TOKP = 4 * MiB, WS_TOKW = 5 * MiB, WS_TOKS = 6 * MiB, WS_ROWW = 7 * MiB;
constexpr size_t WS_WMIX = 8 * MiB;
constexpr size_t WS_WBR = 56 * MiB;
constexpr size_t WS_WOUT = 68 * MiB;
constexpr size_t WS_WUP = 72 * MiB;
constexpr size_t WS_WDN = 328 * MiB;
constexpr size_t WS_X = 456 * MiB;
constexpr size_t WS_H = 600 * MiB;
constexpr size_t WS_P = 672 * MiB;
constexpr size_t WS_AA = 1536 * MiB;
constexpr size_t WS_END = 1752 * MiB;
constexpr size_t WS_M32 = WS_P;
constexpr size_t WS_MB = WS_P + 2 * 72 * MiB;
constexpr size_t WS_ACT = WS_P;
constexpr size_t WS_H2S = WS_P + 5 * 72 * MiB;
static_assert(PSTR * 2 == 72 * MiB && (size_t)MAXSORT * 2048 == 304 * MiB && WS_H2S + 304 * MiB <= WS_AA, "ws map");
constexpr int CW_TMO = 0, CW_BAR = 4096, CW_Q = 8192, CW_CNT = 10240;
constexpr int LDS_BYTES = 147456, LCTL_OFF = 143360;
constexpr int N_PHASES = 20;
#ifndef MK_PER_PHASE
#define MK_PER_PHASE 0
#endif

__device__ __forceinline__ float bflo(unsigned w) { return __uint_as_float(w << 16); }
__device__ __forceinline__ float bfhi(unsigned w) { return __uint_as_float(w & 0xffff0000u); }
__device__ __forceinline__ float bfel(const u32x4& w, int e) { const unsigned x = w[e >> 1]; return (e & 1) ? bfhi(x) : bflo(x); }
__device__ __forceinline__ unsigned f2bf(float f) { unsigned u = __float_as_uint(f); return (u + 0x7fffu + ((u >> 16) & 1u)) >> 16; }
__device__ __forceinline__ unsigned pk2(float lo, float hi) { unsigned r; asm volatile("v_cvt_pk_bf16_f32 %0, %1, %2" : "=v"(r) : "v"(lo), "v"(hi)); return r; }
__device__ __forceinline__ float wave_sum(float v) {
#pragma unroll
    for (int o = 1; o < 64; o <<= 1) v += __shfl_xor(v, o);
    return v;
}
__device__ __forceinline__ float wave_max(float v) {
#pragma unroll
    for (int o = 1; o < 64; o <<= 1) v = fmaxf(v, __shfl_xor(v, o));
    return v;
}
__device__ __forceinline__ float sigmoidf_(float x) { return 1.0f / (1.0f + __expf(-x)); }
__device__ __forceinline__ float gelu_tanh(float y) { const float z = 0.7978845608028654f * (y + 0.044715f * y * y * y); const float t = 1.0f - 2.0f / (__expf(2.0f * z) + 1.0f); return 0.5f * y * (1.0f + t); }
#define LDS_WAIT() asm volatile("s_waitcnt lgkmcnt(0)" ::: "memory")
#define VM_WAIT() asm volatile("s_waitcnt vmcnt(0)" ::: "memory")
#define RLX_AGENT __ATOMIC_RELAXED, __HIP_MEMORY_SCOPE_AGENT
#define MFMA16(a, b, c) __builtin_amdgcn_mfma_f32_16x16x32_bf16((a), (b), (c), 0, 0, 0)
__device__ __forceinline__ int opaque_tid() { int t = threadIdx.x; asm volatile("" : "+v"(t)); return t; }
namespace pg8 {
#define PG8_LAS __attribute__((address_space(3)))
constexpr int BM = 256, BK = 64, HALF = 128, HTB = HALF * BK * 2, STAGE_BYTES = 8 * HTB, NXCD = 8, WGM = 8;
__host__ __device__ __forceinline__ int lds_byte(int r, int c) { const int st = (r >> 4) * 2 + (c >> 5), rr = r & 15, cc = c & 31, ob = rr * 64 + cc * 2; return st * 1024 + (ob ^ (((ob >> 9) & 1) << 5)); }
__host__ __device__ __forceinline__ void stage_rc(int b, int& R, int& C) { const int st = b / 1024, sb = b % 1024, swz = sb ^ (((sb >> 9) & 1) << 5); R = (st >> 1) * 16 + swz / 64; C = (st & 1) * 32 + (swz % 64) / 2; }
__host__ __device__ __forceinline__ int perm32(int rho) { const int n = rho >> 4, i = rho & 15; return 8 * (i >> 2) + 4 * n + (i & 3); }
struct Unit { int pm, pn, aux; };
struct StaticOrder {
    int nM, nN, nwg, G, c;
    __device__ __forceinline__ void init(int nM_, int nN_, int G_, int c_) { nM = nM_; nN = nN_; nwg = nM * nN; G = G_; c = c_; }
    __device__ __forceinline__ bool next(int i, int& pm, int& pn) const {
        const long L = (long)i * G + c; if (L >= nwg) return false;
        int wgid = (int)L; { const int q = nwg / NXCD, r = nwg % NXCD, xcd = wgid % NXCD, off = wgid / NXCD; wgid = (xcd < r ? xcd * (q + 1) : r * (q + 1) + (xcd - r) * q) + off; }
        const int nig = WGM * nN, gid = wgid / nig, fm = gid * WGM, gsz = (nM - fm) < WGM ? (nM - fm) : WGM;
        pm = fm + ((wgid % nig) % gsz); pn = (wgid % nig) / gsz; return true;
    }
};
template <class Epi, class Sched, bool ALIGN_EPI>
__device__ __forceinline__ void gemm_phase(PG8_LAS unsigned char* lds, const int K, const Sched& S, const Epi& E) {
    const int tid = opaque_tid(), wid = __builtin_amdgcn_readfirstlane(tid >> 6), lane = tid & 63, wr = wid >> 2, wc = wid & 3, fr = lane & 15, fq = lane >> 4;
    const int nt = K / BK;
    unsigned voffA[2], voffB[2];
#pragma unroll
    for (int i = 0; i < 2; ++i) { int R, C; stage_rc(tid * 16 + i * 8192, R, C); const int Rb = Epi::PERM ? ((R & ~31) + perm32(R & 31)) : R;
        voffA[i] = (unsigned)(R * K + C) * 2u; voffB[i] = (unsigned)(Rb * K + C) * 2u; }
    const size_t kstep = (size_t)(BK * 2);
    const size_t hstep = (size_t)HALF * K * 2;
    const unsigned ldsw = (unsigned)wid * 1024u;
    const int aoff = lds_byte(wr * 64 + fr, fq * 8), boff = lds_byte(wc * 32 + fr, fq * 8);
#define PG8_SA(b, h) (((b) * 2 + (h)) * HTB)
#define PG8_SB(b, h) ((4 + (b) * 2 + (h)) * HTB)
#define PG8_STAGE(bufoff, gbase, voff) do { _Pragma("unroll") for (int _i = 0; _i < 2; ++_i) \
        __builtin_amdgcn_global_load_lds((const unsigned*)((const char*)(gbase) + (voff)[_i]), (PG8_LAS unsigned*)(lds + (bufoff) + ldsw + _i * 8192), 16, 0, 0); } while (0)
#define PG8_LDA(dst, b, h) do { _Pragma("unroll") for (int m = 0; m < 4; ++m) _Pragma("unroll") for (int k = 0; k < 2; ++k) dst[m][k] = *(const PG8_LAS bf16x8*)(lds + PG8_SA(b, h) + aoff + m * 2048 + k * 1024); } while (0)
#define PG8_LDB(dst, b, h) do { _Pragma("unroll") for (int n = 0; n < 2; ++n) _Pragma("unroll") for (int k = 0; k < 2; ++k) dst[n][k] = *(const PG8_LAS bf16x8*)(lds + PG8_SB(b, h) + boff + n * 2048 + k * 1024); } while (0)
#define PG8_MMA(ai, bj, At, Bt) do { __builtin_amdgcn_s_setprio(1); _Pragma("unroll") for (int m = 0; m < 4; ++m) _Pragma("unroll") for (int n = 0; n < 2; ++n) _Pragma("unroll") for (int k = 0; k < 2; ++k) \
        acc[ai][bj][m][n] = __builtin_amdgcn_mfma_f32_16x16x32_bf16(Bt[n][k], At[m][k], acc[ai][bj][m][n], 0, 0, 0); __builtin_amdgcn_s_setprio(0); } while (0)
#define PG8_WAIT_V(n) asm volatile("s_waitcnt vmcnt(" #n ")" ::: "memory")
#define PG8_WAIT_L(n) asm volatile("s_waitcnt lgkmcnt(" #n ")" ::: "memory")
#define PG8_BAR __builtin_amdgcn_s_barrier()
#define PG8_SCHED __builtin_amdgcn_sched_barrier(0)
    Unit cur, nxt; int ui = 0;
    if (!S.next(0, cur)) return;
    f32x4 acc[2][2][4][2];
#pragma unroll
    for (int a = 0; a < 2; ++a)
#pragma unroll
        for (int b = 0; b < 2; ++b)
#pragma unroll
            for (int m = 0; m < 4; ++m)
#pragma unroll
                for (int n = 0; n < 2; ++n) acc[a][b][m][n] = (f32x4){0.f, 0.f, 0.f, 0.f};
    bf16x8 At[4][2], B0[2][2], B1[2][2];
    const char* cA = S.a_base(cur); const char* cB = S.b_base(cur);
    PG8_STAGE(PG8_SB(0, 0), cB, voffB); PG8_STAGE(PG8_SB(0, 1), cB + hstep, voffB); PG8_STAGE(PG8_SA(0, 0), cA, voffA); PG8_STAGE(PG8_SA(0, 1), cA + hstep, voffA);
    if (wr == 1) PG8_BAR;
    PG8_WAIT_V(2); PG8_BAR;
    PG8_STAGE(PG8_SB(1, 0), cB + kstep, voffB); PG8_STAGE(PG8_SA(1, 0), cA + kstep, voffA); PG8_STAGE(PG8_SB(1, 1), cB + hstep + kstep, voffB);
    PG8_WAIT_V(6); PG8_BAR;
    for (;;) {
        const bool has_next = S.next(ui + 1, nxt);
        const char* nA = has_next ? S.a_base(nxt) : cA; const char* nB = has_next ? S.b_base(nxt) : cB;
        for (int t = 0; t < nt; t += 2) {
            const bool last = (t == nt - 2);
            const char* a1 = cA + (size_t)(t + 1) * kstep;
            const char* a2 = last ? nA : cA + (size_t)(t + 2) * kstep; const char* b2 = last ? nB : cB + (size_t)(t + 2) * kstep;
            const char* a3 = a2 + kstep; const char* b3 = b2 + kstep;
            PG8_LDB(B0, 0, 0); PG8_LDB(B1, 0, 1); PG8_SCHED; PG8_LDA(At, 0, 0); PG8_STAGE(PG8_SA(1, 1), a1 + hstep, voffA);
            PG8_WAIT_V(8); PG8_WAIT_L(0); PG8_BAR; PG8_MMA(0, 0, At, B0); PG8_MMA(0, 1, At, B1); PG8_BAR; PG8_SCHED;
            PG8_LDA(At, 0, 1); PG8_STAGE(PG8_SB(0, 0), b2, voffB); PG8_STAGE(PG8_SB(0, 1), b2 + hstep, voffB); PG8_STAGE(PG8_SA(0, 0), a2, voffA);
            PG8_WAIT_V(8); PG8_WAIT_L(0); PG8_BAR; PG8_MMA(1, 0, At, B0); PG8_MMA(1, 1, At, B1); PG8_BAR; PG8_SCHED;
            PG8_LDB(B0, 1, 0); PG8_LDB(B1, 1, 1); PG8_SCHED; PG8_LDA(At, 1, 0); PG8_STAGE(PG8_SA(0, 1), a2 + hstep, voffA);
            PG8_WAIT_V(8); PG8_WAIT_L(0); PG8_BAR; PG8_MMA(0, 0, At, B0); PG8_MMA(0, 1, At, B1); PG8_BAR; PG8_SCHED;
            PG8_LDA(At, 1, 1); PG8_STAGE(PG8_SB(1, 0), b3, voffB); PG8_STAGE(PG8_SB(1, 1), b3 + hstep, voffB); PG8_STAGE(PG8_SA(1, 0), a3, voffA);
            PG8_WAIT_V(8); PG8_WAIT_L(0); PG8_BAR; PG8_MMA(1, 0, At, B0); PG8_MMA(1, 1, At, B1); PG8_BAR; PG8_SCHED;
        }
        if constexpr (ALIGN_EPI) { if (wr == 0) PG8_BAR; }
        E(acc, cur, wr, wc, fr, fq);
        if (!has_next) break;
#pragma unroll
        for (int a = 0; a < 2; ++a)
#pragma unroll
            for (int b = 0; b < 2; ++b)
#pragma unroll
                for (int m = 0; m < 4; ++m)
#pragma unroll
                    for (int n = 0; n < 2; ++n) acc[a][b][m][n] = (f32x4){0.f, 0.f, 0.f, 0.f};
        cur = nxt; cA = nA; cB = nB; ++ui;
        if constexpr (ALIGN_EPI) { if (wr == 1) PG8_BAR; }
    }
    PG8_WAIT_V(0);
    if constexpr (!ALIGN_EPI) { if (wr == 0) PG8_BAR; }
    PG8_BAR;
#undef PG8_SA
#undef PG8_SB
#undef PG8_STAGE
#undef PG8_LDA
#undef PG8_LDB
#undef PG8_MMA
#undef PG8_WAIT_V
#undef PG8_WAIT_L
#undef PG8_BAR
#undef PG8_SCHED
}
}

struct SchedDense {
    pg8::StaticOrder so; const char* A; const char* B; int K; bool lat;
    __device__ __forceinline__ void init(const void* A_, const void* B_, int K_, int nN, bool lat_, int G, int c) { A = (const char*)A_; B = (const char*)B_; K = K_; lat = lat_; so.init(lat_ ? 128 : 144, nN, G, c); }
    __device__ __forceinline__ bool next(int i, pg8::Unit& u) const { int pm, pn; if (!so.next(i, pm, pn)) return false; if (lat) pm = (pm >> 3) * 9 + 1 + (pm & 7); u.pm = pm; u.pn = pn; u.aux = 0; return true; }
    __device__ __forceinline__ const char* a_base(const pg8::Unit& u) const { return A + (size_t)u.pm * 256 * K * 2; }
    __device__ __forceinline__ const char* b_base(const pg8::Unit& u) const { return B + (size_t)u.pn * 256 * K * 2; }
};
struct SchedBranch {
    pg8::StaticOrder so; const char* A; const char* B; bool lat;
    __device__ __forceinline__ void init(const void* A_, const void* B_, bool lat_, int G, int c) { A = (const char*)A_; B = (const char*)B_; lat = lat_; so.init(lat_ ? 128 : 144, 4, G, c); }
    __device__ __forceinline__ bool next(int i, pg8::Unit& u) const { int pm, pn; const int it = i / 3; if (!so.next(it, pm, pn)) return false; if (lat) pm = (pm >> 3) * 9 + 1 + (pm & 7); u.pm = pm; u.pn = pn; u.aux = i - 3 * it; return true; }
    __device__ __forceinline__ const char* a_base(const pg8::Unit& u) const { return A + (size_t)u.aux * PSTR * 2 + (size_t)u.pm * 256 * 1024 * 2; }
    __device__ __forceinline__ const char* b_base(const pg8::Unit& u) const { return B + (size_t)u.aux * 1024 * 1024 * 2 + (size_t)u.pn * 256 * 1024 * 2; }
};
struct SchedMoE {
    const volatile LAS int* toff; int TT, npn, xcd, j, nwx, G, c; const char* A; const char* B; size_t bexp;
    __device__ __forceinline__ void init(const void* A_, const void* B_, size_t bexp_, const volatile LAS int* toff_, int npn_, int G_, int c_) {
        A = (const char*)A_; B = (const char*)B_; bexp = bexp_; toff = toff_; TT = toff_[NEXP]; npn = npn_; G = G_; c = c_; xcd = c_ & 7; j = c_ >> 3; nwx = G_ >> 3; }
    __device__ __forceinline__ bool next(int i, pg8::Unit& u) const {
        int tm, pn;
        if ((G & 7) == 0) { const int q = i * nwx + j; const int t = q / npn; tm = xcd + 8 * t; pn = q - t * npn; }
        else { const int L = i * G + c; tm = L / npn; pn = L - tm * npn; }
        if (tm >= TT) return false;
        int e = 0;
        while (e < NEXP - 1 && toff[e + 1] <= tm) ++e;
        u.pm = tm; u.pn = pn; u.aux = __builtin_amdgcn_readfirstlane(e); return true;
    }
    __device__ __forceinline__ const char* a_base(const pg8::Unit& u) const { return A + (size_t)u.pm * 256 * 1024 * 2; }
    __device__ __forceinline__ const char* b_base(const pg8::Unit& u) const { return B + (size_t)u.aux * bexp + (size_t)u.pn * 256 * 1024 * 2; }
};

typedef f32x4 AccT[2][2][4][2];
struct EpiProj {
    static constexpr bool PERM = true; bf16* P;
    __device__ __forceinline__ void operator()(const AccT& acc, const pg8::Unit& u, int wr, int wc, int fr, int fq) const {
        const int row0 = u.pm * 256 + wr * 64 + fr; bf16* base = P + (size_t)(u.pn >> 2) * PSTR; const int col0 = (u.pn & 3) * 256 + wc * 32 + 8 * fq;
#pragma unroll
        for (int ai = 0; ai < 2; ++ai)
#pragma unroll
            for (int m = 0; m < 4; ++m) { bf16* rowp = base + (size_t)(row0 + ai * 128 + m * 16) * 1024 + col0;
#pragma unroll
                for (int bj = 0; bj < 2; ++bj) { const f32x4 v0 = acc[ai][bj][m][0], v1 = acc[ai][bj][m][1];
                    u32x4 w; w.x = pk2(v0[0], v0[1]); w.y = pk2(v0[2], v0[3]); w.z = pk2(v1[0], v1[1]); w.w = pk2(v1[2], v1[3]);
                    *(u32x4*)(rowp + bj * 128) = w; } }
    }
};
struct EpiBranch {
    static constexpr bool PERM = false; const bf16* G; float* M32; bf16* MB;
    __device__ __forceinline__ void operator()(const AccT& acc, const pg8::Unit& u, int wr, int wc, int fr, int fq) const {
        const int j = u.aux; const bf16* gate = G + (size_t)j * PSTR;
        const int row0 = u.pm * 256 + wr * 64 + fr, col0 = u.pn * 256 + wc * 32 + 4 * fq;
#pragma unroll
        for (int ai = 0; ai < 2; ++ai)
#pragma unroll
            for (int m = 0; m < 4; ++m) { const size_t ro = (size_t)(row0 + ai * 128 + m * 16) * 1024 + col0;
#pragma unroll
                for (int bj = 0; bj < 2; ++bj)
#pragma unroll
                    for (int n = 0; n < 2; ++n) { const size_t off = ro + bj * 128 + n * 16;
                        const u32x2 gw = *(const u32x2*)(gate + off);
                        f32x4 v = acc[ai][bj][m][n];
                        v[0] *= sigmoidf_(bflo(gw.x)); v[1] *= sigmoidf_(bfhi(gw.x)); v[2] *= sigmoidf_(bflo(gw.y)); v[3] *= sigmoidf_(bfhi(gw.y));
                        if (j == 0) { *(f32x4*)(M32 + off) = v; }
                        else { const f32x4 o = *(const f32x4*)(M32 + off) + v;
                            if (j == 1) *(f32x4*)(M32 + off) = o; else { u32x2 w; w.x = pk2(o[0], o[1]); w.y = pk2(o[2], o[3]); *(u32x2*)(MB + off) = w; } } } }
    }
};
struct EpiOut {
    static constexpr bool PERM = false; const float* xin_x; const float* xin_ctx; float* X; const float* modv_l; bool first;
    __device__ __forceinline__ void operator()(const AccT& acc, const pg8::Unit& u, int wr, int wc, int fr, int fq) const {
        const int b = u.pm / 9, jt = u.pm - 9 * b; const float* g1 = modv_l + (size_t)(jt == 0 ? 16 : b) * 6144 + 2 * 1024;
        const float* src = first ? (jt == 0 ? xin_ctx + (size_t)b * CTXL * 1024 : xin_x + ((size_t)b * SEQ + (size_t)(jt - 1) * 256) * 1024) : X + (size_t)u.pm * 256 * 1024;
        float* dst = X + (size_t)u.pm * 256 * 1024;
        const int lr0 = wr * 64 + fr, col0 = u.pn * 256 + wc * 32 + 4 * fq;
        f32x4 gv[2][2];
#pragma unroll
        for (int bj = 0; bj < 2; ++bj)
#pragma unroll
            for (int n = 0; n < 2; ++n) gv[bj][n] = *(const f32x4*)(g1 + col0 + bj * 128 + n * 16);
#pragma unroll
        for (int ai = 0; ai < 2; ++ai)
#pragma unroll
            for (int m = 0; m < 4; ++m) { const size_t ro = (size_t)(lr0 + ai * 128 + m * 16) * 1024 + col0;
#pragma unroll
                for (int bj = 0; bj < 2; ++bj)
#pragma unroll
                    for (int n = 0; n < 2; ++n) { const size_t off = ro + bj * 128 + n * 16; const f32x4 xo = *(const f32x4*)(src + off); *(f32x4*)(dst + off) = xo + gv[bj][n] * acc[ai][bj][m][n]; } }
    }
};
__device__ __forceinline__ float swiglu_(float gl, float li) { gl = fminf(gl, 7.0f); li = fminf(fmaxf(li, -7.0f), 7.0f); return gl * sigmoidf_(1.702f * gl) * (li + 1.0f); }
struct EpiUp {
    static constexpr bool PERM = true; bf16* ACT; const float* bup;
    __device__ __forceinline__ void operator()(const AccT& acc, const pg8::Unit& u, int wr, int wc, int fr, int fq) const {
        const float* bias = bup + (size_t)u.aux * 2048; const int row0 = u.pm * 256 + wr * 64 + fr, colb = u.pn * 256 + wc * 32 + 8 * fq;
        f32x4 bv[2][2];
#pragma unroll
        for (int bj = 0; bj < 2; ++bj)
#pragma unroll
            for (int n = 0; n < 2; ++n) bv[bj][n] = *(const f32x4*)(bias + colb + bj * 128 + 4 * n);
#pragma unroll
        for (int ai = 0; ai < 2; ++ai)
#pragma unroll
            for (int m = 0; m < 4; ++m) { bf16* rowp = ACT + (size_t)(row0 + ai * 128 + m * 16) * 1024 + (colb >> 1);
#pragma unroll
                for (int bj = 0; bj < 2; ++bj) { const f32x4 v0 = acc[ai][bj][m][0] + bv[bj][0], v1 = acc[ai][bj][m][1] + bv[bj][1];
                    u32x2 w; w.x = pk2(swiglu_(v0[0], v0[1]), swiglu_(v0[2], v0[3])); w.y = pk2(swiglu_(v1[0], v1[1]), swiglu_(v1[2], v1[3]));
                    *(u32x2*)(rowp + bj * 64) = w; } }
    }
};
struct EpiDown {
    static constexpr bool PERM = true; bf16* Y; const float* bdn; const float* roww;
    __device__ __forceinline__ void operator()(const AccT& acc, const pg8::Unit& u, int wr, int wc, int fr, int fq) const {
        const float* bias = bdn + (size_t)u.aux * 1024; const int row0 = u.pm * 256 + wr * 64 + fr, col0 = u.pn * 256 + wc * 32 + 8 * fq;
        f32x4 bv[2][2];
#pragma unroll
        for (int bj = 0; bj < 2; ++bj)
#pragma unroll
            for (int n = 0; n < 2; ++n) bv[bj][n] = *(const f32x4*)(bias + col0 + bj * 128 + 4 * n);
#pragma unroll
        for (int ai = 0; ai < 2; ++ai)
#pragma unroll
            for (int m = 0; m < 4; ++m) { const int row = row0 + ai * 128 + m * 16; const float w8 = roww[row]; bf16* rowp = Y + (size_t)row * 1024 + col0;
#pragma unroll
                for (int bj = 0; bj < 2; ++bj) { const f32x4 v0 = (acc[ai][bj][m][0] + bv[bj][0]) * w8, v1 = (acc[ai][bj][m][1] + bv[bj][1]) * w8;
                    u32x4 w; w.x = pk2(v0[0], v0[1]); w.y = pk2(v0[2], v0[3]); w.z = pk2(v1[0], v1[1]); w.w = pk2(v1[2], v1[3]);
                    *(u32x4*)(rowp + bj * 128) = w; } }
    }
};
#define XB_TMO      128
#define XB_XCNT(j)  (256  + 64 * (j))
#define XB_XSUB(j)  (1280 + 64 * (j))
#define XB_XGEN(j)  (2304 + 64 * (j))
#define XB_TOP      3328
#define XB_TOPGEN   3392
#define XCD_BAR_WORDS 3456
#define XB_SPIN_CAP (1u << 18)
__device__ __forceinline__ unsigned xb_ld(unsigned* p)              { return __hip_atomic_load(p, __ATOMIC_RELAXED, __HIP_MEMORY_SCOPE_AGENT); }
__device__ __forceinline__ unsigned xb_add(unsigned* p, unsigned v) { return __hip_atomic_fetch_add(p, v, __ATOMIC_RELAXED, __HIP_MEMORY_SCOPE_AGENT); }
__device__ __forceinline__ unsigned xb_xcc_id() { return (unsigned)__builtin_amdgcn_s_getreg((3 << 11) | 20) & 0xFu; }
#define XB_SPIN(cond, bar) do { unsigned _sp = 0; while (cond) { __builtin_amdgcn_s_sleep(1); \
    if ((++_sp & 255u) == 0u) { if (xb_ld(&(bar)[XB_TMO])) break; if (_sp > XB_SPIN_CAP) { atomicAdd(&(bar)[XB_TMO], 1u); break; } } } } while (0)
struct XcdBarrier { unsigned* bar; unsigned x; volatile LAS unsigned* st; };
__device__ __forceinline__ XcdBarrier xcd_barrier_post(unsigned* bar, volatile LAS unsigned* st) {
    XcdBarrier b; b.bar = bar; b.x = xb_xcc_id(); b.st = st;
    if (threadIdx.x == 0) (void)xb_add(&bar[XB_XCNT(b.x)], 1u);
    return b;
}
__device__ __forceinline__ void xcd_barrier_complete(unsigned* bar, unsigned x, unsigned& nloc, unsigned& nx) {
    const unsigned G = gridDim.x * gridDim.y * gridDim.z;
    unsigned sum, cnt, mine, sp = 0u;
    for (;;) {
        sum = 0u; cnt = 0u; mine = 0u;
#pragma unroll
        for (unsigned j = 0; j < 16; ++j) { const unsigned c = xb_ld(&bar[XB_XCNT(j)]); sum += c; cnt += (c > 0u) ? 1u : 0u; mine = (j == x) ? c : mine; }
        if (sum == G) break;
        __builtin_amdgcn_s_sleep(1);
        if ((++sp & 255u) == 0u) { if (xb_ld(&bar[XB_TMO])) break; if (sp > XB_SPIN_CAP) { atomicAdd(&bar[XB_TMO], 1u); break; } }
    }
    nloc = mine > 0u ? mine : 1u; nx = cnt > 0u ? cnt : 1u;
}
__device__ __forceinline__ void xcd_barrier(const XcdBarrier& b) {
    asm volatile("s_waitcnt vmcnt(0)" ::: "memory");
    __syncthreads();
    if (threadIdx.x == 0) {
        unsigned* bar = b.bar;
        __builtin_amdgcn_s_waitcnt(0);
        unsigned nloc = b.st[0], nx = b.st[1];
        if (nloc == 0u) { xcd_barrier_complete(bar, b.x, nloc, nx); b.st[0] = nloc; b.st[1] = nx; }
        const unsigned old = xb_add(&bar[XB_XSUB(b.x)], 1u);
        const unsigned gen = old / nloc;
        if (old + 1u == (gen + 1u) * nloc) {
            __builtin_amdgcn_fence(__ATOMIC_RELEASE, "agent");
            asm volatile("s_waitcnt vmcnt(0)" ::: "memory");
            const unsigned og = xb_add(&bar[XB_TOP], 1u);
            const unsigned tg = og / nx;
            if (og + 1u == (tg + 1u) * nx) xb_add(&bar[XB_TOPGEN], 1u);
            else XB_SPIN(xb_ld(&bar[XB_TOPGEN]) == tg, bar);
            __builtin_amdgcn_fence(__ATOMIC_ACQUIRE, "agent");
            xb_add(&bar[XB_XGEN(b.x)], 1u);
            asm volatile("s_waitcnt vmcnt(0)" ::: "memory");
        } else {
            XB_SPIN(xb_ld(&bar[XB_XGEN(b.x)]) == gen, bar);
            __builtin_amdgcn_fence(__ATOMIC_ACQUIRE, "agent");
            asm volatile("s_waitcnt vmcnt(0)" ::: "memory");
        }
    }
    __syncthreads();
}

struct Args {
    const float* in[28]; float* out; unsigned char* ws; int ph_lo, ph_hi;
};
struct Frame {
    LAS unsigned char* lds; volatile LAS unsigned* MISC; unsigned* ctl; unsigned char* ws;
    int vcu, G, c;
    const float* const* in;
};
#define PHASE_IDS() const int tid = opaque_tid(); const int lane = tid & 63; const int wave = __builtin_amdgcn_readfirstlane(tid >> 6); (void)lane; (void)wave
enum { I_X = 0, I_C, I_CTX, I_CCTX, I_WMOD, I_BMOD, I_N1G, I_N2G, I_WMIX, I_RDF, I_RDB, I_RPB, I_CONVW, I_CONVB, I_GAW, I_GAB, I_GXW, I_GXB, I_LAM, I_WBR, I_WOUT, I_WR, I_BR, I_WUP, I_BUP, I_WDN, I_BDN, I_FNG };

__device__ __forceinline__ void p0_transpose_item(const float* W, int N, bf16* WT, LAS float* scr, int item, int lane) {
    const int nblk = N / 32, kb = item / nblk, nb = item - kb * nblk, k0 = 64 * kb, n0 = 32 * nb;
#pragma unroll 8
    for (int i = 0; i < 32; ++i) { const int kk = 2 * i + (lane >> 5); scr[kk * 33 + (lane & 31)] = W[(size_t)(k0 + kk) * N + n0 + (lane & 31)]; }
    LDS_WAIT(); asm volatile("" ::: "memory");
    const int c = lane & 7;
#pragma unroll
    for (int j = 0; j < 4; ++j) { const int n = (lane >> 3) + 8 * j; const LAS float* s = scr + (8 * c) * 33 + n;
        u32x4 o; o.x = pk2(s[0 * 33], s[1 * 33]); o.y = pk2(s[2 * 33], s[3 * 33]); o.z = pk2(s[4 * 33], s[5 * 33]); o.w = pk2(s[6 * 33], s[7 * 33]);
        *(u32x4*)(WT + (size_t)(n0 + n) * 1024 + k0 + 8 * c) = o; }
    LDS_WAIT(); asm volatile("" ::: "memory");
}
__device__ __forceinline__ void p0_prologue(Frame& F) {
    PHASE_IDS();
    {
        float2* rope = (float2*)(F.ws + WS_ROPE);
        const int gt = F.c * 512 + tid;
        if (gt < 96 * 32) { const int pos = gt >> 5, i = gt & 31; const float p = (float)(pos < 32 ? pos : pos - 32); const float inv = powf(10000.0f, -(float)i / 32.0f); const float a = p * inv; rope[gt] = make_float2(cosf(a), sinf(a)); }
    }
    if (F.c < 192) {
        LAS float* sil = (LAS float*)F.lds;
        LAS float* red = (LAS float*)(F.lds + 17 * 1024 * 4);
        for (int i = tid; i < 17 * 1024; i += 512) { const int b = i >> 10, k = i & 1023; const float v = b < 16 ? F.in[I_C][b * 1024 + k] : F.in[I_CCTX][k]; sil[i] = v * sigmoidf_(v); }
        __syncthreads();
        const int l = F.c / 96, cg = F.c - 96 * l; const float* wm = F.in[I_WMOD] + (size_t)l * 1024 * 6144 + 64 * cg + lane;
        float acc[17];
#pragma unroll
        for (int b = 0; b < 17; ++b) acc[b] = 0.f;
        const int kb = wave * 128;
#pragma unroll 4
        for (int kk = 0; kk < 128; ++kk) { const float wv = wm[(size_t)(kb + kk) * 6144];
#pragma unroll
            for (int b = 0; b < 17; ++b) acc[b] += sil[b * 1024 + kb + kk] * wv; }
#pragma unroll
        for (int b = 0; b < 17; ++b) red[(wave * 17 + b) * 64 + lane] = acc[b];
        __syncthreads();
        float* modv = (float*)(F.ws + WS_MODV);
        for (int i = tid; i < 17 * 64; i += 512) { const int b = i >> 6, n = i & 63; float s = 0.f;
#pragma unroll
            for (int w = 0; w < 8; ++w) s += red[(w * 17 + b) * 64 + n];
            const int col = 64 * cg + n; modv[((size_t)l * 17 + b) * 6144 + col] = s + F.in[I_BMOD][l * 6144 + col]; }
        __syncthreads();
    }
    LAS float* scr = (LAS float*)(F.lds + wave * 16384);
    const int gw = F.vcu * 8 + wave, NGW = F.G * 8;
    constexpr int I0 = 2 * 6144, I1 = I0 + 6 * 512, I2 = I1 + 2 * 512, I3 = I2 + 64 * 1024, I4 = I3 + 64 * 512;
    for (int it = gw; it < I4; it += NGW) {
        if (it < I0) { const int mi = it / 6144, r = it - mi * 6144; p0_transpose_item(F.in[I_WMIX] + (size_t)mi * 1024 * 12288, 12288, (bf16*)(F.ws + WS_WMIX) + (size_t)mi * 12288 * 1024, scr, r, lane); }
        else if (it < I1) { const int q = it - I0, mi = q >> 9, r = q & 511; p0_transpose_item(F.in[I_WBR] + (size_t)mi * 1024 * 1024, 1024, (bf16*)(F.ws + WS_WBR) + (size_t)mi * 1024 * 1024, scr, r, lane); }
        else if (it < I2) { const int q = it - I1, mi = q >> 9, r = q & 511; p0_transpose_item(F.in[I_WOUT] + (size_t)mi * 1024 * 1024, 1024, (bf16*)(F.ws + WS_WOUT) + (size_t)mi * 1024 * 1024, scr, r, lane); }
        else if (it < I3) { const int q = it - I2, mi = q >> 10, r = q & 1023; p0_transpose_item(F.in[I_WUP] + (size_t)mi * 1024 * 2048, 2048, (bf16*)(F.ws + WS_WUP) + (size_t)mi * 2048 * 1024, scr, r, lane); }
        else { const int q = it - I3, mi = q >> 9, r = q & 511; p0_transpose_item(F.in[I_WDN] + (size_t)mi * 1024 * 1024, 1024, (bf16*)(F.ws + WS_WDN) + (size_t)mi * 1024 * 1024, scr, r, lane); }
    }
}

__device__ __forceinline__ float row_rstd(const f32x4 (&v)[4]) {
    float s = 0.f;
#pragma unroll
    for (int j = 0; j < 4; ++j) s += (v[j].x * v[j].x + v[j].y * v[j].y) + (v[j].z * v[j].z + v[j].w * v[j].w);
    return rsqrtf(wave_sum(s) * (1.0f / 1024.0f) + NORM_EPS);
}
__device__ __forceinline__ void modulate_row(f32x4 (&v)[4], const float* g, const float* sc, const float* sh, bf16* orow, int lane) {
    const float rstd = row_rstd(v);
#pragma unroll
    for (int j = 0; j < 4; ++j) { const int col = 4 * lane + 256 * j;
        const f32x4 g4 = *(const f32x4*)(g + col), s4 = *(const f32x4*)(sc + col), h4 = *(const f32x4*)(sh + col);
        v[j] = v[j] * rstd * g4 * (s4 + 1.0f) + h4;
        u32x2 w; w.x = pk2(v[j].x, v[j].y); w.y = pk2(v[j].z, v[j].w); *(u32x2*)(orow + col) = w; }
}
__device__ __forceinline__ const float* in_row(const float* x, const float* ctx, int r) { const int b = r / SROW, s = r - b * SROW; return s < CTXL ? ctx + ((size_t)b * CTXL + s) * D : x + ((size_t)b * SEQ + (s - CTXL)) * D; }
__device__ __forceinline__ void p1_norm1(Frame& F) {
    PHASE_IDS();
    const int gw = F.vcu * 8 + wave, NGW = F.G * 8;
    const float* modv = (const float*)(F.ws + WS_MODV); bf16* H = (bf16*)(F.ws + WS_H);
    for (int r = gw; r < NROWS; r += NGW) {
        const int b = r / SROW, s = r - b * SROW; const float* xr = in_row(F.in[I_X], F.in[I_CTX], r); const float* mv = modv + (size_t)(s < CTXL ? 16 : b) * 6144;
        f32x4 v[4];
#pragma unroll
        for (int j = 0; j < 4; ++j) v[j] = *(const f32x4*)(xr + 4 * lane + 256 * j);
        modulate_row(v, F.in[I_N1G], mv + 1024, mv, H + (size_t)r * 1024, lane);
    }
}
constexpr int WR_STRIDE = 1028;
constexpr int L6_WR = 0, L6_LCNT = 32 * WR_STRIDE * 4, L6_LBASE = L6_LCNT + 128, L6_TAB = L6_LBASE + 128, L6_MAXROWS = 160;
static_assert(L6_TAB + L6_MAXROWS * 48 <= LCTL_OFF, "router LDS");
__device__ __forceinline__ void p6_router(Frame& F, int l, bool lat) {
    PHASE_IDS();
    LAS float* WR = (LAS float*)(F.lds + L6_WR);
    volatile LAS int* LCNT = (volatile LAS int*)(F.lds + L6_LCNT); volatile LAS int* LBASE = (volatile LAS int*)(F.lds + L6_LBASE);
    LAS int* TAB = (LAS int*)(F.lds + L6_TAB);
    const float* wr = F.in[I_WR] + (size_t)l * 1024 * 32;
    for (int idx = tid; idx < 32768; idx += 512) { const int d = idx >> 5, e = idx & 31; WR[e * WR_STRIDE + d] = wr[idx]; }
    if (tid < 32) LCNT[tid] = 0;
    __syncthreads();
    const int RPW = (NROWS + F.G - 1) / F.G; const int rbeg = F.c * RPW; int nloc = NROWS - rbeg; nloc = nloc < 0 ? 0 : (nloc > RPW ? RPW : nloc);
    const float* modv = (const float*)(F.ws + WS_MODV) + (size_t)l * 17 * 6144; float* X = (float*)(F.ws + WS_X); bf16* H = (bf16*)(F.ws + WS_H);
    const float* n2g = F.in[I_N2G] + l * 1024; const float* brt = F.in[I_BR] + l * 32;
    const int el = (lane >> 1) & 31;
    for (int lr = wave; lr < nloc; lr += 8) {
        const int r = rbeg + lr; const int b = r / SROW, s = r - b * SROW;
        if (lat && s < CTXL) { if (lane < 4) TAB[(lr * 4 + lane) * 3] = -1; continue; }
        const float* mv = modv + (size_t)(s < CTXL ? 16 : b) * 6144;
        f32x4 v[4];
#pragma unroll
        for (int j = 0; j < 4; ++j) v[j] = *(const f32x4*)(X + (size_t)r * 1024 + 4 * lane + 256 * j);
        modulate_row(v, n2g, mv + 4 * 1024, mv + 3 * 1024, H + (size_t)r * 1024, lane);
        float p[32];
#pragma unroll
        for (int e = 0; e < 32; ++e) { float a = 0.f;
#pragma unroll
            for (int j = 0; j < 4; ++j) { const f32x4 w4 = *(const LAS f32x4*)(WR + e * WR_STRIDE + 256 * j + 4 * lane); a += (v[j].x * w4.x + v[j].y * w4.y) + (v[j].z * w4.z + v[j].w * w4.w); }
            p[e] = a; }
        float q16[16], q8[8], q4[4], q2[2], q1;
        { const bool hi = (lane & 32) != 0;
#pragma unroll
          for (int e = 0; e < 16; ++e) { const float keep = hi ? p[e + 16] : p[e], send = hi ? p[e] : p[e + 16]; q16[e] = keep + __shfl_xor(send, 32); } }
        { const bool hi = (lane & 16) != 0;
#pragma unroll
          for (int e = 0; e < 8; ++e) { const float keep = hi ? q16[e + 8] : q16[e], send = hi ? q16[e] : q16[e + 8]; q8[e] = keep + __shfl_xor(send, 16); } }
        { const bool hi = (lane & 8) != 0;
#pragma unroll
          for (int e = 0; e < 4; ++e) { const float keep = hi ? q8[e + 4] : q8[e], send = hi ? q8[e] : q8[e + 4]; q4[e] = keep + __shfl_xor(send, 8); } }
        { const bool hi = (lane & 4) != 0;
#pragma unroll
          for (int e = 0; e < 2; ++e) { const float keep = hi ? q4[e + 2] : q4[e], send = hi ? q4[e] : q4[e + 2]; q2[e] = keep + __shfl_xor(send, 4); } }
        { const bool hi = (lane & 2) != 0; const float keep = hi ? q2[1] : q2[0], send = hi ? q2[0] : q2[1]; q1 = keep + __shfl_xor(send, 2); }
        float val = q1 + __shfl_xor(q1, 1) + brt[el];
        int te[4]; float tv[4];
#pragma unroll
        for (int k = 0; k < 4; ++k) { const float m = wave_max(val); const unsigned long long mask = __ballot(val == m); const int fl = mask ? (int)__builtin_ctzll(mask) : 0;
            te[k] = (fl >> 1) & 31; tv[k] = m; if (el == te[k]) val = -INFINITY; }
        const float e1 = __expf(tv[1] - tv[0]), e2 = __expf(tv[2] - tv[0]), e3 = __expf(tv[3] - tv[0]); const float inv = 1.0f / (1.0f + e1 + e2 + e3);
        if (lane < 4) { const int ek = lane == 0 ? te[0] : lane == 1 ? te[1] : lane == 2 ? te[2] : te[3]; const float wk = (lane == 0 ? 1.0f : lane == 1 ? e1 : lane == 2 ? e2 : e3) * inv;
            const int pos = atomicAdd((int*)(LCNT + ek), 1);
            LAS int* t = TAB + (lr * 4 + lane) * 3; t[0] = ek; t[1] = pos; t[2] = __float_as_int(wk); }
    }
    __syncthreads();
    unsigned* cnt = F.ctl + CW_CNT + l * 64;
    if (tid < 32) LBASE[tid] = (int)atomicAdd(cnt + tid, (unsigned)LCNT[tid]);
    __syncthreads();
    int* toke = (int*)(F.ws + WS_TOKE); int* tokp = (int*)(F.ws + WS_TOKP); float* tokw = (float*)(F.ws + WS_TOKW);
    for (int idx = tid; idx < nloc * 4; idx += 512) { const LAS int* t = TAB + idx * 3; const int e = t[0]; const size_t o = (size_t)rbeg * 4 + idx;
        toke[o] = e; if (e >= 0) { tokp[o] = LBASE[e] + t[1]; tokw[o] = __int_as_float(t[2]); } }
    __syncthreads();
}
__device__ __forceinline__ void moe_toff(Frame& F, int l, volatile LAS int* toff) {
    PHASE_IDS();
    if (tid == 0) { unsigned* cnt = F.ctl + CW_CNT + l * 64; int a = 0;
        for (int e = 0; e < NEXP; ++e) { toff[e] = a; const int c = (int)__hip_atomic_load(cnt + e, RLX_AGENT); a += (c + 255) >> 8; }
        toff[NEXP] = a; }
    __syncthreads();
}
__device__ __forceinline__ void p6b_scatter(Frame& F, int l, bool lat) {
    PHASE_IDS();
    volatile LAS int* toff = (volatile LAS int*)(F.lds + LCTL_OFF + 256);
    moe_toff(F, l, toff);
    const int gw = F.vcu * 8 + wave, NGW = F.G * 8;
    const int* toke = (const int*)(F.ws + WS_TOKE); const int* tokp = (const int*)(F.ws + WS_TOKP); const float* tokw = (const float*)(F.ws + WS_TOKW);
    int* toks = (int*)(F.ws + WS_TOKS); float* roww = (float*)(F.ws + WS_ROWW);
    const bf16* H = (const bf16*)(F.ws + WS_H); bf16* H2S = (bf16*)(F.ws + WS_H2S);
    for (int r = gw; r < NROWS; r += NGW) {
        const int s = r % SROW; if (lat && s < CTXL) continue;
        const u32x4 h0 = *(const u32x4*)(H + (size_t)r * 1024 + 8 * lane), h1 = *(const u32x4*)(H + (size_t)r * 1024 + 512 + 8 * lane);
#pragma unroll
        for (int k = 0; k < 4; ++k) { const int e = toke[(size_t)r * 4 + k], pos = tokp[(size_t)r * 4 + k]; const int slot = toff[e] * 256 + pos;
            *(u32x4*)(H2S + (size_t)slot * 1024 + 8 * lane) = h0; *(u32x4*)(H2S + (size_t)slot * 1024 + 512 + 8 * lane) = h1;
            if (lane == 0) { roww[slot] = tokw[(size_t)r * 4 + k]; toks[(size_t)r * 4 + k] = slot; } }
    }
}
__device__ __forceinline__ void p9_combine(Frame& F, int l, bool last, float* out) {
    PHASE_IDS();
    const int gw = F.vcu * 8 + wave, NGW = F.G * 8;
    const int* toks = (const int*)(F.ws + WS_TOKS); const bf16* Y = (const bf16*)(F.ws + WS_H2S);
    float* X = (float*)(F.ws + WS_X); bf16* H = (bf16*)(F.ws + WS_H);
    const float* modv = (const float*)(F.ws + WS_MODV) + (size_t)l * 17 * 6144;
    for (int r = gw; r < NROWS; r += NGW) {
        const int b = r / SROW, s = r - b * SROW; if (last && s < CTXL) continue;
        const int mb = s < CTXL ? 16 : b; const float* g2 = modv + (size_t)mb * 6144 + 5 * 1024;
        f32x4 v[4], ys[4];
#pragma unroll
        for (int j = 0; j < 4; ++j) { v[j] = *(const f32x4*)(X + (size_t)r * 1024 + 4 * lane + 256 * j); ys[j] = (f32x4){0.f, 0.f, 0.f, 0.f}; }
#pragma unroll
        for (int k = 0; k < 4; ++k) { const int slot = toks[(size_t)r * 4 + k];
#pragma unroll
            for (int j = 0; j < 4; ++j) { const u32x2 w = *(const u32x2*)(Y + (size_t)slot * 1024 + 4 * lane + 256 * j); ys[j].x += bflo(w.x); ys[j].y += bfhi(w.x); ys[j].z += bflo(w.y); ys[j].w += bfhi(w.y); } }
#pragma unroll
        for (int j = 0; j < 4; ++j) v[j] = v[j] + *(const f32x4*)(g2 + 4 * lane + 256 * j) * ys[j];
        if (!last) {
#pragma unroll
            for (int j = 0; j < 4; ++j) *(f32x4*)(X + (size_t)r * 1024 + 4 * lane + 256 * j) = v[j];
            const float* mv = (const float*)(F.ws + WS_MODV) + ((size_t)(l + 1) * 17 + mb) * 6144;
            modulate_row(v, F.in[I_N1G] + (l + 1) * 1024, mv + 1024, mv, H + (size_t)r * 1024, lane);
        } else {
            const float rstd = row_rstd(v); float* orow = out + ((size_t)b * SEQ + (s - CTXL)) * 1024;
#pragma unroll
            for (int j = 0; j < 4; ++j) { const int col = 4 * lane + 256 * j; *(f32x4*)(orow + col) = v[j] * rstd * *(const f32x4*)(F.in[I_FNG] + col); }
        }
    }
}
__device__ __forceinline__ void chunk_of(int pass, int step, bool& isctx, int& cidx) { isctx = step < 4; cidx = pass == 0 ? (isctx ? step : step - 4) : (isctx ? 3 - step : 35 - step); }

constexpr int RS_Q = 272, RS_T = 144;
constexpr int LR_QS = 0, LR_KS = LR_QS + 64 * RS_Q, LR_KT = LR_KS + 64 * RS_Q, LR_VT = LR_KT + 128 * RS_T, LR_ST = LR_VT + 128 * RS_T, LR_SC = LR_ST + 128 * RS_Q, LR_END = LR_SC + 64 * RS_T;
static_assert(LR_END <= LCTL_OFF, "retention LDS");
__device__ __forceinline__ void ret_unit(Frame& F, int l, int b, int h, bool need_ctx) {
    LAS unsigned char* Qs = F.lds + LR_QS; LAS unsigned char* Ks = F.lds + LR_KS; LAS unsigned char* KT = F.lds + LR_KT; LAS unsigned char* VT = F.lds + LR_VT;
    LAS unsigned char* ST = F.lds + LR_ST; LAS unsigned char* Sc = F.lds + LR_SC; LAS unsigned char* Ys = Ks;
    const bf16* Pq = (const bf16*)(F.ws + WS_P) + 0 * PSTR + h * 128; const bf16* Pk = (const bf16*)(F.ws + WS_P) + 1 * PSTR + h * 128;
    const bf16* Pv = (const bf16*)(F.ws + WS_P) + 2 * PSTR + h * 128; const bf16* Pg = (const bf16*)(F.ws + WS_P) + 3 * PSTR + h * 128;
    bf16* AA = (bf16*)(F.ws + WS_AA) + h * 128;
    const float2* ropeR = (const float2*)(F.ws + WS_ROPE); const float2* ropeC = ropeR + 32 * 32;
    const float xf = F.in[I_RDF][l * 8 + h], xb = F.in[I_RDB][l * 8 + h];
    const float lf2 = -log1pf(expf(-xf)) * LOG2E, lb2 = -log1pf(expf(-xb)) * LOG2E;
    PHASE_IDS(); const int w = wave, fr = lane & 15, g = lane >> 4;
    const int rowb = b * SROW;
    for (int pass = 0; pass < 2; ++pass) {
        const float lg2 = pass ? lb2 : lf2; const float gC = exp2f(64.0f * lg2);
        f32x4 Sacc[8];
#pragma unroll
        for (int nd = 0; nd < 8; ++nd) Sacc[nd] = (f32x4){0.f, 0.f, 0.f, 0.f};
        __syncthreads();
        for (int i = tid; i < 128 * RS_Q / 4; i += 512) ((LAS unsigned*)ST)[i] = 0u;
        for (int step = 0; step < 36; ++step) {
            bool isctx; int cidx; chunk_of(pass, step, isctx, cidx);
            const int row0 = rowb + (isctx ? 64 * cidx : CTXL + 64 * cidx);
            const bool do_out = !isctx || need_ctx;
            {
                const int p = tid >> 3, sub = tid & 7, hf = sub >> 2, ig = sub & 3, d0 = 64 * hf + 8 * ig;
                const size_t ro = (size_t)(row0 + p) * 1024 + d0;
                const u32x4 ka = *(const u32x4*)(Pk + ro), kb = *(const u32x4*)(Pk + ro + 32);
                u32x4 qa = (u32x4){0u, 0u, 0u, 0u}, qb = qa;
                if (do_out) { qa = *(const u32x4*)(Pq + ro); qb = *(const u32x4*)(Pq + ro + 32); }
                float cs[8], sn[8];
                if (!isctx) { const float2* tab = (hf ? ropeC + p * 32 : ropeR + cidx * 32) + 8 * ig;
#pragma unroll
                    for (int e = 0; e < 8; ++e) { const float2 t = tab[e]; cs[e] = t.x; sn[e] = t.y; } }
                else {
#pragma unroll
                    for (int e = 0; e < 8; ++e) { cs[e] = 1.f; sn[e] = 0.f; } }
                float q1[8], q2[8], k1[8], k2[8];
#pragma unroll
                for (int e = 0; e < 8; ++e) { const float a = bfel(qa, e), c = bfel(qb, e); q1[e] = a * cs[e] - c * sn[e]; q2[e] = a * sn[e] + c * cs[e];
                    const float ak = bfel(ka, e), ck = bfel(kb, e); k1[e] = (ak * cs[e] - ck * sn[e]) * 0.08838834764831845f; k2[e] = (ak * sn[e] + ck * cs[e]) * 0.08838834764831845f; }
                if (do_out) {
                    u32x4 w1, w2;
                    w1.x = pk2(q1[0], q1[1]); w1.y = pk2(q1[2], q1[3]); w1.z = pk2(q1[4], q1[5]); w1.w = pk2(q1[6], q1[7]);
                    w2.x = pk2(q2[0], q2[1]); w2.y = pk2(q2[2], q2[3]); w2.z = pk2(q2[4], q2[5]); w2.w = pk2(q2[6], q2[7]);
                    *(LAS u32x4*)(Qs + p * RS_Q + d0 * 2) = w1; *(LAS u32x4*)(Qs + p * RS_Q + (d0 + 32) * 2) = w2;
                }
                u32x4 x1, x2;
                x1.x = pk2(k1[0], k1[1]); x1.y = pk2(k1[2], k1[3]); x1.z = pk2(k1[4], k1[5]); x1.w = pk2(k1[6], k1[7]);
                x2.x = pk2(k2[0], k2[1]); x2.y = pk2(k2[2], k2[3]); x2.z = pk2(k2[4], k2[5]); x2.w = pk2(k2[6], k2[7]);
                if (pass == 0 && do_out) { *(LAS u32x4*)(Ks + p * RS_Q + d0 * 2) = x1; *(LAS u32x4*)(Ks + p * RS_Q + (d0 + 32) * 2) = x2; }
#pragma unroll
                for (int e = 0; e < 8; ++e) { const unsigned a = x1[e >> 1], c = x2[e >> 1];
                    *(LAS unsigned short*)(KT + (d0 + e) * RS_T + p * 2) = (unsigned short)((e & 1) ? (a >> 16) : (a & 0xffffu));
                    *(LAS unsigned short*)(KT + (d0 + 32 + e) * RS_T + p * 2) = (unsigned short)((e & 1) ? (c >> 16) : (c & 0xffffu)); }
#pragma unroll
                for (int it2 = 0; it2 < 2; ++it2) { const int it = tid + 512 * it2, pv = it >> 4, vg = it & 15;
                    const u32x4 vv = *(const u32x4*)(Pv + (size_t)(row0 + pv) * 1024 + 8 * vg);
#pragma unroll
                    for (int e = 0; e < 8; ++e) { const unsigned a = vv[e >> 1]; *(LAS unsigned short*)(VT + (8 * vg + e) * RS_T + pv * 2) = (unsigned short)((e & 1) ? (a >> 16) : (a & 0xffffu)); } }
            }
            __syncthreads();
            if (pass == 0 && do_out) {
                const int mi = w >> 1;
#pragma unroll
                for (int t = 0; t < 2; ++t) { const int nj = 2 * (w & 1) + t; f32x4 acc = (f32x4){0.f, 0.f, 0.f, 0.f};
#pragma unroll
                    for (int ks = 0; ks < 4; ++ks) { const bf16x8 a = *(const LAS bf16x8*)(Qs + (16 * mi + fr) * RS_Q + (32 * ks + 8 * g) * 2), bb = *(const LAS bf16x8*)(Ks + (16 * nj + fr) * RS_Q + (32 * ks + 8 * g) * 2);
                        acc = MFMA16(a, bb, acc); }
#pragma unroll
                    for (int r = 0; r < 4; ++r) { const int i = 16 * mi + 4 * g + r, j = 16 * nj + fr, dd = i - j; const float dec = exp2f(dd >= 0 ? (float)dd * lf2 : (float)(-dd) * lb2);
                        *(LAS unsigned short*)(Sc + i * RS_T + j * 2) = (unsigned short)f2bf(acc[r] * dec); } }
            }
            __syncthreads();
            if (do_out) {
                const int mi = w >> 1, nd0 = 4 * (w & 1);
                f32x4 a1[4], a2[4];
#pragma unroll
                for (int t = 0; t < 4; ++t) { a1[t] = (f32x4){0.f, 0.f, 0.f, 0.f}; a2[t] = (f32x4){0.f, 0.f, 0.f, 0.f}; }
                if (pass == 0) {
#pragma unroll
                    for (int ks = 0; ks < 2; ++ks) { const bf16x8 a = *(const LAS bf16x8*)(Sc + (16 * mi + fr) * RS_T + (32 * ks + 8 * g) * 2);
#pragma unroll
                        for (int t = 0; t < 4; ++t) { const bf16x8 bb = *(const LAS bf16x8*)(VT + (16 * (nd0 + t) + fr) * RS_T + (32 * ks + 8 * g) * 2); a1[t] = MFMA16(a, bb, a1[t]); } }
                }
#pragma unroll
                for (int ks = 0; ks < 4; ++ks) { const bf16x8 a = *(const LAS bf16x8*)(Qs + (16 * mi + fr) * RS_Q + (32 * ks + 8 * g) * 2);
#pragma unroll
                    for (int t = 0; t < 4; ++t) { const bf16x8 bb = *(const LAS bf16x8*)(ST + (16 * (nd0 + t) + fr) * RS_Q + (32 * ks + 8 * g) * 2); a2[t] = MFMA16(a, bb, a2[t]); } }
#pragma unroll
                for (int r = 0; r < 4; ++r) { const int il = 16 * mi + 4 * g + r; const float xi = exp2f(pass == 0 ? (float)(il + 1) * lf2 : (float)(64 - il) * lb2);
#pragma unroll
                    for (int t = 0; t < 4; ++t) *(LAS unsigned short*)(Ys + il * RS_Q + (16 * (nd0 + t) + fr) * 2) = (unsigned short)f2bf(a1[t][r] + xi * a2[t][r]); }
            }
            {
                bf16x8 af[2];
#pragma unroll
                for (int ks = 0; ks < 2; ++ks) { const u32x4 kk = *(const LAS u32x4*)(KT + (16 * w + fr) * RS_T + (32 * ks + 8 * g) * 2); float z[8];
#pragma unroll
                    for (int e = 0; e < 8; ++e) { const int tok = 32 * ks + 8 * g + e; z[e] = bfel(kk, e) * exp2f(pass == 0 ? (float)(63 - tok) * lf2 : (float)tok * lb2); }
                    u32x4 o; o.x = pk2(z[0], z[1]); o.y = pk2(z[2], z[3]); o.z = pk2(z[4], z[5]); o.w = pk2(z[6], z[7]); af[ks] = __builtin_bit_cast(bf16x8, o); }
#pragma unroll
                for (int nd = 0; nd < 8; ++nd) { Sacc[nd] = Sacc[nd] * gC;
#pragma unroll
                    for (int ks = 0; ks < 2; ++ks) { const bf16x8 bb = *(const LAS bf16x8*)(VT + (16 * nd + fr) * RS_T + (32 * ks + 8 * g) * 2); Sacc[nd] = MFMA16(af[ks], bb, Sacc[nd]); } }
            }
            __syncthreads();
#pragma unroll
            for (int nd = 0; nd < 8; ++nd) { u32x2 o; o.x = pk2(Sacc[nd][0], Sacc[nd][1]); o.y = pk2(Sacc[nd][2], Sacc[nd][3]); *(LAS u32x2*)(ST + (16 * nd + fr) * RS_Q + (16 * w + 4 * g) * 2) = o; }
            if (do_out) {
                const int p = tid >> 3, sg = tid & 7; const size_t go = (size_t)(row0 + p) * 1024 + 16 * sg;
                const u32x4 y0 = *(const LAS u32x4*)(Ys + p * RS_Q + 32 * sg), y1 = *(const LAS u32x4*)(Ys + p * RS_Q + 32 * sg + 16);
                if (pass == 0) { *(u32x4*)(AA + go) = y0; *(u32x4*)(AA + go + 8) = y1; }
                else {
                    const u32x4 f0 = *(const u32x4*)(AA + go), f1 = *(const u32x4*)(AA + go + 8), g0 = *(const u32x4*)(Pg + go), g1 = *(const u32x4*)(Pg + go + 8);
                    float tv[16]; float ss = 0.f;
#pragma unroll
                    for (int e = 0; e < 8; ++e) { tv[e] = bfel(y0, e) + bfel(f0, e); tv[8 + e] = bfel(y1, e) + bfel(f1, e); ss += tv[e] * tv[e] + tv[8 + e] * tv[8 + e]; }
                    ss += __shfl_xor(ss, 1); ss += __shfl_xor(ss, 2); ss += __shfl_xor(ss, 4);
                    const float rstd = rsqrtf(ss * (1.0f / 128.0f) + NORM_EPS);
#pragma unroll
                    for (int e = 0; e < 8; ++e) { const float ga = bfel(g0, e), gb = bfel(g1, e); tv[e] *= rstd * ga * sigmoidf_(ga); tv[8 + e] *= rstd * gb * sigmoidf_(gb); }
                    u32x4 o0, o1;
                    o0.x = pk2(tv[0], tv[1]); o0.y = pk2(tv[2], tv[3]); o0.z = pk2(tv[4], tv[5]); o0.w = pk2(tv[6], tv[7]);
                    o1.x = pk2(tv[8], tv[9]); o1.y = pk2(tv[10], tv[11]); o1.z = pk2(tv[12], tv[13]); o1.w = pk2(tv[14], tv[15]);
                    *(u32x4*)(AA + go) = o0; *(u32x4*)(AA + go + 8) = o1;
                }
            }
            __syncthreads();
        }
    }
}
constexpr int NA_SC = 528, NA_SL = 1168;
constexpr int LN_VC = 0, LN_VL = LN_VC + 64 * NA_SC, LN_RPB = LN_VL + 64 * NA_SL, LN_END = LN_RPB + 512 * 4;
static_assert(LN_END <= LCTL_OFF, "NA LDS");
__device__ __forceinline__ int clampi(int v, int lo, int hi) { return v < lo ? lo : (v > hi ? hi : v); }
__device__ __forceinline__ void na_block(float (&s)[8], float& m, float& lsum, f32x4 (&O)[4], const LAS unsigned char* vt, int vstride, int key0, int fr, int g) {
    float mb = fmaxf(fmaxf(fmaxf(s[0], s[1]), fmaxf(s[2], s[3])), fmaxf(fmaxf(s[4], s[5]), fmaxf(s[6], s[7])));
    mb = fmaxf(mb, __shfl_xor(mb, 16)); mb = fmaxf(mb, __shfl_xor(mb, 32));
    const float mn = fmaxf(m, mb); const float alpha = exp2f(m - mn); m = mn;
    float ps = 0.f;
#pragma unroll
    for (int e = 0; e < 8; ++e) { s[e] = exp2f(s[e] - mn); ps += s[e]; }
    lsum = lsum * alpha + ps;
    u32x4 pw; pw.x = pk2(s[0], s[1]); pw.y = pk2(s[2], s[3]); pw.z = pk2(s[4], s[5]); pw.w = pk2(s[6], s[7]);
    const bf16x8 pf = __builtin_bit_cast(bf16x8, pw);
#pragma unroll
    for (int dt = 0; dt < 4; ++dt) { const LAS unsigned char* vp = vt + (16 * dt + fr) * vstride + (key0 + 4 * g) * 2;
        const u32x2 lo = *(const LAS u32x2*)vp, hi = *(const LAS u32x2*)(vp + 32);
        u32x4 vw; vw.x = lo.x; vw.y = lo.y; vw.z = hi.x; vw.w = hi.y;
        O[dt] = O[dt] * alpha; O[dt] = MFMA16(__builtin_bit_cast(bf16x8, vw), pf, O[dt]); }
}
__device__ __forceinline__ void na_unit(Frame& F, int l, int b, int h, int rp) {
    LAS unsigned char* VC = F.lds + LN_VC; LAS unsigned char* VL = F.lds + LN_VL; LAS float* RPB = (LAS float*)(F.lds + LN_RPB);
    const bf16* Pq = (const bf16*)(F.ws + WS_P) + 4 * PSTR + h * 64; const bf16* Pk = (const bf16*)(F.ws + WS_P) + 5 * PSTR + h * 64; const bf16* Pv = (const bf16*)(F.ws + WS_P) + 6 * PSTR + h * 64;
    bf16* AB = (bf16*)(F.ws + WS_AA) + PSTR + h * 64;
    PHASE_IDS(); const int w = wave, fr = lane & 15, g = lane >> 4;
    const int rowb = b * SROW, ra = 2 * rp; const int rlo = clampi(ra - 4, 0, 24); const int nrows = clampi(ra - 3, 0, 24) + 8 - rlo;
    for (int it = tid; it < 256 * 8; it += 512) { const int key = it >> 3, dg = it & 7; const u32x4 vv = *(const u32x4*)(Pv + (size_t)(rowb + key) * 1024 + 8 * dg);
#pragma unroll
        for (int e = 0; e < 8; ++e) { const unsigned a = vv[e >> 1]; *(LAS unsigned short*)(VC + (8 * dg + e) * NA_SC + key * 2) = (unsigned short)((e & 1) ? (a >> 16) : (a & 0xffffu)); } }
    for (int it = tid; it < nrows * 64 * 8; it += 512) { const int ksl = it >> 3, dg = it & 7; const u32x4 vv = *(const u32x4*)(Pv + (size_t)(rowb + CTXL + rlo * 64 + ksl) * 1024 + 8 * dg);
#pragma unroll
        for (int e = 0; e < 8; ++e) { const unsigned a = vv[e >> 1]; *(LAS unsigned short*)(VL + (8 * dg + e) * NA_SL + ksl * 2) = (unsigned short)((e & 1) ? (a >> 16) : (a & 0xffffu)); } }
    if (tid < 465) RPB[tid] = F.in[I_RPB][((size_t)l * 16 + h) * 465 + tid];
    __syncthreads();
    const int qr = ra + (w >> 2), q0 = 16 * (w & 3); const int qrow = rowb + CTXL + qr * 64 + q0 + fr;
    bf16x8 qf[2];
#pragma unroll
    for (int ks = 0; ks < 2; ++ks) qf[ks] = *(const bf16x8*)(Pq + (size_t)qrow * 1024 + 32 * ks + 8 * g);
    float m = -INFINITY, lsum = 0.f; f32x4 O[4];
#pragma unroll
    for (int dt = 0; dt < 4; ++dt) O[dt] = (f32x4){0.f, 0.f, 0.f, 0.f};
    const float qs = 0.125f * LOG2E;
    for (int kb = 0; kb < 8; ++kb) {
        float s[8];
#pragma unroll
        for (int t = 0; t < 2; ++t) { const bf16* kp = Pk + (size_t)(rowb + 32 * kb + 16 * t + fr) * 1024 + 8 * g;
            f32x4 a = (f32x4){0.f, 0.f, 0.f, 0.f};
            a = MFMA16(*(const bf16x8*)kp, qf[0], a); a = MFMA16(*(const bf16x8*)(kp + 32), qf[1], a);
#pragma unroll
            for (int r = 0; r < 4; ++r) s[4 * t + r] = a[r] * qs; }
        na_block(s, m, lsum, O, VC, NA_SC, 32 * kb, fr, g);
    }
    const int r0 = clampi(qr - 4, 0, 24), cspan = clampi(q0 - 8, 0, 32); const int cq = q0 + fr, wst = clampi(cq - 8, 0, 48);
    for (int kr = 0; kr < 8; ++kr) {
        const int R = r0 + kr; float s[8];
#pragma unroll
        for (int t = 0; t < 2; ++t) { const bf16* kp = Pk + (size_t)(rowb + CTXL + R * 64 + cspan + 16 * t + fr) * 1024 + 8 * g;
            f32x4 a = (f32x4){0.f, 0.f, 0.f, 0.f};
            a = MFMA16(*(const bf16x8*)kp, qf[0], a); a = MFMA16(*(const bf16x8*)(kp + 32), qf[1], a);
#pragma unroll
            for (int r = 0; r < 4; ++r) { const int ck = cspan + 16 * t + 4 * g + r; const bool valid = (ck >= wst) && (ck < wst + 16);
                const int bi = (R - qr + 7) * 31 + clampi(ck - cq + 15, 0, 30);
                s[4 * t + r] = valid ? (a[r] * 0.125f + RPB[bi]) * LOG2E : -INFINITY; } }
        na_block(s, m, lsum, O, VL, NA_SL, (R - rlo) * 64 + cspan, fr, g);
    }
    lsum += __shfl_xor(lsum, 16); lsum += __shfl_xor(lsum, 32);
    const float inv = 1.0f / lsum;
#pragma unroll
    for (int dt = 0; dt < 4; ++dt) { u32x2 o; o.x = pk2(O[dt][0] * inv, O[dt][1] * inv); o.y = pk2(O[dt][2] * inv, O[dt][3] * inv); *(u32x2*)(AB + (size_t)qrow * 1024 + 16 * dt + 4 * g) = o; }
    __syncthreads();
}
constexpr int RS_UF = 528;
constexpr int LL_UB = 0, LL_UF = LL_UB + 64 * RS_Q, LL_AB = LL_UF + 64 * RS_UF, LL_BB = LL_AB + 64 * RS_UF, LL_CW = LL_BB + 64 * RS_UF, LL_END = LL_CW + 5 * 128 * 4;
static_assert(LL_END <= LCTL_OFF, "LRU LDS");
__device__ __forceinline__ void lru_unit(Frame& F, int l, int b, int kblk, bool need_ctx) {
    LAS unsigned char* Ub = F.lds + LL_UB; LAS unsigned char* Uf = F.lds + LL_UF; LAS unsigned char* Ab = F.lds + LL_AB; LAS unsigned char* Bb = F.lds + LL_BB; LAS float* CW = (LAS float*)(F.lds + LL_CW);
    const int ch0 = 128 * kblk;
    const bf16* Plx = (const bf16*)(F.ws + WS_P) + 7 * PSTR + ch0; const bf16* Ply = (const bf16*)(F.ws + WS_P) + 8 * PSTR + ch0;
    bf16* AC = (bf16*)(F.ws + WS_AA) + 2 * PSTR + ch0;
    PHASE_IDS(); const int w = wave, fr = lane & 15, g = lane >> 4;
    const int rowb = b * SROW;
    __syncthreads();
    for (int i = tid; i < 5 * 128; i += 512) { const int j = i >> 7, c = i & 127; CW[i] = j < 4 ? F.in[I_CONVW][((size_t)l * 4 + j) * 1024 + ch0 + c] : F.in[I_CONVB][(size_t)l * 1024 + ch0 + c]; }
    const int co = 16 * w + fr;
    for (int pass = 0; pass < 2; ++pass) {
        bf16x8 Bfa[4], Bfx[4];
        { const float* wa = F.in[I_GAW] + ((((size_t)l * 2 + pass) * 8 + kblk) * 128) * 128 + co; const float* wx = F.in[I_GXW] + ((((size_t)l * 2 + pass) * 8 + kblk) * 128) * 128 + co;
#pragma unroll
          for (int ks = 0; ks < 4; ++ks) { float ta[8], tx[8];
#pragma unroll
              for (int e = 0; e < 8; ++e) { const int ci = 32 * ks + 8 * g + e; ta[e] = wa[(size_t)ci * 128]; tx[e] = wx[(size_t)ci * 128]; }
              u32x4 oa, ox; oa.x = pk2(ta[0], ta[1]); oa.y = pk2(ta[2], ta[3]); oa.z = pk2(ta[4], ta[5]); oa.w = pk2(ta[6], ta[7]);
              ox.x = pk2(tx[0], tx[1]); ox.y = pk2(tx[2], tx[3]); ox.z = pk2(tx[4], tx[5]); ox.w = pk2(tx[6], tx[7]);
              Bfa[ks] = __builtin_bit_cast(bf16x8, oa); Bfx[ks] = __builtin_bit_cast(bf16x8, ox); } }
        const size_t vo = ((size_t)l * 2 + pass) * 1024 + ch0 + co;
        const float ba = F.in[I_GAB][vo], bx = F.in[I_GXB][vo]; const float nsp8 = -8.0f * log1pf(expf(-F.in[I_LAM][vo]));
        float hstate = 0.f;
        for (int step = 0; step < 36; ++step) {
            bool isctx; int cidx; chunk_of(pass, step, isctx, cidx);
            const int segb = rowb + (isctx ? 0 : CTXL), seglen = isctx ? CTXL : SEQ, t0 = 64 * cidx;
            const bool do_out = !isctx || need_ctx;
            { const int p = tid >> 3, cg = tid & 7, c0 = 16 * cg; float u[16];
#pragma unroll
              for (int e = 0; e < 16; ++e) u[e] = CW[4 * 128 + c0 + e];
#pragma unroll
              for (int j = 0; j < 4; ++j) { const int tt = t0 + p + j - 1;
                  if (tt >= 0 && tt < seglen) { const bf16* xp = Plx + (size_t)(segb + tt) * 1024 + c0; const u32x4 x0 = *(const u32x4*)xp, x1 = *(const u32x4*)(xp + 8);
#pragma unroll
                      for (int e = 0; e < 8; ++e) { u[e] += CW[j * 128 + c0 + e] * bfel(x0, e); u[8 + e] += CW[j * 128 + c0 + 8 + e] * bfel(x1, e); } } }
              u32x4 o0, o1; o0.x = pk2(u[0], u[1]); o0.y = pk2(u[2], u[3]); o0.z = pk2(u[4], u[5]); o0.w = pk2(u[6], u[7]);
              o1.x = pk2(u[8], u[9]); o1.y = pk2(u[10], u[11]); o1.z = pk2(u[12], u[13]); o1.w = pk2(u[14], u[15]);
              *(LAS u32x4*)(Ub + p * RS_Q + c0 * 2) = o0; *(LAS u32x4*)(Ub + p * RS_Q + c0 * 2 + 16) = o1;
#pragma unroll
              for (int q = 0; q < 4; ++q) *(LAS f32x4*)(Uf + p * RS_UF + (c0 + 4 * q) * 4) = (f32x4){u[4 * q], u[4 * q + 1], u[4 * q + 2], u[4 * q + 3]}; }
            __syncthreads();
#pragma unroll
            for (int mt = 0; mt < 4; ++mt) { f32x4 ga = (f32x4){0.f, 0.f, 0.f, 0.f}, gx = ga;
#pragma unroll
                for (int ks = 0; ks < 4; ++ks) { const bf16x8 a = *(const LAS bf16x8*)(Ub + (16 * mt + fr) * RS_Q + (32 * ks + 8 * g) * 2); ga = MFMA16(a, Bfa[ks], ga); gx = MFMA16(a, Bfx[ks], gx); }
#pragma unroll
                for (int r = 0; r < 4; ++r) { const int tok = 16 * mt + 4 * g + r; const float rr = sigmoidf_(ga[r] + ba), ii = sigmoidf_(gx[r] + bx); const float la = nsp8 * rr;
                    const float av = __expf(la); const float uu = *(const LAS float*)(Uf + tok * RS_UF + co * 4); const float bt = sqrtf(fmaxf(-expm1f(2.0f * la), 0.f)) * ii * uu;
                    *(LAS float*)(Ab + tok * RS_UF + co * 4) = av; *(LAS float*)(Bb + tok * RS_UF + co * 4) = bt; } }
            __syncthreads();
            if (tid < 128) {
                if (pass == 0) {
#pragma unroll 8
                    for (int tt = 0; tt < 64; ++tt) { const float av = *(const LAS float*)(Ab + tt * RS_UF + tid * 4), bv = *(const LAS float*)(Bb + tt * RS_UF + tid * 4); hstate = av * hstate + bv; *(LAS float*)(Bb + tt * RS_UF + tid * 4) = hstate; }
                } else {
#pragma unroll 8
                    for (int tt = 63; tt >= 0; --tt) { const float av = *(const LAS float*)(Ab + tt * RS_UF + tid * 4), bv = *(const LAS float*)(Bb + tt * RS_UF + tid * 4); hstate = av * hstate + bv; *(LAS float*)(Bb + tt * RS_UF + tid * 4) = hstate; }
                }
            }
            __syncthreads();
            if (do_out) { const int p = tid >> 3, cg = tid & 7, c0 = 16 * cg; const size_t go = (size_t)(segb + t0 + p) * 1024 + c0; float hv[16];
#pragma unroll
                for (int q = 0; q < 4; ++q) { const f32x4 t = *(const LAS f32x4*)(Bb + p * RS_UF + (c0 + 4 * q) * 4); hv[4 * q] = t.x; hv[4 * q + 1] = t.y; hv[4 * q + 2] = t.z; hv[4 * q + 3] = t.w; }
                if (pass == 1) { const u32x4 f0 = *(const u32x4*)(AC + go), f1 = *(const u32x4*)(AC + go + 8), y0 = *(const u32x4*)(Ply + go), y1 = *(const u32x4*)(Ply + go + 8);
#pragma unroll
                    for (int e = 0; e < 8; ++e) { hv[e] = (hv[e] + bfel(f0, e)) * gelu_tanh(bfel(y0, e)); hv[8 + e] = (hv[8 + e] + bfel(f1, e)) * gelu_tanh(bfel(y1, e)); } }
                u32x4 o0, o1; o0.x = pk2(hv[0], hv[1]); o0.y = pk2(hv[2], hv[3]); o0.z = pk2(hv[4], hv[5]); o0.w = pk2(hv[6], hv[7]);
                o1.x = pk2(hv[8], hv[9]); o1.y = pk2(hv[10], hv[11]); o1.z = pk2(hv[12], hv[13]); o1.w = pk2(hv[14], hv[15]);
                *(u32x4*)(AC + go) = o0; *(u32x4*)(AC + go + 8) = o1; }
        }
        __syncthreads();
    }
}

__device__ __forceinline__ int queue_pop(Frame& F, unsigned* q) {
    __syncthreads();
    if (threadIdx.x == 0) F.MISC[0] = atomicAdd(q, 1u);
    __syncthreads();
    return (int)F.MISC[0];
}
#ifndef PHMASK
#define PHMASK 0xffff
#endif
#define PHM(b) ((PHMASK >> (b)) & 1)
__device__ __forceinline__ void p3_mixers(Frame& F, int l, bool need_ctx) {
    unsigned* q = F.ctl + CW_Q + l * 3 * 64;
    if (PHM(3)) for (;;) { const int u = queue_pop(F, q); if (u >= NB * 8) break; ret_unit(F, l, u >> 3, u & 7, need_ctx); }
    if (PHM(4)) for (;;) { const int u = queue_pop(F, q + 64); if (u >= NB * 8) break; lru_unit(F, l, u >> 3, u & 7, need_ctx); }
    if (PHM(5)) for (;;) { const int u = queue_pop(F, q + 128); if (u >= NB * 16 * 16) break; na_unit(F, l, u >> 8, (u >> 4) & 15, u & 15); }
}
__global__ void __launch_bounds__(512, 2) fwd_kernel(Args args) {
    extern __shared__ __attribute__((aligned(16))) unsigned char lds[];
    Frame F;
    F.lds = (LAS unsigned char*)lds; F.MISC = (volatile LAS unsigned*)(F.lds + LCTL_OFF);
    F.G = gridDim.x; F.c = blockIdx.x; F.vcu = (F.G % 8 == 0) ? (F.c % 8) * (F.G / 8) + F.c / 8 : F.c;
    F.ws = args.ws; F.ctl = (unsigned*)(args.ws + WS_CTL); F.in = args.in;
    for (int u = threadIdx.x; u < (LDS_BYTES - LCTL_OFF) / 4; u += 512) ((LAS unsigned*)(F.lds + LCTL_OFF))[u] = 0u;
    __syncthreads();
    XcdBarrier bar; bar.bar = F.ctl + CW_BAR; bar.x = 0; bar.st = nullptr;
    if (!MK_PER_PHASE) bar = xcd_barrier_post(F.ctl + CW_BAR, F.MISC + 8);
    const int lo = args.ph_lo, hi = args.ph_hi;
#ifndef PHMASK
#define PHMASK 0xffff
#endif
#define PHM(b) ((PHMASK >> (b)) & 1)
#define IN(k) (lo <= (k) && (k) < hi)
#define SEAM(k) do { if (IN(k) && IN((k) + 1)) xcd_barrier(bar); } while (0)
    volatile LAS int* toff = (volatile LAS int*)(F.lds + LCTL_OFF + 256);

    if (PHM(0) && IN(0)) { p0_prologue(F); } SEAM(0);
    if (PHM(1) && IN(1)) { p1_norm1(F); } SEAM(1);
    for (int l = 0; l < DEPTH; ++l) {
        const int pb = 2 + 9 * l; const bool last = (l == DEPTH - 1);
        if (PHM(2) && IN(pb + 0)) {
            SchedDense S; S.init(F.ws + WS_H, F.ws + WS_WMIX + (size_t)l * 12288 * 1024 * 2, 1024, 48, false, F.G, F.c);
            EpiProj E{(bf16*)(F.ws + WS_P)};
            pg8::gemm_phase<EpiProj, SchedDense, true>(F.lds, 1024, S, E);
        } SEAM(pb + 0);
        if (IN(pb + 1)) { p3_mixers(F, l, !last); } SEAM(pb + 1);
        if (PHM(6) && IN(pb + 2)) {
            SchedBranch S; S.init(F.ws + WS_AA, F.ws + WS_WBR + (size_t)l * 3 * 1024 * 1024 * 2, last, F.G, F.c);
            EpiBranch E{(const bf16*)(F.ws + WS_P) + 9 * PSTR, (float*)(F.ws + WS_M32), (bf16*)(F.ws + WS_MB)};
            pg8::gemm_phase<EpiBranch, SchedBranch, true>(F.lds, 1024, S, E);
        } SEAM(pb + 2);
        if (PHM(7) && IN(pb + 3)) {
            SchedDense S; S.init(F.ws + WS_MB, F.ws + WS_WOUT + (size_t)l * 1024 * 1024 * 2, 1024, 4, last, F.G, F.c);
            EpiOut E{F.in[I_X], F.in[I_CTX], (float*)(F.ws + WS_X), (const float*)(F.ws + WS_MODV) + (size_t)l * 17 * 6144, l == 0};
            pg8::gemm_phase<EpiOut, SchedDense, true>(F.lds, 1024, S, E);
        } SEAM(pb + 3);
        if (PHM(8) && IN(pb + 4)) { p6_router(F, l, last); } SEAM(pb + 4);
        if (PHM(9) && IN(pb + 5)) { p6b_scatter(F, l, last); } SEAM(pb + 5);
        if (PHM(10) && IN(pb + 6)) {
            moe_toff(F, l, toff);
            SchedMoE S; S.init(F.ws + WS_H2S, F.ws + WS_WUP + (size_t)l * 32 * 2048 * 1024 * 2, (size_t)2048 * 1024 * 2, toff, 8, F.G, F.c);
            EpiUp E{(bf16*)(F.ws + WS_ACT), F.in[I_BUP] + (size_t)l * 32 * 2048};
            pg8::gemm_phase<EpiUp, SchedMoE, true>(F.lds, 1024, S, E);
        } SEAM(pb + 6);
        if (PHM(11) && IN(pb + 7)) {
            moe_toff(F, l, toff);
            SchedMoE S; S.init(F.ws + WS_ACT, F.ws + WS_WDN + (size_t)l * 32 * 1024 * 1024 * 2, (size_t)1024 * 1024 * 2, toff, 4, F.G, F.c);
            EpiDown E{(bf16*)(F.ws + WS_H2S), F.in[I_BDN] + (size_t)l * 32 * 1024, (const float*)(F.ws + WS_ROWW)};
            pg8::gemm_phase<EpiDown, SchedMoE, true>(F.lds, 1024, S, E);
        } SEAM(pb + 7);
        if (PHM(12) && IN(pb + 8)) { p9_combine(F, l, last, args.out); } SEAM(pb + 8);
    }
#undef IN
#undef SEAM
}

extern "C" void kernel_launch(void* const* d_in, const int* in_sizes, int n_in, void* d_out, int out_size, void* d_ws, size_t ws_size, hipStream_t stream) {
    static int grid = 0;
    if (grid == 0) {
        if (n_in != 28 || ws_size < WS_END) { fprintf(stderr, "kernel_launch: expected 28 inputs and >= %zu bytes of workspace; got %d, %zu\n", (size_t)WS_END, n_in, ws_size); grid = -1; return; }
        int dev = 0, cus = 0, per_cu = 0;
        if (hipGetDevice(&dev) != hipSuccess || hipDeviceGetAttribute(&cus, hipDeviceAttributeMultiprocessorCount, dev) != hipSuccess) { grid = -1; return; }
        if (hipFuncSetAttribute((const void*)fwd_kernel, hipFuncAttributeMaxDynamicSharedMemorySize, LDS_BYTES) != hipSuccess) { fprintf(stderr, "kernel_launch: hipFuncSetAttribute failed\n"); grid = -1; return; }
        if (hipOccupancyMaxActiveBlocksPerMultiprocessor(&per_cu, (const void*)fwd_kernel, 512, LDS_BYTES) != hipSuccess || per_cu < 1) fprintf(stderr, "kernel_launch: occupancy query reports %d\n", per_cu);
        (void)hipGetLastError();
        grid = cus > 256 ? 256 : cus;
    }
    if (grid < 0) return;
    if (hipMemsetAsync((char*)d_ws + WS_CTL, 0, CTL_ZERO_BYTES, stream) != hipSuccess) return;
    Args a{};
    for (int i = 0; i < 28; ++i) a.in[i] = (const float*)d_in[i];
    a.out = (float*)d_out; a.ws = (unsigned char*)d_ws;
#if MK_PER_PHASE
    for (int p = 0; p < N_PHASES; ++p) { a.ph_lo = p; a.ph_hi = p + 1; hipLaunchKernelGGL(fwd_kernel, dim3(grid), dim3(512), LDS_BYTES, stream, a); }
#else
    a.ph_lo = 0; a.ph_hi = N_PHASES;
    hipLaunchKernelGGL(fwd_kernel, dim3(grid), dim3(512), LDS_BYTES, stream, a);
#endif
    const hipError_t le = hipPeekAtLastError();
    if (le != hipSuccess) fprintf(stderr, "kernel_launch: launch failed: %s\n", hipGetErrorName(le));
}
```

```cpp
#include <hip/hip_runtime.h>
#include <cstdio>
#include <cstdint>

#define GAS __attribute__((address_space(1)))
#define LAS __attribute__((address_space(3)))
typedef unsigned short bf16;
typedef short bf16x8 __attribute__((ext_vector_type(8)));
typedef float f32x4 __attribute__((ext_vector_type(4)));
typedef float f32x2 __attribute__((ext_vector_type(2)));
typedef unsigned u32x4 __attribute__((ext_vector_type(4)));
typedef unsigned u32x2 __attribute__((ext_vector_type(2)));
typedef GAS unsigned gu32;

constexpr int D = 1024, NB = 16, SEQ = 2048, CTXL = 256, SROW = CTXL + SEQ, NROWS = NB * SROW, DEPTH = 2;
constexpr int INW = 12288, NEXP = 32, DEXP = 1024;
constexpr size_t PSTR = (size_t)NROWS * 1024;
constexpr int MAXSORT = NROWS * 4 + NEXP * 256;
constexpr float NORM_EPS = 1e-6f;
constexpr float LOG2E = 1.4426950408889634f;

constexpr size_t MiB = 1u << 20;
constexpr size_t WS_CTL = 0, CTL_ZERO_BYTES = 1 * MiB;
constexpr size_t WS_MODV = 1 * MiB;
constexpr size_t WS_ROPE = 2 * MiB;
constexpr size_t WS_TOKE = 3 * MiB, WS_TOKP = 4 * MiB, WS_TOKW = 5 * MiB, WS_TOKS = 6 * MiB, WS_ROWW = 7 * MiB;
constexpr size_t WS_WMIX = 8 * MiB;
constexpr size_t WS_WBR = 56 * MiB;
constexpr size_t WS_WOUT = 68 * MiB;
constexpr size_t WS_WUP = 72 * MiB;
constexpr size_t WS_WDN = 328 * MiB;
constexpr size_t WS_X = 456 * MiB;
constexpr size_t WS_H = 600 * MiB;
constexpr size_t WS_P = 672 * MiB;
constexpr size_t WS_AA = 1536 * MiB;
constexpr size_t WS_END = 1752 * MiB;
constexpr size_t WS_M32 = WS_P;
constexpr size_t WS_MB = WS_P + 2 * 72 * MiB;
constexpr size_t WS_ACT = WS_P;
constexpr size_t WS_H2S = WS_P + 5 * 72 * MiB;
static_assert(PSTR * 2 == 72 * MiB && (size_t)MAXSORT * 2048 == 304 * MiB && WS_H2S + 304 * MiB <= WS_AA, "ws map");
constexpr int CW_TMO = 0, CW_BAR = 4096, CW_Q = 8192, CW_CNT = 10240;
constexpr int LDS_BYTES = 163840, LCTL_OFF = 162816;
constexpr int N_PHASES = 20;
#ifndef REP_MASK
#define REP_MASK 0
#endif
#ifndef MK_PER_PHASE
#define MK_PER_PHASE 0
#endif

__device__ __forceinline__ float bflo(unsigned w) { return __uint_as_float(w << 16); }
__device__ __forceinline__ float bfhi(unsigned w) { return __uint_as_float(w & 0xffff0000u); }
__device__ __forceinline__ float bfel(const u32x4& w, int e) { const unsigned x = w[e >> 1]; return (e & 1) ? bfhi(x) : bflo(x); }
__device__ __forceinline__ unsigned f2bf(float f) { unsigned u = __float_as_uint(f); return (u + 0x7fffu + ((u >> 16) & 1u)) >> 16; }
__device__ __forceinline__ unsigned pk2(float lo, float hi) { unsigned r; asm volatile("v_cvt_pk_bf16_f32 %0, %1, %2" : "=v"(r) : "v"(lo), "v"(hi)); return r; }
__device__ __forceinline__ float wave_sum(float v) {
#pragma unroll
    for (int o = 1; o < 64; o <<= 1) v += __shfl_xor(v, o);
    return v;
}
__device__ __forceinline__ float wave_max(float v) {
#pragma unroll
    for (int o = 1; o < 64; o <<= 1) v = fmaxf(v, __shfl_xor(v, o));
    return v;
}
__device__ __forceinline__ float fexp2(float x) { return __builtin_amdgcn_exp2f(x); }
__device__ __forceinline__ float sigmoidf_(float x) { return __builtin_amdgcn_rcpf(1.0f + __builtin_amdgcn_exp2f(-x * LOG2E)); }
__device__ __forceinline__ float gelu_tanh(float y) { const float z = 0.7978845608028654f * (y + 0.044715f * y * y * y); const float t = 1.0f - 2.0f / (__expf(2.0f * z) + 1.0f); return 0.5f * y * (1.0f + t); }
#define LDS_WAIT() asm volatile("s_waitcnt lgkmcnt(0)" ::: "memory")
#define VM_WAIT() asm volatile("s_waitcnt vmcnt(0)" ::: "memory")
#define RLX_AGENT __ATOMIC_RELAXED, __HIP_MEMORY_SCOPE_AGENT
#define MFMA16(a, b, c) __builtin_amdgcn_mfma_f32_16x16x32_bf16((a), (b), (c), 0, 0, 0)
__device__ __forceinline__ int opaque_tid() { int t = threadIdx.x; asm volatile("" : "+v"(t)); return t; }
namespace pg8 {
#define PG8_LAS __attribute__((address_space(3)))
constexpr int BM = 256, BK = 64, HALF = 128, HTB = HALF * BK * 2, STAGE_BYTES = 8 * HTB, NXCD = 8, WGM = 8;
__host__ __device__ __forceinline__ int lds_byte(int r, int c) { const int st = (r >> 4) * 2 + (c >> 5), rr = r & 15, cc = c & 31, ob = rr * 64 + cc * 2; return st * 1024 + (ob ^ (((ob >> 9) & 1) << 5)); }
__host__ __device__ __forceinline__ void stage_rc(int b, int& R, int& C) { const int st = b / 1024, sb = b % 1024, swz = sb ^ (((sb >> 9) & 1) << 5); R = (st >> 1) * 16 + swz / 64; C = (st & 1) * 32 + (swz % 64) / 2; }
__host__ __device__ __forceinline__ int perm32(int rho) { const int n = rho >> 4, i = rho & 15; return 8 * (i >> 2) + 4 * n + (i & 3); }
struct Unit { int pm, pn, aux; };
struct StaticOrder {
    int nM, nN, nwg, G, c;
    __device__ __forceinline__ void init(int nM_, int nN_, int G_, int c_) { nM = nM_; nN = nN_; nwg = nM * nN; G = G_; c = c_; }
    __device__ __forceinline__ bool next(int i, int& pm, int& pn) const {
        const long L = (long)i * G + c; if (L >= nwg) return false;
        int wgid = (int)L; { const int q = nwg / NXCD, r = nwg % NXCD, xcd = wgid % NXCD, off = wgid / NXCD; wgid = (xcd < r ? xcd * (q + 1) : r * (q + 1) + (xcd - r) * q) + off; }
        const int nig = WGM * nN, gid = wgid / nig, fm = gid * WGM, gsz = (nM - fm) < WGM ? (nM - fm) : WGM;
        pm = fm + ((wgid % nig) % gsz); pn = (wgid % nig) / gsz; return true;
    }
};
template <class Epi, class Sched, bool ALIGN_EPI>
__device__ __forceinline__ void gemm_phase(PG8_LAS unsigned char* lds, const int K, const Sched& S, const Epi& E) {
    const int tid = opaque_tid(), wid = __builtin_amdgcn_readfirstlane(tid >> 6), lane = tid & 63, wr = wid >> 2, wc = wid & 3, fr = lane & 15, fq = lane >> 4;
    const int nt = K / BK;
    unsigned voffA[2], voffB[2];
#pragma unroll
    for (int i = 0; i < 2; ++i) { int R, C; stage_rc(tid * 16 + i * 8192, R, C); const int Rb = Epi::PERM ? ((R & ~31) + perm32(R & 31)) : R;
        voffA[i] = (unsigned)(R * K + C) * 2u; voffB[i] = (unsigned)(Rb * K + C) * 2u; }
    const size_t kstep = (size_t)(BK * 2);
    const size_t hstep = (size_t)HALF * K * 2;
    const unsigned ldsw = (unsigned)wid * 1024u;
    const int aoff = lds_byte(wr * 64 + fr, fq * 8), boff = lds_byte(wc * 32 + fr, fq * 8);
#define PG8_SA(b, h) (((b) * 2 + (h)) * HTB)
#define PG8_SB(b, h) ((4 + (b) * 2 + (h)) * HTB)
#define PG8_STAGE(bufoff, gbase, voff) do { _Pragma("unroll") for (int _i = 0; _i < 2; ++_i) \
        __builtin_amdgcn_global_load_lds((const unsigned*)((const char*)(gbase) + (voff)[_i]), (PG8_LAS unsigned*)(lds + (bufoff) + ldsw + _i * 8192), 16, 0, 0); } while (0)
#define PG8_LDA(dst, b, h) do { _Pragma("unroll") for (int m = 0; m < 4; ++m) _Pragma("unroll") for (int k = 0; k < 2; ++k) dst[m][k] = *(const PG8_LAS bf16x8*)(lds + PG8_SA(b, h) + aoff + m * 2048 + k * 1024); } while (0)
#define PG8_LDB(dst, b, h) do { _Pragma("unroll") for (int n = 0; n < 2; ++n) _Pragma("unroll") for (int k = 0; k < 2; ++k) dst[n][k] = *(const PG8_LAS bf16x8*)(lds + PG8_SB(b, h) + boff + n * 2048 + k * 1024); } while (0)
#define PG8_MMA(ai, bj, At, Bt) do { __builtin_amdgcn_s_setprio(1); _Pragma("unroll") for (int m = 0; m < 4; ++m) _Pragma("unroll") for (int n = 0; n < 2; ++n) _Pragma("unroll") for (int k = 0; k < 2; ++k) \
        acc[ai][bj][m][n] = __builtin_amdgcn_mfma_f32_16x16x32_bf16(Bt[n][k], At[m][k], acc[ai][bj][m][n], 0, 0, 0); __builtin_amdgcn_s_setprio(0); } while (0)
#define PG8_WAIT_V(n) asm volatile("s_waitcnt vmcnt(" #n ")" ::: "memory")
#define PG8_WAIT_L(n) asm volatile("s_waitcnt lgkmcnt(" #n ")" ::: "memory")
#define PG8_BAR __builtin_amdgcn_s_barrier()
#define PG8_SCHED __builtin_amdgcn_sched_barrier(0)
    Unit cur, nxt; int ui = 0;
    if (!S.next(0, cur)) return;
    f32x4 acc[2][2][4][2];
#pragma unroll
    for (int a = 0; a < 2; ++a)
#pragma unroll
        for (int b = 0; b < 2; ++b)
#pragma unroll
            for (int m = 0; m < 4; ++m)
#pragma unroll
                for (int n = 0; n < 2; ++n) acc[a][b][m][n] = (f32x4){0.f, 0.f, 0.f, 0.f};
    bf16x8 At[4][2], B0[2][2], B1[2][2];
    const char* cA = S.a_base(cur); const char* cB = S.b_base(cur);
    PG8_STAGE(PG8_SB(0, 0), cB, voffB); PG8_STAGE(PG8_SB(0, 1), cB + hstep, voffB); PG8_STAGE(PG8_SA(0, 0), cA, voffA); PG8_STAGE(PG8_SA(0, 1), cA + hstep, voffA);
    if (wr == 1) PG8_BAR;
    PG8_WAIT_V(2); PG8_BAR;
    PG8_STAGE(PG8_SB(1, 0), cB + kstep, voffB); PG8_STAGE(PG8_SA(1, 0), cA + kstep, voffA); PG8_STAGE(PG8_SB(1, 1), cB + hstep + kstep, voffB);
    PG8_WAIT_V(6); PG8_BAR;
    for (;;) {
        const bool has_next = S.next(ui + 1, nxt);
        const char* nA = has_next ? S.a_base(nxt) : cA; const char* nB = has_next ? S.b_base(nxt) : cB;
        for (int t = 0; t < nt; t += 2) {
            const bool last = (t == nt - 2);
            const char* a1 = cA + (size_t)(t + 1) * kstep;
            const char* a2 = last ? nA : cA + (size_t)(t + 2) * kstep; const char* b2 = last ? nB : cB + (size_t)(t + 2) * kstep;
            const char* a3 = a2 + kstep; const char* b3 = b2 + kstep;
            PG8_LDB(B0, 0, 0); PG8_LDB(B1, 0, 1); PG8_SCHED; PG8_LDA(At, 0, 0); PG8_STAGE(PG8_SA(1, 1), a1 + hstep, voffA);
            PG8_WAIT_V(8); PG8_WAIT_L(0); PG8_BAR; PG8_MMA(0, 0, At, B0); PG8_MMA(0, 1, At, B1); PG8_BAR; PG8_SCHED;
            PG8_LDA(At, 0, 1); PG8_STAGE(PG8_SB(0, 0), b2, voffB); PG8_STAGE(PG8_SB(0, 1), b2 + hstep, voffB); PG8_STAGE(PG8_SA(0, 0), a2, voffA);
            PG8_WAIT_V(8); PG8_WAIT_L(0); PG8_BAR; PG8_MMA(1, 0, At, B0); PG8_MMA(1, 1, At, B1); PG8_BAR; PG8_SCHED;
            PG8_LDB(B0, 1, 0); PG8_LDB(B1, 1, 1); PG8_SCHED; PG8_LDA(At, 1, 0); PG8_STAGE(PG8_SA(0, 1), a2 + hstep, voffA);
            PG8_WAIT_V(8); PG8_WAIT_L(0); PG8_BAR; PG8_MMA(0, 0, At, B0); PG8_MMA(0, 1, At, B1); PG8_BAR; PG8_SCHED;
            PG8_LDA(At, 1, 1); PG8_STAGE(PG8_SB(1, 0), b3, voffB); PG8_STAGE(PG8_SB(1, 1), b3 + hstep, voffB); PG8_STAGE(PG8_SA(1, 0), a3, voffA);
            PG8_WAIT_V(8); PG8_WAIT_L(0); PG8_BAR; PG8_MMA(1, 0, At, B0); PG8_MMA(1, 1, At, B1); PG8_BAR; PG8_SCHED;
        }
        if constexpr (ALIGN_EPI) { if (wr == 0) PG8_BAR; }
        E(acc, cur, wr, wc, fr, fq);
        if (!has_next) break;
#pragma unroll
        for (int a = 0; a < 2; ++a)
#pragma unroll
            for (int b = 0; b < 2; ++b)
#pragma unroll
                for (int m = 0; m < 4; ++m)
#pragma unroll
                    for (int n = 0; n < 2; ++n) acc[a][b][m][n] = (f32x4){0.f, 0.f, 0.f, 0.f};
        cur = nxt; cA = nA; cB = nB; ++ui;
        if constexpr (ALIGN_EPI) { if (wr == 1) PG8_BAR; }
    }
    PG8_WAIT_V(0);
    if constexpr (!ALIGN_EPI) { if (wr == 0) PG8_BAR; }
    PG8_BAR;
#undef PG8_SA
#undef PG8_SB
#undef PG8_STAGE
#undef PG8_LDA
#undef PG8_LDB
#undef PG8_MMA
#undef PG8_WAIT_V
#undef PG8_WAIT_L
#undef PG8_BAR
#undef PG8_SCHED
}
}

struct SchedDense {
    pg8::StaticOrder so; const char* A; const char* B; int K; bool lat;
    __device__ __forceinline__ void init(const void* A_, const void* B_, int K_, int nN, bool lat_, int G, int c) { A = (const char*)A_; B = (const char*)B_; K = K_; lat = lat_; so.init(lat_ ? 128 : 144, nN, G, c); }
    __device__ __forceinline__ bool next(int i, pg8::Unit& u) const { int pm, pn; if (!so.next(i, pm, pn)) return false; if (lat) pm = (pm >> 3) * 9 + 1 + (pm & 7); u.pm = pm; u.pn = pn; u.aux = 0; return true; }
    __device__ __forceinline__ const char* a_base(const pg8::Unit& u) const { return A + (size_t)u.pm * 256 * K * 2; }
    __device__ __forceinline__ const char* b_base(const pg8::Unit& u) const { return B + (size_t)u.pn * 256 * K * 2; }
};
struct SchedBranch {
    pg8::StaticOrder so; const char* A; const char* B; bool lat;
    __device__ __forceinline__ void init(const void* A_, const void* B_, bool lat_, int G, int c) { A = (const char*)A_; B = (const char*)B_; lat = lat_; so.init(lat_ ? 128 : 144, 4, G, c); }
    __device__ __forceinline__ bool next(int i, pg8::Unit& u) const { int pm, pn; const int it = i / 3; if (!so.next(it, pm, pn)) return false; if (lat) pm = (pm >> 3) * 9 + 1 + (pm & 7); u.pm = pm; u.pn = pn; u.aux = i - 3 * it; return true; }
    __device__ __forceinline__ const char* a_base(const pg8::Unit& u) const { return A + (size_t)u.aux * PSTR * 2 + (size_t)u.pm * 256 * 1024 * 2; }
    __device__ __forceinline__ const char* b_base(const pg8::Unit& u) const { return B + (size_t)u.aux * 1024 * 1024 * 2 + (size_t)u.pn * 256 * 1024 * 2; }
};
struct SchedMoE {
    const volatile LAS int* toff; int TT, npn, xcd, j, nwx, G, c; const char* A; const char* B; size_t bexp;
    __device__ __forceinline__ void init(const void* A_, const void* B_, size_t bexp_, const volatile LAS int* toff_, int npn_, int G_, int c_) {
        A = (const char*)A_; B = (const char*)B_; bexp = bexp_; toff = toff_; TT = toff_[NEXP]; npn = npn_; G = G_; c = c_; xcd = c_ & 7; j = c_ >> 3; nwx = G_ >> 3; }
    __device__ __forceinline__ bool next(int i, pg8::Unit& u) const {
        int tm, pn;
        if ((G & 7) == 0) { const int q = i * nwx + j; const int t = q / npn; tm = xcd + 8 * t; pn = q - t * npn; }
        else { const int L = i * G + c; tm = L / npn; pn = L - tm * npn; }
        if (tm >= TT) return false;
        int e = 0;
        while (e < NEXP - 1 && toff[e + 1] <= tm) ++e;
        u.pm = tm; u.pn = pn; u.aux = __builtin_amdgcn_readfirstlane(e); return true;
    }
    __device__ __forceinline__ const char* a_base(const pg8::Unit& u) const { return A + (size_t)u.pm * 256 * 1024 * 2; }
    __device__ __forceinline__ const char* b_base(const pg8::Unit& u) const { return B + (size_t)u.aux * bexp + (size_t)u.pn * 256 * 1024 * 2; }
};

typedef f32x4 AccT[2][2][4][2];
struct EpiProj {
    static constexpr bool PERM = true; bf16* P;
    __device__ __forceinline__ void operator()(const AccT& acc, const pg8::Unit& u, int wr, int wc, int fr, int fq) const {
        const int grp = u.pn >> 2;
        if (grp == 6) {
            const int b = u.pm / 9, s0 = (u.pm - 9 * b) * 256 + wr * 64 + fr; const int c0 = (u.pn & 3) * 256 + wc * 32 + 8 * fq;
            bf16* base = P + 6 * PSTR + (size_t)b * 1024 * SROW;
#pragma unroll
            for (int ai = 0; ai < 2; ++ai)
#pragma unroll
                for (int m = 0; m < 4; ++m) { const int s = s0 + ai * 128 + m * 16;
#pragma unroll
                    for (int bj = 0; bj < 2; ++bj)
#pragma unroll
                        for (int n = 0; n < 2; ++n)
#pragma unroll
                            for (int i = 0; i < 4; ++i) { const int c = c0 + bj * 128 + 4 * n + i; base[(size_t)c * SROW + s] = (bf16)f2bf(acc[ai][bj][m][n][i]); } }
            return;
        }
        const int row0 = u.pm * 256 + wr * 64 + fr; bf16* base = P + (size_t)grp * PSTR; const int col0 = (u.pn & 3) * 256 + wc * 32 + 8 * fq;
#pragma unroll
        for (int ai = 0; ai < 2; ++ai)
#pragma unroll
            for (int m = 0; m < 4; ++m) { bf16* rowp = base + (size_t)(row0 + ai * 128 + m * 16) * 1024 + col0;
#pragma unroll
                for (int bj = 0; bj < 2; ++bj) { const f32x4 v0 = acc[ai][bj][m][0], v1 = acc[ai][bj][m][1];
                    u32x4 w; w.x = pk2(v0[0], v0[1]); w.y = pk2(v0[2], v0[3]); w.z = pk2(v1[0], v1[1]); w.w = pk2(v1[2], v1[3]);
                    *(u32x4*)(rowp + bj * 128) = w; } }
    }
};
struct EpiBranch {
    static constexpr bool PERM = false; const bf16* G; float* M32; bf16* MB;
    __device__ __forceinline__ void operator()(const AccT& acc, const pg8::Unit& u, int wr, int wc, int fr, int fq) const {
        const int j = u.aux; const bf16* gate = G + (size_t)j * PSTR;
        const int row0 = u.pm * 256 + wr * 64 + fr, col0 = u.pn * 256 + wc * 32 + 4 * fq;
#pragma unroll
        for (int ai = 0; ai < 2; ++ai)
#pragma unroll
            for (int m = 0; m < 4; ++m) { const size_t ro = (size_t)(row0 + ai * 128 + m * 16) * 1024 + col0;
#pragma unroll
                for (int bj = 0; bj < 2; ++bj)
#pragma unroll
                    for (int n = 0; n < 2; ++n) { const size_t off = ro + bj * 128 + n * 16;
                        const u32x2 gw = *(const u32x2*)(gate + off);
                        f32x4 v = acc[ai][bj][m][n];
                        v[0] *= sigmoidf_(bflo(gw.x)); v[1] *= sigmoidf_(bfhi(gw.x)); v[2] *= sigmoidf_(bflo(gw.y)); v[3] *= sigmoidf_(bfhi(gw.y));
                        if (j == 0) { *(f32x4*)(M32 + off) = v; }
                        else { const f32x4 o = *(const f32x4*)(M32 + off) + v;
                            if (j == 1) *(f32x4*)(M32 + off) = o; else { u32x2 w; w.x = pk2(o[0], o[1]); w.y = pk2(o[2], o[3]); *(u32x2*)(MB + off) = w; } } } }
    }
};
struct EpiOut {
    static constexpr bool PERM = false; const float* xin_x; const float* xin_ctx; float* X; const float* modv_l; bool first;
    __device__ __forceinline__ void operator()(const AccT& acc, const pg8::Unit& u, int wr, int wc, int fr, int fq) const {
        const int b = u.pm / 9, jt = u.pm - 9 * b; const float* g1 = modv_l + (size_t)(jt == 0 ? 16 : b) * 6144 + 2 * 1024;
        const float* src = first ? (jt == 0 ? xin_ctx + (size_t)b * CTXL * 1024 : xin_x + ((size_t)b * SEQ + (size_t)(jt - 1) * 256) * 1024) : X + (size_t)u.pm * 256 * 1024;
        float* dst = X + (size_t)u.pm * 256 * 1024;
        const int lr0 = wr * 64 + fr, col0 = u.pn * 256 + wc * 32 + 4 * fq;
        f32x4 gv[2][2];
#pragma unroll
        for (int bj = 0; bj < 2; ++bj)
#pragma unroll
            for (int n = 0; n < 2; ++n) gv[bj][n] = *(const f32x4*)(g1 + col0 + bj * 128 + n * 16);
#pragma unroll
        for (int ai = 0; ai < 2; ++ai)
#pragma unroll
            for (int m = 0; m < 4; ++m) { const size_t ro = (size_t)(lr0 + ai * 128 + m * 16) * 1024 + col0;
#pragma unroll
                for (int bj = 0; bj < 2; ++bj)
#pragma unroll
                    for (int n = 0; n < 2; ++n) { const size_t off = ro + bj * 128 + n * 16; const f32x4 xo = *(const f32x4*)(src + off); *(f32x4*)(dst + off) = xo + gv[bj][n] * acc[ai][bj][m][n]; } }
    }
};
__device__ __forceinline__ float swiglu_(float gl, float li) { gl = fminf(gl, 7.0f); li = fminf(fmaxf(li, -7.0f), 7.0f); return gl * sigmoidf_(1.702f * gl) * (li + 1.0f); }
struct EpiUp {
    static constexpr bool PERM = true; bf16* ACT; const float* bup;
    __device__ __forceinline__ void operator()(const AccT& acc, const pg8::Unit& u, int wr, int wc, int fr, int fq) const {
        const float* bias = bup + (size_t)u.aux * 2048; const int row0 = u.pm * 256 + wr * 64 + fr, colb = u.pn * 256 + wc * 32 + 8 * fq;
        f32x4 bv[2][2];
#pragma unroll
        for (int bj = 0; bj < 2; ++bj)
#pragma unroll
            for (int n = 0; n < 2; ++n) bv[bj][n] = *(const f32x4*)(bias + colb + bj * 128 + 4 * n);
#pragma unroll
        for (int ai = 0; ai < 2; ++ai)
#pragma unroll
            for (int m = 0; m < 4; ++m) { bf16* rowp = ACT + (size_t)(row0 + ai * 128 + m * 16) * 1024 + (colb >> 1);
#pragma unroll
                for (int bj = 0; bj < 2; ++bj) { const f32x4 v0 = acc[ai][bj][m][0] + bv[bj][0], v1 = acc[ai][bj][m][1] + bv[bj][1];
                    u32x2 w; w.x = pk2(swiglu_(v0[0], v0[1]), swiglu_(v0[2], v0[3])); w.y = pk2(swiglu_(v1[0], v1[1]), swiglu_(v1[2], v1[3]));
                    *(u32x2*)(rowp + bj * 64) = w; } }
    }
};
struct EpiDown {
    static constexpr bool PERM = true; bf16* Y; const float* bdn; const float* roww;
    __device__ __forceinline__ void operator()(const AccT& acc, const pg8::Unit& u, int wr, int wc, int fr, int fq) const {
        const float* bias = bdn + (size_t)u.aux * 1024; const int row0 = u.pm * 256 + wr * 64 + fr, col0 = u.pn * 256 + wc * 32 + 8 * fq;
        f32x4 bv[2][2];
#pragma unroll
        for (int bj = 0; bj < 2; ++bj)
#pragma unroll
            for (int n = 0; n < 2; ++n) bv[bj][n] = *(const f32x4*)(bias + col0 + bj * 128 + 4 * n);
#pragma unroll
        for (int ai = 0; ai < 2; ++ai)
#pragma unroll
            for (int m = 0; m < 4; ++m) { const int row = row0 + ai * 128 + m * 16; const float w8 = roww[row]; bf16* rowp = Y + (size_t)row * 1024 + col0;
#pragma unroll
                for (int bj = 0; bj < 2; ++bj) { const f32x4 v0 = (acc[ai][bj][m][0] + bv[bj][0]) * w8, v1 = (acc[ai][bj][m][1] + bv[bj][1]) * w8;
                    u32x4 w; w.x = pk2(v0[0], v0[1]); w.y = pk2(v0[2], v0[3]); w.z = pk2(v1[0], v1[1]); w.w = pk2(v1[2], v1[3]);
                    *(u32x4*)(rowp + bj * 128) = w; } }
    }
};
#define XB_TMO      128
#define XB_XCNT(j)  (256  + 64 * (j))
#define XB_XSUB(j)  (1280 + 64 * (j))
#define XB_XGEN(j)  (2304 + 64 * (j))
#define XB_TOP      3328
#define XB_TOPGEN   3392
#define XCD_BAR_WORDS 3456
#define XB_SPIN_CAP (1u << 18)
__device__ __forceinline__ unsigned xb_ld(unsigned* p)              { return __hip_atomic_load(p, __ATOMIC_RELAXED, __HIP_MEMORY_SCOPE_AGENT); }
__device__ __forceinline__ unsigned xb_add(unsigned* p, unsigned v) { return __hip_atomic_fetch_add(p, v, __ATOMIC_RELAXED, __HIP_MEMORY_SCOPE_AGENT); }
__device__ __forceinline__ unsigned xb_xcc_id() { return (unsigned)__builtin_amdgcn_s_getreg((3 << 11) | 20) & 0xFu; }
#define XB_SPIN(cond, bar) do { unsigned _sp = 0; while (cond) { __builtin_amdgcn_s_sleep(1); \
    if ((++_sp & 255u) == 0u) { if (xb_ld(&(bar)[XB_TMO])) break; if (_sp > XB_SPIN_CAP) { atomicAdd(&(bar)[XB_TMO], 1u); break; } } } } while (0)
struct XcdBarrier { unsigned* bar; unsigned x; volatile LAS unsigned* st; };
__device__ __forceinline__ XcdBarrier xcd_barrier_post(unsigned* bar, volatile LAS unsigned* st) {
    XcdBarrier b; b.bar = bar; b.x = xb_xcc_id(); b.st = st;
    if (threadIdx.x == 0) (void)xb_add(&bar[XB_XCNT(b.x)], 1u);
    return b;
}
__device__ __forceinline__ void xcd_barrier_complete(unsigned* bar, unsigned x, unsigned& nloc, unsigned& nx) {
    const unsigned G = gridDim.x * gridDim.y * gridDim.z;
    unsigned sum, cnt, mine, sp = 0u;
    for (;;) {
        sum = 0u; cnt = 0u; mine = 0u;
#pragma unroll
        for (unsigned j = 0; j < 16; ++j) { const unsigned c = xb_ld(&bar[XB_XCNT(j)]); sum += c; cnt += (c > 0u) ? 1u : 0u; mine = (j == x) ? c : mine; }
        if (sum == G) break;
        __builtin_amdgcn_s_sleep(1);
        if ((++sp & 255u) == 0u) { if (xb_ld(&bar[XB_TMO])) break; if (sp > XB_SPIN_CAP) { atomicAdd(&bar[XB_TMO], 1u); break; } }
    }
    nloc = mine > 0u ? mine : 1u; nx = cnt > 0u ? cnt : 1u;
}
__device__ __forceinline__ void xcd_barrier(const XcdBarrier& b) {
    asm volatile("s_waitcnt vmcnt(0)" ::: "memory");
    __syncthreads();
    if (threadIdx.x == 0) {
        unsigned* bar = b.bar;
        __builtin_amdgcn_s_waitcnt(0);
        unsigned nloc = b.st[0], nx = b.st[1];
        if (nloc == 0u) { xcd_barrier_complete(bar, b.x, nloc, nx); b.st[0] = nloc; b.st[1] = nx; }
        const unsigned old = xb_add(&bar[XB_XSUB(b.x)], 1u);
        const unsigned gen = old / nloc;
        if (old + 1u == (gen + 1u) * nloc) {
            __builtin_amdgcn_fence(__ATOMIC_RELEASE, "agent");
            asm volatile("s_waitcnt vmcnt(0)" ::: "memory");
            const unsigned og = xb_add(&bar[XB_TOP], 1u);
            const unsigned tg = og / nx;
            if (og + 1u == (tg + 1u) * nx) xb_add(&bar[XB_TOPGEN], 1u);
            else XB_SPIN(xb_ld(&bar[XB_TOPGEN]) == tg, bar);
            __builtin_amdgcn_fence(__ATOMIC_ACQUIRE, "agent");
            xb_add(&bar[XB_XGEN(b.x)], 1u);
            asm volatile("s_waitcnt vmcnt(0)" ::: "memory");
        } else {
            XB_SPIN(xb_ld(&bar[XB_XGEN(b.x)]) == gen, bar);
            __builtin_amdgcn_fence(__ATOMIC_ACQUIRE, "agent");
            asm volatile("s_waitcnt vmcnt(0)" ::: "memory");
        }
    }
    __syncthreads();
}

struct Args {
    const float* in[28]; float* out; unsigned char* ws; int ph_lo, ph_hi;
};
struct Frame {
    LAS unsigned char* lds; volatile LAS unsigned* MISC; unsigned* ctl; unsigned char* ws;
    int vcu, G, c;
    const float* const* in;
};
#define PHASE_IDS() const int tid = opaque_tid(); const int lane = tid & 63; const int wave = __builtin_amdgcn_readfirstlane(tid >> 6); (void)lane; (void)wave
enum { I_X = 0, I_C, I_CTX, I_CCTX, I_WMOD, I_BMOD, I_N1G, I_N2G, I_WMIX, I_RDF, I_RDB, I_RPB, I_CONVW, I_CONVB, I_GAW, I_GAB, I_GXW, I_GXB, I_LAM, I_WBR, I_WOUT, I_WR, I_BR, I_WUP, I_BUP, I_WDN, I_BDN, I_FNG };

__device__ __forceinline__ void p0_transpose_item(const float* W, int N, bf16* WT, LAS float* scr, int item, int lane) {
    const int nblk = N / 32, kb = item / nblk, nb = item - kb * nblk, k0 = 64 * kb, n0 = 32 * nb;
#pragma unroll 8
    for (int i = 0; i < 32; ++i) { const int kk = 2 * i + (lane >> 5); scr[kk * 33 + (lane & 31)] = W[(size_t)(k0 + kk) * N + n0 + (lane & 31)]; }
    LDS_WAIT(); asm volatile("" ::: "memory");
    const int c = lane & 7;
#pragma unroll
    for (int j = 0; j < 4; ++j) { const int n = (lane >> 3) + 8 * j; const LAS float* s = scr + (8 * c) * 33 + n;
        u32x4 o; o.x = pk2(s[0 * 33], s[1 * 33]); o.y = pk2(s[2 * 33], s[3 * 33]); o.z = pk2(s[4 * 33], s[5 * 33]); o.w = pk2(s[6 * 33], s[7 * 33]);
        *(u32x4*)(WT + (size_t)(n0 + n) * 1024 + k0 + 8 * c) = o; }
    LDS_WAIT(); asm volatile("" ::: "memory");
}
__device__ __forceinline__ void p0_prologue(Frame& F, int nrep) {
    PHASE_IDS();
    {
        float2* rope = (float2*)(F.ws + WS_ROPE);
        const int gt = F.c * 512 + tid;
        if (gt < 96 * 32) { const int pos = gt >> 5, i = gt & 31; const float p = (float)(pos < 32 ? pos : pos - 32); const float inv = powf(10000.0f, -(float)i / 32.0f); const float a = p * inv; rope[gt] = make_float2(cosf(a), sinf(a)); }
    }
    if (F.c < 192) {
        LAS float* sil = (LAS float*)F.lds;
        LAS float* red = (LAS float*)(F.lds + 17 * 1024 * 4);
        for (int i = tid; i < 17 * 1024; i += 512) { const int b = i >> 10, k = i & 1023; const float v = b < 16 ? F.in[I_C][b * 1024 + k] : F.in[I_CCTX][k]; sil[i] = v * sigmoidf_(v); }
        __syncthreads();
        const int l = F.c / 96, cg = F.c - 96 * l; const float* wm = F.in[I_WMOD] + (size_t)l * 1024 * 6144 + 64 * cg + lane;
        float acc[17];
#pragma unroll
        for (int b = 0; b < 17; ++b) acc[b] = 0.f;
        const int kb = wave * 128;
#pragma unroll 4
        for (int kk = 0; kk < 128; ++kk) { const float wv = wm[(size_t)(kb + kk) * 6144];
#pragma unroll
            for (int b = 0; b < 17; ++b) acc[b] += sil[b * 1024 + kb + kk] * wv; }
#pragma unroll
        for (int b = 0; b < 17; ++b) red[(wave * 17 + b) * 64 + lane] = acc[b];
        __syncthreads();
        float* modv = (float*)(F.ws + WS_MODV);
        for (int i = tid; i < 17 * 64; i += 512) { const int b = i >> 6, n = i & 63; float s = 0.f;
#pragma unroll
            for (int w = 0; w < 8; ++w) s += red[(w * 17 + b) * 64 + n];
            const int col = 64 * cg + n; modv[((size_t)l * 17 + b) * 6144 + col] = s + F.in[I_BMOD][l * 6144 + col]; }
        __syncthreads();
    }
    LAS float* scr = (LAS float*)(F.lds + wave * 16384);
    const int gw = F.vcu * 8 + wave, NGW = F.G * 8;
    constexpr int I0 = 2 * 6144, I1 = I0 + 6 * 512, I2 = I1 + 2 * 512, I3 = I2 + 64 * 1024, I4 = I3 + 64 * 512;
    for (int rep = 0; rep < nrep; ++rep)
    for (int it = gw; it < I4; it += NGW) {
        if (it < I0) { const int mi = it / 6144, r = it - mi * 6144; p0_transpose_item(F.in[I_WMIX] + (size_t)mi * 1024 * 12288, 12288, (bf16*)(F.ws + WS_WMIX) + (size_t)mi * 12288 * 1024, scr, r, lane); }
        else if (it < I1) { const int q = it - I0, mi = q >> 9, r = q & 511; p0_transpose_item(F.in[I_WBR] + (size_t)mi * 1024 * 1024, 1024, (bf16*)(F.ws + WS_WBR) + (size_t)mi * 1024 * 1024, scr, r, lane); }
        else if (it < I2) { const int q = it - I1, mi = q >> 9, r = q & 511; p0_transpose_item(F.in[I_WOUT] + (size_t)mi * 1024 * 1024, 1024, (bf16*)(F.ws + WS_WOUT) + (size_t)mi * 1024 * 1024, scr, r, lane); }
        else if (it < I3) { const int q = it - I2, mi = q >> 10, r = q & 1023; p0_transpose_item(F.in[I_WUP] + (size_t)mi * 1024 * 2048, 2048, (bf16*)(F.ws + WS_WUP) + (size_t)mi * 2048 * 1024, scr, r, lane); }
        else { const int q = it - I3, mi = q >> 9, r = q & 511; p0_transpose_item(F.in[I_WDN] + (size_t)mi * 1024 * 1024, 1024, (bf16*)(F.ws + WS_WDN) + (size_t)mi * 1024 * 1024, scr, r, lane); }
    }
}

__device__ __forceinline__ float row_rstd(const f32x4 (&v)[4]) {
    float s = 0.f;
#pragma unroll
    for (int j = 0; j < 4; ++j) s += (v[j].x * v[j].x + v[j].y * v[j].y) + (v[j].z * v[j].z + v[j].w * v[j].w);
    return rsqrtf(wave_sum(s) * (1.0f / 1024.0f) + NORM_EPS);
}
__device__ __forceinline__ void modulate_row(f32x4 (&v)[4], const float* g, const float* sc, const float* sh, bf16* orow, int lane) {
    const float rstd = row_rstd(v);
#pragma unroll
    for (int j = 0; j < 4; ++j) { const int col = 4 * lane + 256 * j;
        const f32x4 g4 = *(const f32x4*)(g + col), s4 = *(const f32x4*)(sc + col), h4 = *(const f32x4*)(sh + col);
        v[j] = v[j] * rstd * g4 * (s4 + 1.0f) + h4;
        u32x2 w; w.x = pk2(v[j].x, v[j].y); w.y = pk2(v[j].z, v[j].w); *(u32x2*)(orow + col) = w; }
}
__device__ __forceinline__ const float* in_row(const float* x, const float* ctx, int r) { const int b = r / SROW, s = r - b * SROW; return s < CTXL ? ctx + ((size_t)b * CTXL + s) * D : x + ((size_t)b * SEQ + (s - CTXL)) * D; }
__device__ __forceinline__ void p1_norm1(Frame& F) {
    PHASE_IDS();
    const int gw = F.vcu * 8 + wave, NGW = F.G * 8;
    const float* modv = (const float*)(F.ws + WS_MODV); bf16* H = (bf16*)(F.ws + WS_H);
    for (int r = gw; r < NROWS; r += NGW) {
        const int b = r / SROW, s = r - b * SROW; const float* xr = in_row(F.in[I_X], F.in[I_CTX], r); const float* mv = modv + (size_t)(s < CTXL ? 16 : b) * 6144;
        f32x4 v[4];
#pragma unroll
        for (int j = 0; j < 4; ++j) v[j] = *(const f32x4*)(xr + 4 * lane + 256 * j);
        modulate_row(v, F.in[I_N1G], mv + 1024, mv, H + (size_t)r * 1024, lane);
    }
}
constexpr int WR_STRIDE = 1028;
constexpr int L6_WR = 0, L6_LCNT = 32 * WR_STRIDE * 4, L6_LBASE = L6_LCNT + 128, L6_TAB = L6_LBASE + 128, L6_MAXROWS = 160;
static_assert(L6_TAB + L6_MAXROWS * 48 <= LCTL_OFF, "router LDS");
__device__ __forceinline__ void p6_router(Frame& F, int l, bool lat) {
    PHASE_IDS();
    LAS float* WR = (LAS float*)(F.lds + L6_WR);
    volatile LAS int* LCNT = (volatile LAS int*)(F.lds + L6_LCNT); volatile LAS int* LBASE = (volatile LAS int*)(F.lds + L6_LBASE);
    LAS int* TAB = (LAS int*)(F.lds + L6_TAB);
    const float* wr = F.in[I_WR] + (size_t)l * 1024 * 32;
    for (int idx = tid; idx < 32768; idx += 512) { const int d = idx >> 5, e = idx & 31; WR[e * WR_STRIDE + d] = wr[idx]; }
    if (tid < 32) LCNT[tid] = 0;
    __syncthreads();
    const int RPW = (NROWS + F.G - 1) / F.G; const int rbeg = F.c * RPW; int nloc = NROWS - rbeg; nloc = nloc < 0 ? 0 : (nloc > RPW ? RPW : nloc);
    const float* modv = (const float*)(F.ws + WS_MODV) + (size_t)l * 17 * 6144; float* X = (float*)(F.ws + WS_X); bf16* H = (bf16*)(F.ws + WS_H);
    const float* n2g = F.in[I_N2G] + l * 1024; const float* brt = F.in[I_BR] + l * 32;
    const int el = (lane >> 1) & 31;
    for (int lr = wave; lr < nloc; lr += 8) {
        const int r = rbeg + lr; const int b = r / SROW, s = r - b * SROW;
        if (lat && s < CTXL) { if (lane < 4) TAB[(lr * 4 + lane) * 3] = -1; continue; }
        const float* mv = modv + (size_t)(s < CTXL ? 16 : b) * 6144;
        f32x4 v[4];
#pragma unroll
        for (int j = 0; j < 4; ++j) v[j] = *(const f32x4*)(X + (size_t)r * 1024 + 4 * lane + 256 * j);
        modulate_row(v, n2g, mv + 4 * 1024, mv + 3 * 1024, H + (size_t)r * 1024, lane);
        float p[32];
#pragma unroll
        for (int e = 0; e < 32; ++e) { float a = 0.f;
#pragma unroll
            for (int j = 0; j < 4; ++j) { const f32x4 w4 = *(const LAS f32x4*)(WR + e * WR_STRIDE + 256 * j + 4 * lane); a += (v[j].x * w4.x + v[j].y * w4.y) + (v[j].z * w4.z + v[j].w * w4.w); }
            p[e] = a; }
        float q16[16], q8[8], q4[4], q2[2], q1;
        { const bool hi = (lane & 32) != 0;
#pragma unroll
          for (int e = 0; e < 16; ++e) { const float keep = hi ? p[e + 16] : p[e], send = hi ? p[e] : p[e + 16]; q16[e] = keep + __shfl_xor(send, 32); } }
        { const bool hi = (lane & 16) != 0;
#pragma unroll
          for (int e = 0; e < 8; ++e) { const float keep = hi ? q16[e + 8] : q16[e], send = hi ? q16[e] : q16[e + 8]; q8[e] = keep + __shfl_xor(send, 16); } }
        { const bool hi = (lane & 8) != 0;
#pragma unroll
          for (int e = 0; e < 4; ++e) { const float keep = hi ? q8[e + 4] : q8[e], send = hi ? q8[e] : q8[e + 4]; q4[e] = keep + __shfl_xor(send, 8); } }
        { const bool hi = (lane & 4) != 0;
#pragma unroll
          for (int e = 0; e < 2; ++e) { const float keep = hi ? q4[e + 2] : q4[e], send = hi ? q4[e] : q4[e + 2]; q2[e] = keep + __shfl_xor(send, 4); } }
        { const bool hi = (lane & 2) != 0; const float keep = hi ? q2[1] : q2[0], send = hi ? q2[0] : q2[1]; q1 = keep + __shfl_xor(send, 2); }
        float val = q1 + __shfl_xor(q1, 1) + brt[el];
        int te[4]; float tv[4];
#pragma unroll
        for (int k = 0; k < 4; ++k) { const float m = wave_max(val); const unsigned long long mask = __ballot(val == m); const int fl = mask ? (int)__builtin_ctzll(mask) : 0;
            te[k] = (fl >> 1) & 31; tv[k] = m; if (el == te[k]) val = -INFINITY; }
        const float e1 = __expf(tv[1] - tv[0]), e2 = __expf(tv[2] - tv[0]), e3 = __expf(tv[3] - tv[0]); const float inv = 1.0f / (1.0f + e1 + e2 + e3);
        if (lane < 4) { const int ek = lane == 0 ? te[0] : lane == 1 ? te[1] : lane == 2 ? te[2] : te[3]; const float wk = (lane == 0 ? 1.0f : lane == 1 ? e1 : lane == 2 ? e2 : e3) * inv;
            const int pos = atomicAdd((int*)(LCNT + ek), 1);
            LAS int* t = TAB + (lr * 4 + lane) * 3; t[0] = ek; t[1] = pos; t[2] = __float_as_int(wk); }
    }
    __syncthreads();
    unsigned* cnt = F.ctl + CW_CNT + l * 64;
    if (tid < 32) LBASE[tid] = (int)atomicAdd(cnt + tid, (unsigned)LCNT[tid]);
    __syncthreads();
    int* toke = (int*)(F.ws + WS_TOKE); int* tokp = (int*)(F.ws + WS_TOKP); float* tokw = (float*)(F.ws + WS_TOKW);
    for (int idx = tid; idx < nloc * 4; idx += 512) { const LAS int* t = TAB + idx * 3; const int e = t[0]; const size_t o = (size_t)rbeg * 4 + idx;
        toke[o] = e; if (e >= 0) { tokp[o] = LBASE[e] + t[1]; tokw[o] = __int_as_float(t[2]); } }
    __syncthreads();
}
__device__ __forceinline__ void moe_toff(Frame& F, int l, volatile LAS int* toff) {
    PHASE_IDS();
    if (tid == 0) { unsigned* cnt = F.ctl + CW_CNT + l * 64; int a = 0;
        for (int e = 0; e < NEXP; ++e) { toff[e] = a; const int c = (int)__hip_atomic_load(cnt + e, RLX_AGENT); a += (c + 255) >> 8; }
        toff[NEXP] = a; }
    __syncthreads();
}
__device__ __forceinline__ void p6b_scatter(Frame& F, int l, bool lat) {
    PHASE_IDS();
    volatile LAS int* toff = (volatile LAS int*)(F.lds + LCTL_OFF + 256);
    moe_toff(F, l, toff);
    const int gw = F.vcu * 8 + wave, NGW = F.G * 8;
    const int* toke = (const int*)(F.ws + WS_TOKE); const int* tokp = (const int*)(F.ws + WS_TOKP); const float* tokw = (const float*)(F.ws + WS_TOKW);
    int* toks = (int*)(F.ws + WS_TOKS); float* roww = (float*)(F.ws + WS_ROWW);
    const bf16* H = (const bf16*)(F.ws + WS_H); bf16* H2S = (bf16*)(F.ws + WS_H2S);
    for (int r = gw; r < NROWS; r += NGW) {
        const int s = r % SROW; if (lat && s < CTXL) continue;
        const u32x4 h0 = *(const u32x4*)(H + (size_t)r * 1024 + 8 * lane), h1 = *(const u32x4*)(H + (size_t)r * 1024 + 512 + 8 * lane);
#pragma unroll
        for (int k = 0; k < 4; ++k) { const int e = toke[(size_t)r * 4 + k], pos = tokp[(size_t)r * 4 + k]; const int slot = toff[e] * 256 + pos;
            *(u32x4*)(H2S + (size_t)slot * 1024 + 8 * lane) = h0; *(u32x4*)(H2S + (size_t)slot * 1024 + 512 + 8 * lane) = h1;
            if (lane == 0) { roww[slot] = tokw[(size_t)r * 4 + k]; toks[(size_t)r * 4 + k] = slot; } }
    }
}
__device__ __forceinline__ void p9_combine(Frame& F, int l, bool last, float* out) {
    PHASE_IDS();
    const int gw = F.vcu * 8 + wave, NGW = F.G * 8;
    const int* toks = (const int*)(F.ws + WS_TOKS); const bf16* Y = (const bf16*)(F.ws + WS_H2S);
    float* X = (float*)(F.ws + WS_X); bf16* H = (bf16*)(F.ws + WS_H);
    const float* modv = (const float*)(F.ws + WS_MODV) + (size_t)l * 17 * 6144;
    for (int r = gw; r < NROWS; r += NGW) {
        const int b = r / SROW, s = r - b * SROW; if (last && s < CTXL) continue;
        const int mb = s < CTXL ? 16 : b; const float* g2 = modv + (size_t)mb * 6144 + 5 * 1024;
        f32x4 v[4], ys[4];
#pragma unroll
        for (int j = 0; j < 4; ++j) { v[j] = *(const f32x4*)(X + (size_t)r * 1024 + 4 * lane + 256 * j); ys[j] = (f32x4){0.f, 0.f, 0.f, 0.f}; }
#pragma unroll
        for (int k = 0; k < 4; ++k) { const int slot = toks[(size_t)r * 4 + k];
#pragma unroll
            for (int j = 0; j < 4; ++j) { const u32x2 w = *(const u32x2*)(Y + (size_t)slot * 1024 + 4 * lane + 256 * j); ys[j].x += bflo(w.x); ys[j].y += bfhi(w.x); ys[j].z += bflo(w.y); ys[j].w += bfhi(w.y); } }
#pragma unroll
        for (int j = 0; j < 4; ++j) v[j] = v[j] + *(const f32x4*)(g2 + 4 * lane + 256 * j) * ys[j];
        if (!last) {
#pragma unroll
            for (int j = 0; j < 4; ++j) *(f32x4*)(X + (size_t)r * 1024 + 4 * lane + 256 * j) = v[j];
            const float* mv = (const float*)(F.ws + WS_MODV) + ((size_t)(l + 1) * 17 + mb) * 6144;
            modulate_row(v, F.in[I_N1G] + (l + 1) * 1024, mv + 1024, mv, H + (size_t)r * 1024, lane);
        } else {
            const float rstd = row_rstd(v); float* orow = out + ((size_t)b * SEQ + (s - CTXL)) * 1024;
#pragma unroll
            for (int j = 0; j < 4; ++j) { const int col = 4 * lane + 256 * j; *(f32x4*)(orow + col) = v[j] * rstd * *(const f32x4*)(F.in[I_FNG] + col); }
        }
    }
}
__device__ __forceinline__ void chunk_of(int pass, int step, bool& isctx, int& cidx) { isctx = step < 4; cidx = pass == 0 ? (isctx ? step : step - 4) : (isctx ? 3 - step : 35 - step); }

constexpr int RS_Q = 272, RS_T = 144;
constexpr int LR_QS = 0, LR_KS = LR_QS + 64 * RS_Q, LR_KT = LR_KS + 64 * RS_Q, LR_VT = LR_KT + 128 * RS_T, LR_ST = LR_VT + 128 * RS_T, LR_SC = LR_ST + 128 * RS_Q, LR_END = LR_SC + 64 * RS_T;
static_assert(LR_END <= LCTL_OFF, "retention LDS");
__device__ __forceinline__ void ret_unit(Frame& F, int l, int b, int h, bool need_ctx) {
    LAS unsigned char* Qs = F.lds + LR_QS; LAS unsigned char* Ks = F.lds + LR_KS; LAS unsigned char* KT = F.lds + LR_KT; LAS unsigned char* VT = F.lds + LR_VT;
    LAS unsigned char* ST = F.lds + LR_ST; LAS unsigned char* Sc = F.lds + LR_SC; LAS unsigned char* Ys = Ks;
    const bf16* Pq = (const bf16*)(F.ws + WS_P) + 0 * PSTR + h * 128; const bf16* Pk = (const bf16*)(F.ws + WS_P) + 1 * PSTR + h * 128;
    const bf16* Pv = (const bf16*)(F.ws + WS_P) + 2 * PSTR + h * 128; const bf16* Pg = (const bf16*)(F.ws + WS_P) + 3 * PSTR + h * 128;
    bf16* AA = (bf16*)(F.ws + WS_AA) + h * 128;
    const float2* ropeR = (const float2*)(F.ws + WS_ROPE); const float2* ropeC = ropeR + 32 * 32;
    const float xf = F.in[I_RDF][l * 8 + h], xb = F.in[I_RDB][l * 8 + h];
    const float lf2 = -log1pf(expf(-xf)) * LOG2E, lb2 = -log1pf(expf(-xb)) * LOG2E;
    PHASE_IDS(); const int w = wave, fr = lane & 15, g = lane >> 4;
    const int rowb = b * SROW;
    for (int pass = 0; pass < 2; ++pass) {
        const float lg2 = pass ? lb2 : lf2; const float gC = fexp2(64.0f * lg2);
        f32x4 Sacc[8];
#pragma unroll
        for (int nd = 0; nd < 8; ++nd) Sacc[nd] = (f32x4){0.f, 0.f, 0.f, 0.f};
        __syncthreads();
        for (int i = tid; i < 128 * RS_Q / 4; i += 512) ((LAS unsigned*)ST)[i] = 0u;
        for (int step = 0; step < 36; ++step) {
            bool isctx; int cidx; chunk_of(pass, step, isctx, cidx);
            const int row0 = rowb + (isctx ? 64 * cidx : CTXL + 64 * cidx);
            const bool do_out = !isctx || need_ctx;
            {
                const int p = tid >> 3, sub = tid & 7, hf = sub >> 2, ig = sub & 3, d0 = 64 * hf + 8 * ig;
                const size_t ro = (size_t)(row0 + p) * 1024 + d0;
                const u32x4 ka = *(const u32x4*)(Pk + ro), kb = *(const u32x4*)(Pk + ro + 32);
                u32x4 qa = (u32x4){0u, 0u, 0u, 0u}, qb = qa;
                if (do_out) { qa = *(const u32x4*)(Pq + ro); qb = *(const u32x4*)(Pq + ro + 32); }
                float cs[8], sn[8];
                if (!isctx) { const float2* tab = (hf ? ropeC + p * 32 : ropeR + cidx * 32) + 8 * ig;
#pragma unroll
                    for (int e = 0; e < 8; ++e) { const float2 t = tab[e]; cs[e] = t.x; sn[e] = t.y; } }
                else {
#pragma unroll
                    for (int e = 0; e < 8; ++e) { cs[e] = 1.f; sn[e] = 0.f; } }
                float q1[8], q2[8], k1[8], k2[8];
#pragma unroll
                for (int e = 0; e < 8; ++e) { const float a = bfel(qa, e), c = bfel(qb, e); q1[e] = a * cs[e] - c * sn[e]; q2[e] = a * sn[e] + c * cs[e];
                    const float ak = bfel(ka, e), ck = bfel(kb, e); k1[e] = (ak * cs[e] - ck * sn[e]) * 0.08838834764831845f; k2[e] = (ak * sn[e] + ck * cs[e]) * 0.08838834764831845f; }
                if (do_out) {
                    u32x4 w1, w2;
                    w1.x = pk2(q1[0], q1[1]); w1.y = pk2(q1[2], q1[3]); w1.z = pk2(q1[4], q1[5]); w1.w = pk2(q1[6], q1[7]);
                    w2.x = pk2(q2[0], q2[1]); w2.y = pk2(q2[2], q2[3]); w2.z = pk2(q2[4], q2[5]); w2.w = pk2(q2[6], q2[7]);
                    *(LAS u32x4*)(Qs + p * RS_Q + d0 * 2) = w1; *(LAS u32x4*)(Qs + p * RS_Q + (d0 + 32) * 2) = w2;
                }
                u32x4 x1, x2;
                x1.x = pk2(k1[0], k1[1]); x1.y = pk2(k1[2], k1[3]); x1.z = pk2(k1[4], k1[5]); x1.w = pk2(k1[6], k1[7]);
                x2.x = pk2(k2[0], k2[1]); x2.y = pk2(k2[2], k2[3]); x2.z = pk2(k2[4], k2[5]); x2.w = pk2(k2[6], k2[7]);
                if (pass == 0 && do_out) { *(LAS u32x4*)(Ks + p * RS_Q + d0 * 2) = x1; *(LAS u32x4*)(Ks + p * RS_Q + (d0 + 32) * 2) = x2; }
#pragma unroll
                for (int e = 0; e < 8; ++e) { const unsigned a = x1[e >> 1], c = x2[e >> 1];
                    *(LAS unsigned short*)(KT + (d0 + e) * RS_T + p * 2) = (unsigned short)((e & 1) ? (a >> 16) : (a & 0xffffu));
                    *(LAS unsigned short*)(KT + (d0 + 32 + e) * RS_T + p * 2) = (unsigned short)((e & 1) ? (c >> 16) : (c & 0xffffu)); }
#pragma unroll
                for (int it2 = 0; it2 < 2; ++it2) { const int it = tid + 512 * it2, pv = it >> 4, vg = it & 15;
                    const u32x4 vv = *(const u32x4*)(Pv + (size_t)(row0 + pv) * 1024 + 8 * vg);
#pragma unroll
                    for (int e = 0; e < 8; ++e) { const unsigned a = vv[e >> 1]; *(LAS unsigned short*)(VT + (8 * vg + e) * RS_T + pv * 2) = (unsigned short)((e & 1) ? (a >> 16) : (a & 0xffffu)); } }
            }
            __syncthreads();
            if (pass == 0 && do_out) {
                const int mi = w >> 1;
#pragma unroll
                for (int t = 0; t < 2; ++t) { const int nj = 2 * (w & 1) + t; f32x4 acc = (f32x4){0.f, 0.f, 0.f, 0.f};
#pragma unroll
                    for (int ks = 0; ks < 4; ++ks) { const bf16x8 a = *(const LAS bf16x8*)(Qs + (16 * mi + fr) * RS_Q + (32 * ks + 8 * g) * 2), bb = *(const LAS bf16x8*)(Ks + (16 * nj + fr) * RS_Q + (32 * ks + 8 * g) * 2);
                        acc = MFMA16(a, bb, acc); }
#pragma unroll
                    for (int r = 0; r < 4; ++r) { const int i = 16 * mi + 4 * g + r, j = 16 * nj + fr, dd = i - j; const float dec = fexp2(dd >= 0 ? (float)dd * lf2 : (float)(-dd) * lb2);
                        *(LAS unsigned short*)(Sc + i * RS_T + j * 2) = (unsigned short)f2bf(acc[r] * dec); } }
            }
            __syncthreads();
            if (do_out) {
                const int mi = w >> 1, nd0 = 4 * (w & 1);
                f32x4 a1[4], a2[4];
#pragma unroll
                for (int t = 0; t < 4; ++t) { a1[t] = (f32x4){0.f, 0.f, 0.f, 0.f}; a2[t] = (f32x4){0.f, 0.f, 0.f, 0.f}; }
                if (pass == 0) {
#pragma unroll
                    for (int ks = 0; ks < 2; ++ks) { const bf16x8 a = *(const LAS bf16x8*)(Sc + (16 * mi + fr) * RS_T + (32 * ks + 8 * g) * 2);
#pragma unroll
                        for (int t = 0; t < 4; ++t) { const bf16x8 bb = *(const LAS bf16x8*)(VT + (16 * (nd0 + t) + fr) * RS_T + (32 * ks + 8 * g) * 2); a1[t] = MFMA16(a, bb, a1[t]); } }
                }
#pragma unroll
                for (int ks = 0; ks < 4; ++ks) { const bf16x8 a = *(const LAS bf16x8*)(Qs + (16 * mi + fr) * RS_Q + (32 * ks + 8 * g) * 2);
#pragma unroll
                    for (int t = 0; t < 4; ++t) { const bf16x8 bb = *(const LAS bf16x8*)(ST + (16 * (nd0 + t) + fr) * RS_Q + (32 * ks + 8 * g) * 2); a2[t] = MFMA16(a, bb, a2[t]); } }
#pragma unroll
                for (int r = 0; r < 4; ++r) { const int il = 16 * mi + 4 * g + r; const float xi = fexp2(pass == 0 ? (float)(il + 1) * lf2 : (float)(64 - il) * lb2);
#pragma unroll
                    for (int t = 0; t < 4; ++t) *(LAS unsigned short*)(Ys + il * RS_Q + (16 * (nd0 + t) + fr) * 2) = (unsigned short)f2bf(a1[t][r] + xi * a2[t][r]); }
            }
            {
                bf16x8 af[2];
#pragma unroll
                for (int ks = 0; ks < 2; ++ks) { const u32x4 kk = *(const LAS u32x4*)(KT + (16 * w + fr) * RS_T + (32 * ks + 8 * g) * 2); float z[8];
#pragma unroll
                    for (int e = 0; e < 8; ++e) { const int tok = 32 * ks + 8 * g + e; z[e] = bfel(kk, e) * fexp2(pass == 0 ? (float)(63 - tok) * lf2 : (float)tok * lb2); }
                    u32x4 o; o.x = pk2(z[0], z[1]); o.y = pk2(z[2], z[3]); o.z = pk2(z[4], z[5]); o.w = pk2(z[6], z[7]); af[ks] = __builtin_bit_cast(bf16x8, o); }
#pragma unroll
                for (int nd = 0; nd < 8; ++nd) { Sacc[nd] = Sacc[nd] * gC;
#pragma unroll
                    for (int ks = 0; ks < 2; ++ks) { const bf16x8 bb = *(const LAS bf16x8*)(VT + (16 * nd + fr) * RS_T + (32 * ks + 8 * g) * 2); Sacc[nd] = MFMA16(af[ks], bb, Sacc[nd]); } }
            }
            __syncthreads();
#pragma unroll
            for (int nd = 0; nd < 8; ++nd) { u32x2 o; o.x = pk2(Sacc[nd][0], Sacc[nd][1]); o.y = pk2(Sacc[nd][2], Sacc[nd][3]); *(LAS u32x2*)(ST + (16 * nd + fr) * RS_Q + (16 * w + 4 * g) * 2) = o; }
            if (do_out) {
                const int p = tid >> 3, sg = tid & 7; const size_t go = (size_t)(row0 + p) * 1024 + 16 * sg;
                const u32x4 y0 = *(const LAS u32x4*)(Ys + p * RS_Q + 32 * sg), y1 = *(const LAS u32x4*)(Ys + p * RS_Q + 32 * sg + 16);
                if (pass == 0) { *(u32x4*)(AA + go) = y0; *(u32x4*)(AA + go + 8) = y1; }
                else {
                    const u32x4 f0 = *(const u32x4*)(AA + go), f1 = *(const u32x4*)(AA + go + 8), g0 = *(const u32x4*)(Pg + go), g1 = *(const u32x4*)(Pg + go + 8);
                    float tv[16]; float ss = 0.f;
#pragma unroll
                    for (int e = 0; e < 8; ++e) { tv[e] = bfel(y0, e) + bfel(f0, e); tv[8 + e] = bfel(y1, e) + bfel(f1, e); ss += tv[e] * tv[e] + tv[8 + e] * tv[8 + e]; }
                    ss += __shfl_xor(ss, 1); ss += __shfl_xor(ss, 2); ss += __shfl_xor(ss, 4);
                    const float rstd = rsqrtf(ss * (1.0f / 128.0f) + NORM_EPS);
#pragma unroll
                    for (int e = 0; e < 8; ++e) { const float ga = bfel(g0, e), gb = bfel(g1, e); tv[e] *= rstd * ga * sigmoidf_(ga); tv[8 + e] *= rstd * gb * sigmoidf_(gb); }
                    u32x4 o0, o1;
                    o0.x = pk2(tv[0], tv[1]); o0.y = pk2(tv[2], tv[3]); o0.z = pk2(tv[4], tv[5]); o0.w = pk2(tv[6], tv[7]);
                    o1.x = pk2(tv[8], tv[9]); o1.y = pk2(tv[10], tv[11]); o1.z = pk2(tv[12], tv[13]); o1.w = pk2(tv[14], tv[15]);
                    *(u32x4*)(AA + go) = o0; *(u32x4*)(AA + go + 8) = o1;
                }
            }
            __syncthreads();
        }
    }
}
constexpr int NA_SC = 528, NA_SL = 1168;
constexpr int LN_VC = 0, LN_VL = LN_VC + 64 * NA_SC, LN_RPB = LN_VL + 64 * NA_SL, LN_END = LN_RPB + 512 * 4;
static_assert(LN_END <= LCTL_OFF, "NA LDS");
__device__ __forceinline__ int clampi(int v, int lo, int hi) { return v < lo ? lo : (v > hi ? hi : v); }
__device__ __forceinline__ void na_block(float (&s)[8], float& m, float& lsum, f32x4 (&O)[4], const LAS unsigned char* vt, int vstride, int key0, int fr, int g) {
    float mb = fmaxf(fmaxf(fmaxf(s[0], s[1]), fmaxf(s[2], s[3])), fmaxf(fmaxf(s[4], s[5]), fmaxf(s[6], s[7])));
    mb = fmaxf(mb, __shfl_xor(mb, 16)); mb = fmaxf(mb, __shfl_xor(mb, 32));
    const float mn = fmaxf(m, mb); const float alpha = fexp2(m - mn); m = mn;
    float ps = 0.f;
#pragma unroll
    for (int e = 0; e < 8; ++e) { s[e] = fexp2(s[e] - mn); ps += s[e]; }
    lsum = lsum * alpha + ps;
    u32x4 pw; pw.x = pk2(s[0], s[1]); pw.y = pk2(s[2], s[3]); pw.z = pk2(s[4], s[5]); pw.w = pk2(s[6], s[7]);
    const bf16x8 pf = __builtin_bit_cast(bf16x8, pw);
#pragma unroll
    for (int dt = 0; dt < 4; ++dt) { const LAS unsigned char* vp = vt + (16 * dt + fr) * vstride + (key0 + 4 * g) * 2;
        const u32x2 lo = *(const LAS u32x2*)vp, hi = *(const LAS u32x2*)(vp + 32);
        u32x4 vw; vw.x = lo.x; vw.y = lo.y; vw.z = hi.x; vw.w = hi.y;
        O[dt] = O[dt] * alpha; O[dt] = MFMA16(__builtin_bit_cast(bf16x8, vw), pf, O[dt]); }
}
constexpr int LN_KC = LN_RPB + 512 * 4, LN2_END = LN_KC + 256 * 144;
static_assert(LN2_END <= LCTL_OFF, "NA LDS");
__device__ __forceinline__ int na_hi(int rp) { return clampi(2 * rp - 3, 0, 24) + 7; }
__device__ __forceinline__ void na_unit(Frame& F, int l, int b, int h) {
    LAS unsigned char* VC = F.lds + LN_VC; LAS unsigned char* VL = F.lds + LN_VL; LAS float* RPB = (LAS float*)(F.lds + LN_RPB); LAS unsigned char* KC = F.lds + LN_KC;
    const bf16* Pq = (const bf16*)(F.ws + WS_P) + 4 * PSTR + h * 64; const bf16* Pk = (const bf16*)(F.ws + WS_P) + 5 * PSTR + h * 64;
    const bf16* VTG = (const bf16*)(F.ws + WS_P) + 6 * PSTR + (size_t)(b * 16 + h) * 64 * SROW;
    bf16* AB = (bf16*)(F.ws + WS_AA) + PSTR + h * 64;
    PHASE_IDS(); const int w = wave, fr = lane & 15, g = lane >> 4;
    const int rowb = b * SROW;
    __syncthreads();
#pragma unroll
    for (int i = 0; i < 4; ++i) { const int it = tid + 512 * i; const int key = it >> 3, ch = it & 7; *(LAS u32x4*)(KC + key * 144 + ch * 16) = *(const u32x4*)(Pk + (size_t)(rowb + key) * 1024 + 8 * ch); }
#pragma unroll
    for (int i = 0; i < 4; ++i) { const int it = tid + 512 * i; const int dh = it >> 5, ch = it & 31; *(LAS u32x4*)(VC + dh * NA_SC + ch * 16) = *(const u32x4*)(VTG + (size_t)dh * SROW + 8 * ch); }
    const int sdh = tid >> 3, sch = tid & 7;
#pragma unroll
    for (int R = 0; R < 8; ++R) *(LAS u32x4*)(VL + sdh * NA_SL + R * 128 + sch * 16) = *(const u32x4*)(VTG + (size_t)sdh * SROW + CTXL + R * 64 + 8 * sch);
    if (tid < 465) RPB[tid] = F.in[I_RPB][((size_t)l * 16 + h) * 465 + tid];
    const float qs = 0.125f * LOG2E;
    for (int rp = 0; rp < 16; ++rp) {
        u32x4 nr0 = (u32x4){0u, 0u, 0u, 0u}, nr1 = nr0; const int hcur = na_hi(rp), hnxt = rp < 15 ? na_hi(rp + 1) : hcur;
        if (hnxt > hcur) nr0 = *(const u32x4*)(VTG + (size_t)sdh * SROW + CTXL + (hcur + 1) * 64 + 8 * sch);
        if (hnxt > hcur + 1) nr1 = *(const u32x4*)(VTG + (size_t)sdh * SROW + CTXL + (hcur + 2) * 64 + 8 * sch);
        __syncthreads();
        const int ra = 2 * rp;
        const int qr = ra + (w >> 2), q0 = 16 * (w & 3); const int qrow = rowb + CTXL + qr * 64 + q0 + fr;
        bf16x8 qf[2];
#pragma unroll
        for (int ks = 0; ks < 2; ++ks) qf[ks] = *(const bf16x8*)(Pq + (size_t)qrow * 1024 + 32 * ks + 8 * g);
        float m = -INFINITY, lsum = 0.f; f32x4 O[4];
#pragma unroll
        for (int dt = 0; dt < 4; ++dt) O[dt] = (f32x4){0.f, 0.f, 0.f, 0.f};
        const int r0 = clampi(qr - 4, 0, 24), cspan = clampi(q0 - 8, 0, 32); const int cq = q0 + fr, wst = clampi(cq - 8, 0, 48);
        bf16x8 kf[4], kn[4];
#define NA_LOADK(dst, R_) do { _Pragma("unroll") for (int t = 0; t < 2; ++t) { const bf16* kp = Pk + (size_t)(rowb + CTXL + (R_) * 64 + cspan + 16 * t + fr) * 1024 + 8 * g; dst[2 * t] = *(const bf16x8*)kp; dst[2 * t + 1] = *(const bf16x8*)(kp + 32); } } while (0)
        NA_LOADK(kn, r0);
#pragma unroll 2
        for (int kb = 0; kb < 8; ++kb) {
            float s[8];
#pragma unroll
            for (int t = 0; t < 2; ++t) { const LAS unsigned char* kp = KC + (32 * kb + 16 * t + fr) * 144 + 16 * g;
                f32x4 a = (f32x4){0.f, 0.f, 0.f, 0.f};
                a = MFMA16(*(const LAS bf16x8*)kp, qf[0], a); a = MFMA16(*(const LAS bf16x8*)(kp + 64), qf[1], a);
#pragma unroll
                for (int r = 0; r < 4; ++r) s[4 * t + r] = a[r] * qs; }
            na_block(s, m, lsum, O, VC, NA_SC, 32 * kb, fr, g);
        }
#pragma unroll
        for (int kr = 0; kr < 8; ++kr) {
            const int R = r0 + kr; float s[8];
#pragma unroll
            for (int i = 0; i < 4; ++i) kf[i] = kn[i];
            if (kr < 7) NA_LOADK(kn, R + 1);
#pragma unroll
            for (int t = 0; t < 2; ++t) { f32x4 a = (f32x4){0.f, 0.f, 0.f, 0.f};
                a = MFMA16(kf[2 * t], qf[0], a); a = MFMA16(kf[2 * t + 1], qf[1], a);
#pragma unroll
                for (int r = 0; r < 4; ++r) { const int ck = cspan + 16 * t + 4 * g + r; const bool valid = (ck >= wst) && (ck < wst + 16);
                    const int bi = (R - qr + 7) * 31 + clampi(ck - cq + 15, 0, 30); const float bias = RPB[bi];
                    s[4 * t + r] = valid ? (a[r] * 0.125f + bias) * LOG2E : -INFINITY; } }
            na_block(s, m, lsum, O, VL, NA_SL, (R % 9) * 64 + cspan, fr, g);
        }
#undef NA_LOADK
        lsum += __shfl_xor(lsum, 16); lsum += __shfl_xor(lsum, 32);
        const float inv = 1.0f / lsum;
#pragma unroll
        for (int dt = 0; dt < 4; ++dt) { u32x2 o; o.x = pk2(O[dt][0] * inv, O[dt][1] * inv); o.y = pk2(O[dt][2] * inv, O[dt][3] * inv); *(u32x2*)(AB + (size_t)qrow * 1024 + 16 * dt + 4 * g) = o; }
        __syncthreads();
        if (hnxt > hcur) *(LAS u32x4*)(VL + sdh * NA_SL + ((hcur + 1) % 9) * 128 + sch * 16) = nr0;
        if (hnxt > hcur + 1) *(LAS u32x4*)(VL + sdh * NA_SL + ((hcur + 2) % 9) * 128 + sch * 16) = nr1;
    }
    __syncthreads();
}
constexpr int RS_UF = 528;
constexpr int LL_UB = 0, LL_UF = LL_UB + 64 * RS_Q, LL_HB = LL_UF + 64 * RS_UF, LL_CW = LL_HB + 64 * RS_UF, LL_END = LL_CW + 5 * 128 * 4;
static_assert(LL_END <= LCTL_OFF, "LRU LDS");
__device__ __forceinline__ float fsig(float x) { return __builtin_amdgcn_rcpf(1.0f + __builtin_amdgcn_exp2f(-x * LOG2E)); }
__device__ __forceinline__ float fgelu(float y) { const float z = 0.7978845608028654f * (y + 0.044715f * y * y * y); const float t = 1.0f - 2.0f * __builtin_amdgcn_rcpf(__builtin_amdgcn_exp2f(2.0f * LOG2E * z) + 1.0f); return 0.5f * y * (1.0f + t); }
template <int DIR> __device__ __forceinline__ void lru_scan(const float (&av)[4][4], const float (&bv)[4][4], float& hcar, LAS unsigned char* Hb, int co, int fr, int g) {
#pragma unroll
    for (int mi = 0; mi < 4; ++mi) { constexpr int dummy = 0; (void)dummy; const int mt = DIR == 0 ? mi : 3 - mi;
        float hl[4], cm[4]; float h_ = 0.f, c_ = 1.f;
#pragma unroll
        for (int ri = 0; ri < 4; ++ri) { const int r = DIR == 0 ? ri : 3 - ri; h_ = av[mt][r] * h_ + bv[mt][r]; c_ *= av[mt][r]; hl[r] = h_; cm[r] = c_; }
        float x = hcar, xin = hcar;
#pragma unroll
        for (int gi = 0; gi < 4; ++gi) { const int gg = DIR == 0 ? gi : 3 - gi; const float Pj = __shfl(c_, fr + 16 * gg), Hj = __shfl(h_, fr + 16 * gg); if (g == gg) xin = x; x = Pj * x + Hj; }
        hcar = x;
#pragma unroll
        for (int r = 0; r < 4; ++r) *(LAS float*)(Hb + (16 * mt + 4 * g + r) * RS_UF + co * 4) = hl[r] + cm[r] * xin; }
}
__device__ __forceinline__ void lru_unit(Frame& F, int l, int b, int kblk, bool need_ctx) {
    LAS unsigned char* Ub = F.lds + LL_UB; LAS unsigned char* Uf = F.lds + LL_UF; LAS unsigned char* Hb = F.lds + LL_HB; LAS float* CW = (LAS float*)(F.lds + LL_CW);
    const int ch0 = 128 * kblk;
    const bf16* Plx = (const bf16*)(F.ws + WS_P) + 7 * PSTR + ch0; const bf16* Ply = (const bf16*)(F.ws + WS_P) + 8 * PSTR + ch0;
    bf16* AC = (bf16*)(F.ws + WS_AA) + 2 * PSTR + ch0;
    PHASE_IDS(); const int w = wave, fr = lane & 15, g = lane >> 4;
    const int rowb = b * SROW;
    __syncthreads();
    for (int i = tid; i < 5 * 128; i += 512) { const int j = i >> 7, c = i & 127; CW[i] = j < 4 ? F.in[I_CONVW][((size_t)l * 4 + j) * 1024 + ch0 + c] : F.in[I_CONVB][(size_t)l * 1024 + ch0 + c]; }
    const int co = 16 * w + fr;
    const int p = tid >> 3, c0 = 16 * (tid & 7);
    for (int pass = 0; pass < 2; ++pass) {
        bf16x8 Bfa[4], Bfx[4];
        { const float* wa = F.in[I_GAW] + ((((size_t)l * 2 + pass) * 8 + kblk) * 128) * 128 + co; const float* wx = F.in[I_GXW] + ((((size_t)l * 2 + pass) * 8 + kblk) * 128) * 128 + co;
#pragma unroll
          for (int ks = 0; ks < 4; ++ks) { float ta[8], tx[8];
#pragma unroll
              for (int e = 0; e < 8; ++e) { const int ci = 32 * ks + 8 * g + e; ta[e] = wa[(size_t)ci * 128]; tx[e] = wx[(size_t)ci * 128]; }
              u32x4 oa, ox; oa.x = pk2(ta[0], ta[1]); oa.y = pk2(ta[2], ta[3]); oa.z = pk2(ta[4], ta[5]); oa.w = pk2(ta[6], ta[7]);
              ox.x = pk2(tx[0], tx[1]); ox.y = pk2(tx[2], tx[3]); ox.z = pk2(tx[4], tx[5]); ox.w = pk2(tx[6], tx[7]);
              Bfa[ks] = __builtin_bit_cast(bf16x8, oa); Bfx[ks] = __builtin_bit_cast(bf16x8, ox); } }
        const size_t vo = ((size_t)l * 2 + pass) * 1024 + ch0 + co;
        const float ba = F.in[I_GAB][vo], bx = F.in[I_GXB][vo]; const float nsp8 = -8.0f * LOG2E * log1pf(expf(-F.in[I_LAM][vo]));
        float hcar = 0.f;
        u32x4 xr[4][2];
#define LRU_LOAD_X(step_) do { bool ic_; int ci_; chunk_of(pass, (step_), ic_, ci_); const int sb_ = rowb + (ic_ ? 0 : CTXL), sl_ = ic_ ? CTXL : SEQ, tb_ = 64 * ci_; \
            _Pragma("unroll") for (int j = 0; j < 4; ++j) { const int tt = tb_ + p + j - 1; if (tt >= 0 && tt < sl_) { const bf16* xp = Plx + (size_t)(sb_ + tt) * 1024 + c0; xr[j][0] = *(const u32x4*)xp; xr[j][1] = *(const u32x4*)(xp + 8); } \
                else { xr[j][0] = (u32x4){0u, 0u, 0u, 0u}; xr[j][1] = (u32x4){0u, 0u, 0u, 0u}; } } } while (0)
        LRU_LOAD_X(0);
        for (int step = 0; step < 36; ++step) {
            bool isctx; int cidx; chunk_of(pass, step, isctx, cidx);
            const int segb = rowb + (isctx ? 0 : CTXL), t0 = 64 * cidx;
            const bool do_out = !isctx || need_ctx;
            const size_t go = (size_t)(segb + t0 + p) * 1024 + c0;
            { float u[16];
#pragma unroll
              for (int e = 0; e < 16; ++e) u[e] = CW[4 * 128 + c0 + e];
#pragma unroll
              for (int j = 0; j < 4; ++j) {
#pragma unroll
                  for (int e = 0; e < 8; ++e) { u[e] += CW[j * 128 + c0 + e] * bfel(xr[j][0], e); u[8 + e] += CW[j * 128 + c0 + 8 + e] * bfel(xr[j][1], e); } }
              u32x4 o0, o1; o0.x = pk2(u[0], u[1]); o0.y = pk2(u[2], u[3]); o0.z = pk2(u[4], u[5]); o0.w = pk2(u[6], u[7]);
              o1.x = pk2(u[8], u[9]); o1.y = pk2(u[10], u[11]); o1.z = pk2(u[12], u[13]); o1.w = pk2(u[14], u[15]);
              *(LAS u32x4*)(Ub + p * RS_Q + c0 * 2) = o0; *(LAS u32x4*)(Ub + p * RS_Q + c0 * 2 + 16) = o1;
#pragma unroll
              for (int q = 0; q < 4; ++q) *(LAS f32x4*)(Uf + p * RS_UF + (c0 + 4 * q) * 4) = (f32x4){u[4 * q], u[4 * q + 1], u[4 * q + 2], u[4 * q + 3]}; }
            if (step + 1 < 36) LRU_LOAD_X(step + 1);
            u32x4 pf0 = (u32x4){0u, 0u, 0u, 0u}, pf1 = pf0, py0 = pf0, py1 = pf0;
            if (pass == 1 && do_out) { pf0 = *(const u32x4*)(AC + go); pf1 = *(const u32x4*)(AC + go + 8); py0 = *(const u32x4*)(Ply + go); py1 = *(const u32x4*)(Ply + go + 8); }
            __syncthreads();
            float av[4][4], bv[4][4];
#pragma unroll
            for (int mt = 0; mt < 4; ++mt) { f32x4 ga = (f32x4){0.f, 0.f, 0.f, 0.f}, gx = ga;
#pragma unroll
                for (int ks = 0; ks < 4; ++ks) { const bf16x8 a = *(const LAS bf16x8*)(Ub + (16 * mt + fr) * RS_Q + (32 * ks + 8 * g) * 2); ga = MFMA16(a, Bfa[ks], ga); gx = MFMA16(a, Bfx[ks], gx); }
#pragma unroll
                for (int r = 0; r < 4; ++r) { const int tok = 16 * mt + 4 * g + r; const float rr = fsig(ga[r] + ba), ii = fsig(gx[r] + bx);
                    const float a_ = __builtin_amdgcn_exp2f(nsp8 * rr); const float uu = *(const LAS float*)(Uf + tok * RS_UF + co * 4);
                    av[mt][r] = a_; bv[mt][r] = __builtin_amdgcn_sqrtf(fmaxf(1.0f - a_ * a_, 0.f)) * ii * uu; } }
            if (pass == 0) lru_scan<0>(av, bv, hcar, Hb, co, fr, g); else lru_scan<1>(av, bv, hcar, Hb, co, fr, g);
            __syncthreads();
            if (do_out) { float hv[16];
#pragma unroll
                for (int q = 0; q < 4; ++q) { const f32x4 t = *(const LAS f32x4*)(Hb + p * RS_UF + (c0 + 4 * q) * 4); hv[4 * q] = t.x; hv[4 * q + 1] = t.y; hv[4 * q + 2] = t.z; hv[4 * q + 3] = t.w; }
                if (pass == 1) {
#pragma unroll
                    for (int e = 0; e < 8; ++e) { hv[e] = (hv[e] + bfel(pf0, e)) * fgelu(bfel(py0, e)); hv[8 + e] = (hv[8 + e] + bfel(pf1, e)) * fgelu(bfel(py1, e)); } }
                u32x4 o0, o1; o0.x = pk2(hv[0], hv[1]); o0.y = pk2(hv[2], hv[3]); o0.z = pk2(hv[4], hv[5]); o0.w = pk2(hv[6], hv[7]);
                o1.x = pk2(hv[8], hv[9]); o1.y = pk2(hv[10], hv[11]); o1.z = pk2(hv[12], hv[13]); o1.w = pk2(hv[14], hv[15]);
                *(u32x4*)(AC + go) = o0; *(u32x4*)(AC + go + 8) = o1; }
        }
#undef LRU_LOAD_X
        __syncthreads();
    }
}

__device__ __forceinline__ int queue_pop(Frame& F, unsigned* q) {
    __syncthreads();
    if (threadIdx.x == 0) F.MISC[0] = atomicAdd(q, 1u);
    __syncthreads();
    return (int)F.MISC[0];
}
#ifndef PHMASK
#define PHMASK 0xffff
#endif
#define PHM(b) ((PHMASK >> (b)) & 1)
__device__ __forceinline__ void p3_mixers(Frame& F, int l, bool need_ctx, int rep, int qmask) {
    unsigned* q = F.ctl + CW_Q + (l * 3 + rep * 6) * 64;
    if (PHM(3) && (qmask & 1)) for (;;) { const int u = queue_pop(F, q); if (u >= NB * 8) break; ret_unit(F, l, u >> 3, u & 7, need_ctx); }
    if (PHM(4) && (qmask & 2)) for (;;) { const int u = queue_pop(F, q + 64); if (u >= NB * 8) break; lru_unit(F, l, u >> 3, u & 7, need_ctx); }
    if (PHM(5) && (qmask & 4)) for (;;) { const int u = queue_pop(F, q + 128); if (u >= NB * 16) break; na_unit(F, l, u >> 4, u & 15); }
}
__global__ void __launch_bounds__(512, 2) fwd_kernel(Args args) {
    extern __shared__ __attribute__((aligned(16))) unsigned char lds[];
    Frame F;
    F.lds = (LAS unsigned char*)lds; F.MISC = (volatile LAS unsigned*)(F.lds + LCTL_OFF);
    F.G = gridDim.x; F.c = blockIdx.x; F.vcu = (F.G % 8 == 0) ? (F.c % 8) * (F.G / 8) + F.c / 8 : F.c;
    F.ws = args.ws; F.ctl = (unsigned*)(args.ws + WS_CTL); F.in = args.in;
    for (int u = threadIdx.x; u < (LDS_BYTES - LCTL_OFF) / 4; u += 512) ((LAS unsigned*)(F.lds + LCTL_OFF))[u] = 0u;
    __syncthreads();
    XcdBarrier bar; bar.bar = F.ctl + CW_BAR; bar.x = 0; bar.st = nullptr;
    if (!MK_PER_PHASE) bar = xcd_barrier_post(F.ctl + CW_BAR, F.MISC + 8);
    const int lo = args.ph_lo, hi = args.ph_hi;
#ifndef PHMASK
#define PHMASK 0xffff
#endif
#define PHM(b) ((PHMASK >> (b)) & 1)
#define IN(k) (lo <= (k) && (k) < hi)
#define SEAM(k) do { if (IN(k) && IN((k) + 1)) xcd_barrier(bar); } while (0)
    volatile LAS int* toff = (volatile LAS int*)(F.lds + LCTL_OFF + 256);

    if (PHM(0) && IN(0)) { p0_prologue(F, 1 + ((REP_MASK >> 2) & 1)); } SEAM(0);
    if (PHM(1) && IN(1)) { p1_norm1(F); } SEAM(1);
    for (int l = 0; l < DEPTH; ++l) {
        const int pb = 2 + 9 * l; const bool last = (l == DEPTH - 1);
        if (PHM(2) && IN(pb + 0)) {
            SchedDense S; S.init(F.ws + WS_H, F.ws + WS_WMIX + (size_t)l * 12288 * 1024 * 2, 1024, 48, false, F.G, F.c);
            EpiProj E{(bf16*)(F.ws + WS_P)};
            for (int rep = 0; rep < 1 + (REP_MASK & 1); ++rep) pg8::gemm_phase<EpiProj, SchedDense, true>(F.lds, 1024, S, E);
        } SEAM(pb + 0);
        if (IN(pb + 1)) { constexpr int nrep = 1 + (((REP_MASK >> 3) & 7) ? 1 : 0); for (int rep = 0; rep < nrep; ++rep) { p3_mixers(F, l, !last, rep, rep == 0 ? 7 : ((REP_MASK >> 3) & 7)); if (rep + 1 < nrep) xcd_barrier(bar); } } SEAM(pb + 1);
        if (PHM(6) && IN(pb + 2)) {
            SchedBranch S; S.init(F.ws + WS_AA, F.ws + WS_WBR + (size_t)l * 3 * 1024 * 1024 * 2, last, F.G, F.c);
            EpiBranch E{(const bf16*)(F.ws + WS_P) + 9 * PSTR, (float*)(F.ws + WS_M32), (bf16*)(F.ws + WS_MB)};
            for (int rep = 0; rep < 1 + (REP_MASK & 1); ++rep) pg8::gemm_phase<EpiBranch, SchedBranch, true>(F.lds, 1024, S, E);
        } SEAM(pb + 2);
        if (PHM(7) && IN(pb + 3)) {
            SchedDense S; S.init(F.ws + WS_MB, F.ws + WS_WOUT + (size_t)l * 1024 * 1024 * 2, 1024, 4, last, F.G, F.c);
            EpiOut E{F.in[I_X], F.in[I_CTX], (float*)(F.ws + WS_X), (const float*)(F.ws + WS_MODV) + (size_t)l * 17 * 6144, l == 0};
            pg8::gemm_phase<EpiOut, SchedDense, true>(F.lds, 1024, S, E);
        } SEAM(pb + 3);
        if (PHM(8) && IN(pb + 4)) { p6_router(F, l, last); } SEAM(pb + 4);
        if (PHM(9) && IN(pb + 5)) { p6b_scatter(F, l, last); } SEAM(pb + 5);
        if (PHM(10) && IN(pb + 6)) {
            moe_toff(F, l, toff);
            SchedMoE S; S.init(F.ws + WS_H2S, F.ws + WS_WUP + (size_t)l * 32 * 2048 * 1024 * 2, (size_t)2048 * 1024 * 2, toff, 8, F.G, F.c);
            EpiUp E{(bf16*)(F.ws + WS_ACT), F.in[I_BUP] + (size_t)l * 32 * 2048};
            for (int rep = 0; rep < 1 + (REP_MASK & 1); ++rep) pg8::gemm_phase<EpiUp, SchedMoE, true>(F.lds, 1024, S, E);
        } SEAM(pb + 6);
        if (PHM(11) && IN(pb + 7)) {
            moe_toff(F, l, toff);
            SchedMoE S; S.init(F.ws + WS_ACT, F.ws + WS_WDN + (size_t)l * 32 * 1024 * 1024 * 2, (size_t)1024 * 1024 * 2, toff, 4, F.G, F.c);
            EpiDown E{(bf16*)(F.ws + WS_H2S), F.in[I_BDN] + (size_t)l * 32 * 1024, (const float*)(F.ws + WS_ROWW)};
            for (int rep = 0; rep < 1 + (REP_MASK & 1); ++rep) pg8::gemm_phase<EpiDown, SchedMoE, true>(F.lds, 1024, S, E);
        } SEAM(pb + 7);
        if (PHM(12) && IN(pb + 8)) { p9_combine(F, l, last, args.out); } SEAM(pb + 8);
    }
#undef IN
#undef SEAM
}

extern "C" void kernel_launch(void* const* d_in, const int* in_sizes, int n_in, void* d_out, int out_size, void* d_ws, size_t ws_size, hipStream_t stream) {
    static int grid = 0;
    if (grid == 0) {
        if (n_in != 28 || ws_size < WS_END) { fprintf(stderr, "kernel_launch: expected 28 inputs and >= %zu bytes of workspace; got %d, %zu\n", (size_t)WS_END, n_in, ws_size); grid = -1; return; }
        int dev = 0, cus = 0, per_cu = 0;
        if (hipGetDevice(&dev) != hipSuccess || hipDeviceGetAttribute(&cus, hipDeviceAttributeMultiprocessorCount, dev) != hipSuccess) { grid = -1; return; }
        if (hipFuncSetAttribute((const void*)fwd_kernel, hipFuncAttributeMaxDynamicSharedMemorySize, LDS_BYTES) != hipSuccess) { fprintf(stderr, "kernel_launch: hipFuncSetAttribute failed\n"); grid = -1; return; }
        if (hipOccupancyMaxActiveBlocksPerMultiprocessor(&per_cu, (const void*)fwd_kernel, 512, LDS_BYTES) != hipSuccess || per_cu < 1) fprintf(stderr, "kernel_launch: occupancy query reports %d\n", per_cu);
        (void)hipGetLastError();
        grid = cus > 256 ? 256 : cus;
    }
    if (grid < 0) return;
    if (hipMemsetAsync((char*)d_ws + WS_CTL, 0, CTL_ZERO_BYTES, stream) != hipSuccess) return;
    Args a{};
    for (int i = 0; i < 28; ++i) a.in[i] = (const float*)d_in[i];
    a.out = (float*)d_out; a.ws = (unsigned char*)d_ws;
#if MK_PER_PHASE
    for (int p = 0; p < N_PHASES; ++p) { a.ph_lo = p; a.ph_hi = p + 1; hipLaunchKernelGGL(fwd_kernel, dim3(grid), dim3(512), LDS_BYTES, stream, a); }
#else
    a.ph_lo = 0; a.ph_hi = N_PHASES;
    hipLaunchKernelGGL(fwd_kernel, dim3(grid), dim3(512), LDS_BYTES, stream, a);
#endif
    const hipError_t le = hipPeekAtLastError();
    if (le != hipSuccess) fprintf(stderr, "kernel_launch: launch failed: %s\n", hipGetErrorName(le));
}
```

```cpp
#include <hip/hip_runtime.h>
#include <cstdio>
#include <cstdint>

#define GAS __attribute__((address_space(1)))
#define LAS __attribute__((address_space(3)))
typedef unsigned short bf16;
typedef short bf16x8 __attribute__((ext_vector_type(8)));
typedef float f32x4 __attribute__((ext_vector_type(4)));
typedef float f32x2 __attribute__((ext_vector_type(2)));
typedef unsigned u32x4 __attribute__((ext_vector_type(4)));
typedef unsigned u32x2 __attribute__((ext_vector_type(2)));
typedef GAS unsigned gu32;

constexpr int D = 1024, NB = 16, SEQ = 2048, CTXL = 256, SROW = CTXL + SEQ, NROWS = NB * SROW, DEPTH = 2;
constexpr int INW = 12288, NEXP = 32, DEXP = 1024;
constexpr size_t PSTR = (size_t)NROWS * 1024;
constexpr int MAXSORT = NROWS * 4 + NEXP * 256;
constexpr float NORM_EPS = 1e-6f;
constexpr float LOG2E = 1.4426950408889634f;

constexpr size_t MiB = 1u << 20;
constexpr size_t WS_CTL = 0, CTL_ZERO_BYTES = 1 * MiB;
constexpr size_t WS_MODV = 1 * MiB;
constexpr size_t WS_ROPE = 2 * MiB;
constexpr size_t WS_TOKE = 3 * MiB, WS_TOKP = 4 * MiB, WS_TOKW = 5 * MiB;
constexpr size_t WS_WMIX = 8 * MiB;
constexpr size_t WS_WBR = 56 * MiB;
constexpr size_t WS_WOUT = 68 * MiB;
constexpr size_t WS_WUP = 72 * MiB;
constexpr size_t WS_WDN = 328 * MiB;
constexpr size_t WS_X = 456 * MiB;
constexpr size_t WS_H = 600 * MiB;
constexpr size_t WS_P = 672 * MiB;
constexpr size_t WS_AA = 1536 * MiB;
constexpr size_t WS_END = 1752 * MiB;
constexpr size_t WS_ROWMAP = WS_P + 10 * 72 * MiB;
constexpr size_t WS_ROWW = WS_ROWMAP + 8 * MiB;
constexpr size_t WS_M32 = WS_P;
constexpr size_t WS_MB = WS_P + 2 * 72 * MiB;
constexpr size_t WS_ACT = WS_P;
constexpr size_t WS_H2S = WS_P + 5 * 72 * MiB;
static_assert(PSTR * 2 == 72 * MiB && (size_t)MAXSORT * 2048 == 304 * MiB && WS_H2S + 304 * MiB <= WS_AA, "ws map");
constexpr int CW_TMO = 0, CW_BAR = 4096, CW_Q = 8192, CW_CNT = 10240;
constexpr int LDS_BYTES = 163840, LCTL_OFF = 162816;
constexpr int N_PHASES = 20;
#ifndef REP_MASK
#define REP_MASK 0
#endif
#ifndef MK_PER_PHASE
#define MK_PER_PHASE 0
#endif

__device__ __forceinline__ float bflo(unsigned w) { return __uint_as_float(w << 16); }
__device__ __forceinline__ float bfhi(unsigned w) { return __uint_as_float(w & 0xffff0000u); }
__device__ __forceinline__ float xrow_max(float x) {
    { const auto r = __builtin_amdgcn_permlane16_swap(__float_as_uint(x), __float_as_uint(x), false, false); x = fmaxf(__uint_as_float(r[0]), __uint_as_float(r[1])); }
    { const auto r = __builtin_amdgcn_permlane32_swap(__float_as_uint(x), __float_as_uint(x), false, false); x = fmaxf(__uint_as_float(r[0]), __uint_as_float(r[1])); }
    return x;
}
__device__ __forceinline__ float xrow_sum(float x) {
    { const auto r = __builtin_amdgcn_permlane16_swap(__float_as_uint(x), __float_as_uint(x), false, false); x = __uint_as_float(r[0]) + __uint_as_float(r[1]); }
    { const auto r = __builtin_amdgcn_permlane32_swap(__float_as_uint(x), __float_as_uint(x), false, false); x = __uint_as_float(r[0]) + __uint_as_float(r[1]); }
    return x;
}
#define PIN4(a, b, c, d) asm volatile("" : "+v"(a), "+v"(b), "+v"(c), "+v"(d))
#define PIN8(a, b, c, d, e, f, g, h) asm volatile("" : "+v"(a), "+v"(b), "+v"(c), "+v"(d), "+v"(e), "+v"(f), "+v"(g), "+v"(h))
__device__ __forceinline__ f32x4 bf4(const u32x2& w) { return (f32x4){bflo(w.x), bfhi(w.x), bflo(w.y), bfhi(w.y)}; }
__device__ __forceinline__ float bfel(const u32x4& w, int e) { const unsigned x = w[e >> 1]; return (e & 1) ? bfhi(x) : bflo(x); }
__device__ __forceinline__ unsigned f2bf(float f) { unsigned u = __float_as_uint(f); return (u + 0x7fffu + ((u >> 16) & 1u)) >> 16; }
typedef __bf16 bf16x2_t __attribute__((ext_vector_type(2)));
__device__ __forceinline__ unsigned pk2(float lo, float hi) { const f32x2 v = {lo, hi}; return __builtin_bit_cast(unsigned, __builtin_convertvector(v, bf16x2_t)); }
__device__ __forceinline__ float wave_sum(float v) {
#pragma unroll
    for (int o = 1; o < 64; o <<= 1) v += __shfl_xor(v, o);
    return v;
}
__device__ __forceinline__ float wave_max(float v) {
#pragma unroll
    for (int o = 1; o < 64; o <<= 1) v = fmaxf(v, __shfl_xor(v, o));
    return v;
}
__device__ __forceinline__ float fexp2(float x) { return __builtin_amdgcn_exp2f(x); }
__device__ __forceinline__ float sigmoidf_(float x) { return __builtin_amdgcn_rcpf(1.0f + __builtin_amdgcn_exp2f(-x * LOG2E)); }
__device__ __forceinline__ float gelu_tanh(float y) { const float z = 0.7978845608028654f * (y + 0.044715f * y * y * y); const float t = 1.0f - 2.0f / (__expf(2.0f * z) + 1.0f); return 0.5f * y * (1.0f + t); }
#define LDS_WAIT() asm volatile("s_waitcnt lgkmcnt(0)" ::: "memory")
#define VM_WAIT() asm volatile("s_waitcnt vmcnt(0)" ::: "memory")
#define RLX_AGENT __ATOMIC_RELAXED, __HIP_MEMORY_SCOPE_AGENT
#define MFMA16(a, b, c) __builtin_amdgcn_mfma_f32_16x16x32_bf16((a), (b), (c), 0, 0, 0)
__device__ __forceinline__ int opaque_tid() { int t = threadIdx.x; asm volatile("" : "+v"(t)); return t; }
typedef int i32x4v __attribute__((ext_vector_type(4)));
typedef int i32x8v __attribute__((ext_vector_type(8)));
__device__ __forceinline__ unsigned pk4_fp8(float a, float b, float c, float d) { int p = 0; p = __builtin_amdgcn_cvt_pk_fp8_f32(a, b, p, false); p = __builtin_amdgcn_cvt_pk_fp8_f32(c, d, p, true); return (unsigned)p; }
constexpr float W8_SCALE = 32.0f, ACT8_SCALE = 4.0f, Y8_SCALE = 16.0f;
constexpr int E8_ONE = 0x7F7F7F7F, E8_W = 0x7A7A7A7A, E8_ACT = 0x7D7D7D7D;
#ifndef RELAX_EPI
#define RELAX_EPI 0
#endif
#ifndef STAGGER_TICKS
#define STAGGER_TICKS 0
#endif
namespace pg8 {
#define PG8_LAS __attribute__((address_space(3)))
constexpr int BM = 256, BK = 64, HALF = 128, HTB = HALF * BK * 2, STAGE_BYTES = 8 * HTB, NXCD = 8, WGM = 8;
__host__ __device__ __forceinline__ int lds_byte(int r, int c) { const int st = (r >> 4) * 2 + (c >> 5), rr = r & 15, cc = c & 31, ob = rr * 64 + cc * 2; return st * 1024 + (ob ^ (((ob >> 9) & 1) << 5)); }
__host__ __device__ __forceinline__ void stage_rc(int b, int& R, int& C) { const int st = b / 1024, sb = b % 1024, swz = sb ^ (((sb >> 9) & 1) << 5); R = (st >> 1) * 16 + swz / 64; C = (st & 1) * 32 + (swz % 64) / 2; }
__host__ __device__ __forceinline__ int perm32(int rho) { const int n = rho >> 4, i = rho & 15; return 8 * (i >> 2) + 4 * n + (i & 3); }
struct Unit { int pm, pn, aux, lt; };
struct StaticOrder {
    int nM, nN, nwg, G, c;
    __device__ __forceinline__ void init(int nM_, int nN_, int G_, int c_) { nM = nM_; nN = nN_; nwg = nM * nN; G = G_; c = c_; }
    __device__ __forceinline__ bool next(int i, int& pm, int& pn) const {
        const long L = (long)i * G + c; if (L >= nwg) return false;
        int wgid = (int)L; { const int q = nwg / NXCD, r = nwg % NXCD, xcd = wgid % NXCD, off = wgid / NXCD; wgid = (xcd < r ? xcd * (q + 1) : r * (q + 1) + (xcd - r) * q) + off; }
        const int nig = WGM * nN, gid = wgid / nig, fm = gid * WGM, gsz = (nM - fm) < WGM ? (nM - fm) : WGM;
        pm = fm + ((wgid % nig) % gsz); pn = (wgid % nig) / gsz; return true;
    }
};
template <class Epi, class Sched, bool ALIGN_EPI>
__device__ __forceinline__ void gemm_phase(PG8_LAS unsigned char* lds, const int K, const Sched& S, const Epi& E) {
    const int tid = opaque_tid(), wid = __builtin_amdgcn_readfirstlane(tid >> 6), lane = tid & 63, wr = wid >> 2, wc = wid & 3, fr = lane & 15, fq = lane >> 4;
    const int nt = K / BK;
    constexpr int NE = Epi::NST < 48 ? Epi::NST : 48;
    unsigned voffA[2], voffB[2];
#pragma unroll
    for (int i = 0; i < 2; ++i) { int R, C; stage_rc(tid * 16 + i * 8192, R, C); const int Rb = Epi::PERM ? ((R & ~31) + perm32(R & 31)) : R;
        voffA[i] = (unsigned)(R * K + C) * 2u; voffB[i] = (unsigned)(Rb * K + C) * 2u; }
    unsigned cao[2][2], nao[2][2];
#define PG8_GMAP_ISSUE(u_) do { _Pragma("unroll") for (int h_ = 0; h_ < 2; ++h_) _Pragma("unroll") for (int i_ = 0; i_ < 2; ++i_) \
        { int R_, C_; int t_ = opaque_tid(); stage_rc(t_ * 16 + i_ * 8192, R_, C_); __builtin_amdgcn_global_load_lds((const unsigned*)S.row_ptr((u_), h_ * 128 + R_), (PG8_LAS unsigned*)(lds + Sched::GMAP_OFF + wid * 1024 + (h_ * 2 + i_) * 256), 4, 0, 0); } } while (0)
#define PG8_GMAP_READ(dst, u_) do { _Pragma("unroll") for (int h_ = 0; h_ < 2; ++h_) _Pragma("unroll") for (int i_ = 0; i_ < 2; ++i_) { \
        int R_, C_; int t_ = opaque_tid(); stage_rc(t_ * 16 + i_ * 8192, R_, C_); \
        const unsigned tok_ = *(const volatile PG8_LAS unsigned*)(lds + Sched::GMAP_OFF + wid * 1024 + (h_ * 2 + i_) * 256 + (t_ & 63) * 4); \
        dst[h_][i_] = (S.row_valid((u_), h_ * 128 + R_) ? tok_ : 0u) * (unsigned)(K * 2) + (unsigned)(C_ * 2); } } while (0)
    const size_t kstep = (size_t)(BK * 2);
    const size_t hstep = (size_t)HALF * K * 2;
    const unsigned ldsw = (unsigned)wid * 1024u;
    const int aoff = lds_byte(wr * 64 + fr, fq * 8), boff = lds_byte(wc * 32 + fr, fq * 8);
#define PG8_SA(b, h) (((b) * 2 + (h)) * HTB)
#define PG8_SB(b, h) ((4 + (b) * 2 + (h)) * HTB)
#define PG8_STAGE(bufoff, gbase, voff) do { _Pragma("unroll") for (int _i = 0; _i < 2; ++_i) \
        __builtin_amdgcn_global_load_lds((const unsigned*)((const char*)(gbase) + (voff)[_i]), (PG8_LAS unsigned*)(lds + (bufoff) + ldsw + _i * 8192), 16, 0, 0); } while (0)
#define PG8_LDA(dst, b, h) do { if constexpr (Sched::FP8) { _Pragma("unroll") for (int m = 0; m < 4; ++m) { const i32x4v lo_ = *(const PG8_LAS i32x4v*)(lds + PG8_SA(b, h) + aoff + m * 2048), hi_ = *(const PG8_LAS i32x4v*)(lds + PG8_SA(b, h) + aoff + m * 2048 + 1024); \
            dst##8[m] = __builtin_shufflevector(lo_, hi_, 0, 1, 2, 3, 4, 5, 6, 7); } } \
        else { _Pragma("unroll") for (int m = 0; m < 4; ++m) _Pragma("unroll") for (int k = 0; k < 2; ++k) dst[m][k] = *(const PG8_LAS bf16x8*)(lds + PG8_SA(b, h) + aoff + m * 2048 + k * 1024); } } while (0)
#define PG8_LDB(dst, b, h) do { if constexpr (Sched::FP8) { _Pragma("unroll") for (int n = 0; n < 2; ++n) { const i32x4v lo_ = *(const PG8_LAS i32x4v*)(lds + PG8_SB(b, h) + boff + n * 2048), hi_ = *(const PG8_LAS i32x4v*)(lds + PG8_SB(b, h) + boff + n * 2048 + 1024); \
            dst##8[n] = __builtin_shufflevector(lo_, hi_, 0, 1, 2, 3, 4, 5, 6, 7); } } \
        else { _Pragma("unroll") for (int n = 0; n < 2; ++n) _Pragma("unroll") for (int k = 0; k < 2; ++k) dst[n][k] = *(const PG8_LAS bf16x8*)(lds + PG8_SB(b, h) + boff + n * 2048 + k * 1024); } } while (0)
#define PG8_MMA(ai, bj, At, Bt) do { __builtin_amdgcn_s_setprio(1); \
        if constexpr (Sched::FP8) { _Pragma("unroll") for (int m = 0; m < 4; ++m) _Pragma("unroll") for (int n = 0; n < 2; ++n) \
            asm volatile("v_mfma_scale_f32_16x16x128_f8f6f4 %0, %1, %2, %0, %3, %4 op_sel_hi:[0,0,0]" : "+v"(acc[ai][bj][m][n]) : "v"(Bt##8[n]), "v"(At##8[m]), "v"(e8b_), "v"(e8a_)); } \
        else { _Pragma("unroll") for (int m = 0; m < 4; ++m) _Pragma("unroll") for (int n = 0; n < 2; ++n) _Pragma("unroll") for (int k = 0; k < 2; ++k) \
            acc[ai][bj][m][n] = __builtin_amdgcn_mfma_f32_16x16x32_bf16(Bt[n][k], At[m][k], acc[ai][bj][m][n], 0, 0, 0); } \
        __builtin_amdgcn_s_setprio(0); } while (0)
#define PG8_WAIT_V(n) asm volatile("s_waitcnt vmcnt(" #n ")" ::: "memory")
#define PG8_WAIT_VN(N) asm volatile("s_waitcnt vmcnt(%0)" :: "n"(N) : "memory")
#define PG8_WAIT_L(n) asm volatile("s_waitcnt lgkmcnt(" #n ")" ::: "memory")
#define PG8_BAR __builtin_amdgcn_s_barrier()
#define PG8_SCHED __builtin_amdgcn_sched_barrier(0)
    Unit cur, nxt; int ui = 0;
    if (!S.next(0, cur)) return;
    if (STAGGER_TICKS > 0) {
        const unsigned long long t0 = __builtin_amdgcn_s_memrealtime(); const unsigned long long dl = (unsigned long long)((blockIdx.x >> 3) & 15) * STAGGER_TICKS;
        while (__builtin_amdgcn_s_memrealtime() - t0 < dl) __builtin_amdgcn_s_sleep(16);
    }
    f32x4 acc[2][2][4][2];
#pragma unroll
    for (int a = 0; a < 2; ++a)
#pragma unroll
        for (int b = 0; b < 2; ++b)
#pragma unroll
            for (int m = 0; m < 4; ++m)
#pragma unroll
                for (int n = 0; n < 2; ++n) acc[a][b][m][n] = (f32x4){0.f, 0.f, 0.f, 0.f};
    bf16x8 At[4][2], B0[2][2], B1[2][2]; i32x8v At8[4], B08[2], B18[2]; const int e8a_ = Sched::E8_A, e8b_ = Sched::E8_B; (void)e8a_; (void)e8b_;
    const char* cA = S.a_base(cur); const char* cB = S.b_base(cur);
    if constexpr (Sched::GATHER) { PG8_GMAP_ISSUE(cur); asm volatile("s_waitcnt vmcnt(0)" ::: "memory"); PG8_GMAP_READ(cao, cur); }
#define PG8_STAGE_A(bufoff, h, ptr, kb, useN) do { if constexpr (Sched::GATHER) { unsigned so_[2]; so_[0] = (useN) ? nao[h][0] : cao[h][0]; so_[1] = (useN) ? nao[h][1] : cao[h][1]; PG8_STAGE(bufoff, S.a_gather_base() + (kb), so_); } \
        else { PG8_STAGE(bufoff, ptr, voffA); } } while (0)
    PG8_STAGE(PG8_SB(0, 0), cB, voffB); PG8_STAGE(PG8_SB(0, 1), cB + hstep, voffB); PG8_STAGE_A(PG8_SA(0, 0), 0, cA, 0, false); PG8_STAGE_A(PG8_SA(0, 1), 1, cA + hstep, 0, false);
    if (wr == 1) PG8_BAR;
    PG8_WAIT_V(2); PG8_BAR;
    PG8_STAGE(PG8_SB(1, 0), cB + kstep, voffB); PG8_STAGE_A(PG8_SA(1, 0), 0, cA + kstep, kstep, false); PG8_STAGE(PG8_SB(1, 1), cB + hstep + kstep, voffB);
    PG8_WAIT_V(6); PG8_BAR;
    for (;;) {
        const bool has_next = S.next(ui + 1, nxt);
        const char* nA = has_next ? S.a_base(nxt) : cA; const char* nB = has_next ? S.b_base(nxt) : cB;
        if constexpr (Sched::GATHER) { if (has_next) PG8_GMAP_ISSUE(nxt); }
#pragma nounroll
        for (int t = 0; t < nt; t += 2) {
            const bool last = (t == nt - 2);
            const char* a1 = cA + (size_t)(t + 1) * kstep;
            const char* a2 = last ? nA : cA + (size_t)(t + 2) * kstep; const char* b2 = last ? nB : cB + (size_t)(t + 2) * kstep;
            const char* a3 = a2 + kstep; const char* b3 = b2 + kstep;
            const size_t kb2 = last ? 0 : (size_t)(t + 2) * kstep;
            if constexpr (Sched::GATHER) { if (last) { if (has_next) { PG8_GMAP_READ(nao, nxt); } else {
#pragma unroll
                for (int h_ = 0; h_ < 2; ++h_) { nao[h_][0] = cao[h_][0]; nao[h_][1] = cao[h_][1]; } } } }
            const bool rlx = RELAX_EPI && Epi::RELAX && t == 0 && ui > 0;
            PG8_LDB(B0, 0, 0); PG8_LDB(B1, 0, 1); PG8_SCHED; PG8_LDA(At, 0, 0); if (!rlx) PG8_STAGE_A(PG8_SA(1, 1), 1, a1 + hstep, (size_t)(t + 1) * kstep, false);
            if (rlx) PG8_WAIT_VN(8 + NE); else PG8_WAIT_V(8);
            PG8_WAIT_L(0); PG8_BAR; PG8_MMA(0, 0, At, B0); PG8_MMA(0, 1, At, B1); PG8_BAR; PG8_SCHED;
            PG8_LDA(At, 0, 1); PG8_STAGE(PG8_SB(0, 0), b2, voffB); PG8_STAGE(PG8_SB(0, 1), b2 + hstep, voffB); PG8_STAGE_A(PG8_SA(0, 0), 0, a2, kb2, last);
            if (rlx) PG8_WAIT_VN(14 + NE); else PG8_WAIT_V(8);
            PG8_WAIT_L(0); PG8_BAR; PG8_MMA(1, 0, At, B0); PG8_MMA(1, 1, At, B1); PG8_BAR; PG8_SCHED;
            PG8_LDB(B0, 1, 0); PG8_LDB(B1, 1, 1); PG8_SCHED; PG8_LDA(At, 1, 0); PG8_STAGE_A(PG8_SA(0, 1), 1, a2 + hstep, kb2, last);
            if (rlx) PG8_WAIT_VN(8 + NE); else PG8_WAIT_V(8);
            PG8_WAIT_L(0); PG8_BAR; PG8_MMA(0, 0, At, B0); PG8_MMA(0, 1, At, B1); PG8_BAR; PG8_SCHED;
            PG8_LDA(At, 1, 1); PG8_STAGE(PG8_SB(1, 0), b3, voffB); PG8_STAGE(PG8_SB(1, 1), b3 + hstep, voffB); PG8_STAGE_A(PG8_SA(1, 0), 0, a3, kb2 + kstep, last);
            if (rlx) PG8_WAIT_VN(14 + NE); else PG8_WAIT_V(8);
            PG8_WAIT_L(0); PG8_BAR; PG8_MMA(1, 0, At, B0); PG8_MMA(1, 1, At, B1); PG8_BAR; PG8_SCHED;
        }
        if (RELAX_EPI && Epi::RELAX) { PG8_STAGE(PG8_SA(1, 1), nA + kstep + hstep, voffA); asm volatile("" ::: "memory"); }
        if constexpr (Sched::FP8) { asm volatile("s_nop 15\n\ts_nop 7" ::: "memory"); }
        if constexpr (ALIGN_EPI) { if (wr == 0) PG8_BAR; }
        E(acc, cur, wr, wc, fr, fq);
        if (!has_next) break;
        if constexpr (!Epi::KEEP_ACC)
#pragma unroll
        for (int a = 0; a < 2; ++a)
#pragma unroll
            for (int b = 0; b < 2; ++b)
#pragma unroll
                for (int m = 0; m < 4; ++m)
#pragma unroll
                    for (int n = 0; n < 2; ++n) acc[a][b][m][n] = (f32x4){0.f, 0.f, 0.f, 0.f};
        cur = nxt; cA = nA; cB = nB; ++ui;
        if constexpr (Sched::GATHER) {
#pragma unroll
            for (int h_ = 0; h_ < 2; ++h_) { cao[h_][0] = nao[h_][0]; cao[h_][1] = nao[h_][1]; } }
        if constexpr (ALIGN_EPI) { if (wr == 1) PG8_BAR; }
    }
    PG8_WAIT_V(0);
    if constexpr (!ALIGN_EPI) { if (wr == 0) PG8_BAR; }
    PG8_BAR;
#undef PG8_SA
#undef PG8_STAGE_A
#undef PG8_GMAP_ISSUE
#undef PG8_GMAP_READ
#undef PG8_SB
#undef PG8_STAGE
#undef PG8_LDA
#undef PG8_LDB
#undef PG8_MMA
#undef PG8_WAIT_V
#undef PG8_WAIT_VN
#undef PG8_WAIT_L
#undef PG8_BAR
#undef PG8_SCHED
}
}

struct SchedDense {
    static constexpr bool GATHER = false; static constexpr bool FP8 = false; static constexpr int E8_A = 0, E8_B = 0;
    pg8::StaticOrder so; const char* A; const char* B; int K; bool lat; bool tr26;
    __device__ __forceinline__ void init(const void* A_, const void* B_, int K_, int nN, bool lat_, int G, int c, bool tr26_ = false) { A = (const char*)A_; B = (const char*)B_; K = K_; lat = lat_; tr26 = tr26_; so.init(lat_ ? 128 : 144, nN, G, c); }
    __device__ __forceinline__ bool swapped(const pg8::Unit& u) const { const int grp = u.pn >> 2; return tr26 && (grp == 2 || grp == 6); }
    __device__ __forceinline__ bool next(int i, pg8::Unit& u) const { int pm, pn; if (!so.next(i, pm, pn)) return false; if (lat) pm = (pm >> 3) * 9 + 1 + (pm & 7); u.pm = pm; u.pn = pn; u.aux = 0; return true; }
    __device__ __forceinline__ const char* a_base(const pg8::Unit& u) const { return swapped(u) ? B + (size_t)u.pn * 256 * K * 2 : A + (size_t)u.pm * 256 * K * 2; }
    __device__ __forceinline__ const char* b_base(const pg8::Unit& u) const { return swapped(u) ? A + (size_t)u.pm * 256 * K * 2 : B + (size_t)u.pn * 256 * K * 2; }
};
struct SchedBranch {
    static constexpr bool GATHER = false; static constexpr bool FP8 = false; static constexpr int E8_A = 0, E8_B = 0;
    pg8::StaticOrder so; const char* A; const char* B; bool lat;
    __device__ __forceinline__ void init(const void* A_, const void* B_, bool lat_, int G, int c) { A = (const char*)A_; B = (const char*)B_; lat = lat_; so.init(lat_ ? 128 : 144, 4, G, c); }
    __device__ __forceinline__ bool next(int i, pg8::Unit& u) const { int pm, pn; const int it = i / 3; if (!so.next(it, pm, pn)) return false; if (lat) pm = (pm >> 3) * 9 + 1 + (pm & 7); u.pm = pm; u.pn = pn; u.aux = i - 3 * it; return true; }
    __device__ __forceinline__ const char* a_base(const pg8::Unit& u) const { return A + (size_t)u.aux * PSTR * 2 + (size_t)u.pm * 256 * 1024 * 2; }
    __device__ __forceinline__ const char* b_base(const pg8::Unit& u) const { return B + (size_t)u.aux * 1024 * 1024 * 2 + (size_t)u.pn * 256 * 1024 * 2; }
};
constexpr int MOE_CAP = NROWS;
template <bool G_> struct SchedMoE {
    static constexpr bool GATHER = G_; static constexpr int GMAP_OFF = 131072;
    static constexpr bool FP8 = true; static constexpr int E8_B = E8_W, E8_A = G_ ? E8_ONE : E8_ACT;
    const volatile LAS int* toff; int TT, npn, xcd, j, nwx, G, c; const char* A; const char* B; size_t bexp; const int* rowmap;
    __device__ __forceinline__ void init(const void* A_, const void* B_, size_t bexp_, const volatile LAS int* toff_, int npn_, int G_g, int c_, const int* rowmap_) {
        A = (const char*)A_; B = (const char*)B_; bexp = bexp_; toff = toff_; TT = toff_[NEXP]; npn = npn_; G = G_g; c = c_; xcd = c_ & 7; j = c_ >> 3; nwx = G_g >> 3; rowmap = rowmap_; }
    __device__ __forceinline__ bool next(int i, pg8::Unit& u) const {
        int tm, pn;
        if ((G & 7) == 0) { const int q = i * nwx + j; const int t = q / npn; tm = xcd + 8 * t; pn = q - t * npn; }
        else { const int L = i * G + c; tm = L / npn; pn = L - tm * npn; }
        if (tm >= TT) return false;
        const int ln = (int)__builtin_amdgcn_mbcnt_hi(~0u, __builtin_amdgcn_mbcnt_lo(~0u, 0u));
        const int tv = toff[ln < NEXP - 1 ? ln + 1 : NEXP];
        const int e = (int)__builtin_popcountll(__ballot(ln < NEXP - 1 && tv <= tm));
        const int tb = __builtin_amdgcn_readlane(tv, e > 0 ? e - 1 : 0);
        u.pm = tm; u.pn = pn; u.aux = e; u.lt = tm - (e > 0 ? tb : 0); return true;
    }
    __device__ __forceinline__ const char* a_base(const pg8::Unit& u) const { return A + (size_t)u.pm * 256 * 1024; }
    __device__ __forceinline__ const char* b_base(const pg8::Unit& u) const { return B + (size_t)u.aux * bexp + (size_t)u.pn * 256 * 1024; }
    __device__ __forceinline__ const char* a_gather_base() const { return A; }
    __device__ __forceinline__ const int* row_ptr(const pg8::Unit& u, int lr) const { return rowmap + (size_t)u.aux * MOE_CAP + u.lt * 256 + lr; }
    __device__ __forceinline__ bool row_valid(const pg8::Unit& u, int lr) const { return u.lt * 256 + lr < toff[33 + u.aux]; }
};

typedef f32x4 AccT[2][2][4][2];
struct EpiProj {
    static constexpr bool KEEP_ACC = false; static constexpr bool RELAX = true; static constexpr bool PERM = true; static constexpr int NST = 16; bf16* P;
    __device__ __forceinline__ void operator()(AccT& acc, const pg8::Unit& u, int wr, int wc, int fr, int fq) const {
        const int grp = u.pn >> 2; const bool tr = (grp == 2 || grp == 6);
        const int b = u.pm / 9; const int ld = tr ? SROW : 1024;
        bf16* base = P + (size_t)grp * PSTR + (tr ? (size_t)b * 1024 * SROW + (size_t)(u.pn & 3) * 256 * SROW + (size_t)(u.pm - 9 * b) * 256 : (size_t)u.pm * 256 * 1024 + (size_t)(u.pn & 3) * 256);
        const int row0 = wr * 64 + fr, col0 = wc * 32 + 8 * fq;
#pragma unroll
        for (int ai = 0; ai < 2; ++ai)
#pragma unroll
            for (int m = 0; m < 4; ++m) { bf16* rowp = base + (size_t)(row0 + ai * 128 + m * 16) * ld + col0;
#pragma unroll
                for (int bj = 0; bj < 2; ++bj) { const f32x4 v0 = acc[ai][bj][m][0], v1 = acc[ai][bj][m][1];
                    u32x4 w; w.x = pk2(v0[0], v0[1]); w.y = pk2(v0[2], v0[3]); w.z = pk2(v1[0], v1[1]); w.w = pk2(v1[2], v1[3]);
                    *(u32x4*)(rowp + bj * 128) = w; } }
    }
};
struct EpiBranch {
    static constexpr bool KEEP_ACC = true; static constexpr bool RELAX = false; static constexpr bool PERM = true; static constexpr int NST = 0; const bf16* G; bf16* MB;
    static __device__ __forceinline__ void ratio4(f32x4& v, unsigned g01, unsigned g23, unsigned n01, unsigned n23) {
        const float n0 = 1.0f + fminf(__builtin_amdgcn_exp2f(-bflo(n01) * LOG2E), 1e30f), n1 = 1.0f + fminf(__builtin_amdgcn_exp2f(-bfhi(n01) * LOG2E), 1e30f);
        const float n2 = 1.0f + fminf(__builtin_amdgcn_exp2f(-bflo(n23) * LOG2E), 1e30f), n3 = 1.0f + fminf(__builtin_amdgcn_exp2f(-bfhi(n23) * LOG2E), 1e30f);
        v[0] *= sigmoidf_(bflo(g01)) * n0; v[1] *= sigmoidf_(bfhi(g01)) * n1; v[2] *= sigmoidf_(bflo(g23)) * n2; v[3] *= sigmoidf_(bfhi(g23)) * n3;
    }
    static __device__ __forceinline__ void gate4(f32x4& v, unsigned g01, unsigned g23) { v[0] *= sigmoidf_(bflo(g01)); v[1] *= sigmoidf_(bfhi(g01)); v[2] *= sigmoidf_(bflo(g23)); v[3] *= sigmoidf_(bfhi(g23)); }
    __device__ __forceinline__ void operator()(AccT& acc, const pg8::Unit& u, int wr, int wc, int fr, int fq) const {
        const int j = u.aux; const bf16* gate = G + (size_t)j * PSTR; const bf16* gnext = G + (size_t)(j < 2 ? j + 1 : j) * PSTR;
        int fr_ = fr; asm volatile("" : "+v"(fr_));
        const int row0 = u.pm * 256 + wr * 64 + fr_, col0 = u.pn * 256 + wc * 32 + 8 * fq;
#pragma unroll
        for (int ai = 0; ai < 2; ++ai)
#pragma unroll
        for (int mh = 0; mh < 2; ++mh) { u32x4 gw[2][2], gn[2][2];
#pragma unroll
            for (int mm = 0; mm < 2; ++mm)
#pragma unroll
                for (int bj = 0; bj < 2; ++bj) { const size_t off = (size_t)(row0 + ai * 128 + (2 * mh + mm) * 16) * 1024 + col0 + bj * 128; gw[mm][bj] = *(const u32x4*)(gate + off); gn[mm][bj] = *(const u32x4*)(gnext + off); }
            PIN8(gw[0][0], gw[0][1], gw[1][0], gw[1][1], gn[0][0], gn[0][1], gn[1][0], gn[1][1]);
#pragma unroll
            for (int mm = 0; mm < 2; ++mm) { const int m = 2 * mh + mm;
                if (j < 2) {
#pragma unroll
                    for (int bj = 0; bj < 2; ++bj) { ratio4(acc[ai][bj][m][0], gw[mm][bj].x, gw[mm][bj].y, gn[mm][bj].x, gn[mm][bj].y); ratio4(acc[ai][bj][m][1], gw[mm][bj].z, gw[mm][bj].w, gn[mm][bj].z, gn[mm][bj].w); }
                } else {
#pragma unroll
                    for (int bj = 0; bj < 2; ++bj) { f32x4 v0 = acc[ai][bj][m][0], v1 = acc[ai][bj][m][1];
                        gate4(v0, gw[mm][bj].x, gw[mm][bj].y); gate4(v1, gw[mm][bj].z, gw[mm][bj].w);
                        u32x4 w; w.x = pk2(v0[0], v0[1]); w.y = pk2(v0[2], v0[3]); w.z = pk2(v1[0], v1[1]); w.w = pk2(v1[2], v1[3]);
                        *(u32x4*)(MB + (size_t)(row0 + ai * 128 + m * 16) * 1024 + col0 + bj * 128) = w;
                        acc[ai][bj][m][0] = (f32x4){0.f, 0.f, 0.f, 0.f}; acc[ai][bj][m][1] = (f32x4){0.f, 0.f, 0.f, 0.f}; }
                } } }
    }
};
template <bool FIRST> struct EpiOut {
    static constexpr bool KEEP_ACC = false; static constexpr bool RELAX = false; static constexpr bool PERM = true; static constexpr int NST = 16; const float* xin_x; const float* xin_ctx; bf16* X; const float* modv_l;
    __device__ __forceinline__ void operator()(AccT& acc, const pg8::Unit& u, int wr, int wc, int fr, int fq) const {
        const int b = u.pm / 9, jt = u.pm - 9 * b; const float* g1 = modv_l + (size_t)(jt == 0 ? 16 : b) * 6144 + 2 * 1024;
        const float* src = jt == 0 ? xin_ctx + (size_t)b * CTXL * 1024 : xin_x + ((size_t)b * SEQ + (size_t)(jt - 1) * 256) * 1024;
        bf16* dst = X + (size_t)u.pm * 256 * 1024;
        int fr_ = fr; asm volatile("" : "+v"(fr_));
        const int lr0 = wr * 64 + fr_, col0 = u.pn * 256 + wc * 32 + 8 * fq;
        f32x4 gv[2][2];
#pragma unroll
        for (int bj = 0; bj < 2; ++bj)
#pragma unroll
            for (int n = 0; n < 2; ++n) gv[bj][n] = *(const f32x4*)(g1 + col0 + bj * 128 + n * 4);
        if constexpr (FIRST) {
#pragma unroll
            for (int ai = 0; ai < 2; ++ai)
#pragma unroll
                for (int mh = 0; mh < 2; ++mh) { f32x4 xo[2][2][2];
#pragma unroll
                    for (int mm = 0; mm < 2; ++mm)
#pragma unroll
                        for (int bj = 0; bj < 2; ++bj)
#pragma unroll
                            for (int n = 0; n < 2; ++n) xo[mm][bj][n] = *(const f32x4*)(src + (size_t)(lr0 + ai * 128 + (2 * mh + mm) * 16) * 1024 + col0 + bj * 128 + n * 4);
                    PIN8(xo[0][0][0], xo[0][0][1], xo[0][1][0], xo[0][1][1], xo[1][0][0], xo[1][0][1], xo[1][1][0], xo[1][1][1]);
#pragma unroll
                    for (int mm = 0; mm < 2; ++mm)
#pragma unroll
                        for (int bj = 0; bj < 2; ++bj) { const f32x4 x0 = xo[mm][bj][0] + gv[bj][0] * acc[ai][bj][2 * mh + mm][0], x1 = xo[mm][bj][1] + gv[bj][1] * acc[ai][bj][2 * mh + mm][1];
                            u32x4 w; w.x = pk2(x0[0], x0[1]); w.y = pk2(x0[2], x0[3]); w.z = pk2(x1[0], x1[1]); w.w = pk2(x1[2], x1[3]);
                            *(u32x4*)(dst + (size_t)(lr0 + ai * 128 + (2 * mh + mm) * 16) * 1024 + col0 + bj * 128) = w; } }
        } else {
#pragma unroll
            for (int ai = 0; ai < 2; ++ai) { u32x4 xb[4][2];
#pragma unroll
                for (int m = 0; m < 4; ++m)
#pragma unroll
                    for (int bj = 0; bj < 2; ++bj) xb[m][bj] = *(const u32x4*)(dst + (size_t)(lr0 + ai * 128 + m * 16) * 1024 + col0 + bj * 128);
                PIN8(xb[0][0], xb[0][1], xb[1][0], xb[1][1], xb[2][0], xb[2][1], xb[3][0], xb[3][1]);
#pragma unroll
                for (int m = 0; m < 4; ++m)
#pragma unroll
                    for (int bj = 0; bj < 2; ++bj) { const u32x4 t = xb[m][bj];
                        const f32x4 x0 = (f32x4){bflo(t.x), bfhi(t.x), bflo(t.y), bfhi(t.y)} + gv[bj][0] * acc[ai][bj][m][0], x1 = (f32x4){bflo(t.z), bfhi(t.z), bflo(t.w), bfhi(t.w)} + gv[bj][1] * acc[ai][bj][m][1];
                        u32x4 w; w.x = pk2(x0[0], x0[1]); w.y = pk2(x0[2], x0[3]); w.z = pk2(x1[0], x1[1]); w.w = pk2(x1[2], x1[3]);
                        *(u32x4*)(dst + (size_t)(lr0 + ai * 128 + m * 16) * 1024 + col0 + bj * 128) = w; } }
        }
    }
};
__device__ __forceinline__ float swiglu_(float gl, float li) { gl = fminf(gl, 7.0f); li = fminf(fmaxf(li, -7.0f), 7.0f);
    const float r = __builtin_amdgcn_rcpf(1.0f + __builtin_amdgcn_exp2f(gl * (-1.702f * LOG2E))); return (gl * r) * fmaf(li, ACT8_SCALE, ACT8_SCALE); }
struct EpiUp {
    static constexpr bool KEEP_ACC = false; static constexpr bool RELAX = true; static constexpr bool PERM = true; static constexpr int NST = 16; unsigned char* ACT; const float* bup;
    __device__ __forceinline__ void operator()(AccT& acc, const pg8::Unit& u, int wr, int wc, int fr, int fq) const {
        const float* bias = bup + (size_t)u.aux * 2048; const int row0 = u.pm * 256 + wr * 64 + fr, colb = u.pn * 256 + wc * 32 + 8 * fq;
        f32x4 bv[2][2];
#pragma unroll
        for (int bj = 0; bj < 2; ++bj)
#pragma unroll
            for (int n = 0; n < 2; ++n) bv[bj][n] = *(const f32x4*)(bias + colb + bj * 128 + 4 * n);
#pragma unroll
        for (int ai = 0; ai < 2; ++ai)
#pragma unroll
            for (int m = 0; m < 4; ++m) { unsigned char* rowp = ACT + (size_t)(row0 + ai * 128 + m * 16) * 1024 + (colb >> 1);
#pragma unroll
                for (int bj = 0; bj < 2; ++bj) { const f32x4 v0 = acc[ai][bj][m][0] + bv[bj][0], v1 = acc[ai][bj][m][1] + bv[bj][1];
                    *(unsigned*)(rowp + bj * 64) = pk4_fp8(swiglu_(v0[0], v0[1]), swiglu_(v0[2], v0[3]), swiglu_(v1[0], v1[1]), swiglu_(v1[2], v1[3])); } }
    }
};
struct EpiDown {
    static constexpr bool KEEP_ACC = false; static constexpr bool RELAX = true; static constexpr bool PERM = true; static constexpr int NST = 16; unsigned char* Y; const float* bdn; const float* roww;
    __device__ __forceinline__ void operator()(AccT& acc, const pg8::Unit& u, int wr, int wc, int fr, int fq) const {
        const float* bias = bdn + (size_t)u.aux * 1024; const int row0 = u.pm * 256 + wr * 64 + fr, col0 = u.pn * 256 + wc * 32 + 8 * fq;
        f32x4 bv[2][2];
#pragma unroll
        for (int bj = 0; bj < 2; ++bj)
#pragma unroll
            for (int n = 0; n < 2; ++n) bv[bj][n] = *(const f32x4*)(bias + col0 + bj * 128 + 4 * n);
        float rw[2][4];
#pragma unroll
        for (int ai = 0; ai < 2; ++ai)
#pragma unroll
            for (int m = 0; m < 4; ++m) rw[ai][m] = roww[(size_t)u.aux * MOE_CAP + u.lt * 256 + (wr * 64 + fr + ai * 128 + m * 16)];
        PIN8(rw[0][0], rw[0][1], rw[0][2], rw[0][3], rw[1][0], rw[1][1], rw[1][2], rw[1][3]);
#pragma unroll
        for (int ai = 0; ai < 2; ++ai)
#pragma unroll
            for (int m = 0; m < 4; ++m) { const int row = row0 + ai * 128 + m * 16; const float w8 = rw[ai][m] * Y8_SCALE; unsigned char* rowp = Y + (size_t)row * 1024 + col0;
#pragma unroll
                for (int bj = 0; bj < 2; ++bj) { const f32x4 v0 = (acc[ai][bj][m][0] + bv[bj][0]) * w8, v1 = (acc[ai][bj][m][1] + bv[bj][1]) * w8;
                    u32x2 w; w.x = pk4_fp8(v0[0], v0[1], v0[2], v0[3]); w.y = pk4_fp8(v1[0], v1[1], v1[2], v1[3]);
                    *(u32x2*)(rowp + bj * 128) = w; } }
    }
};
#define XB_TMO      128
#define XB_XCNT(j)  (256  + 64 * (j))
#define XB_XSUB(j)  (1280 + 64 * (j))
#define XB_XGEN(j)  (2304 + 64 * (j))
#define XB_TOP      3328
#define XB_TOPGEN   3392
#define XCD_BAR_WORDS 3456
#define XB_SPIN_CAP (1u << 18)
__device__ __forceinline__ unsigned xb_ld(unsigned* p)              { return __hip_atomic_load(p, __ATOMIC_RELAXED, __HIP_MEMORY_SCOPE_AGENT); }
__device__ __forceinline__ unsigned xb_add(unsigned* p, unsigned v) { return __hip_atomic_fetch_add(p, v, __ATOMIC_RELAXED, __HIP_MEMORY_SCOPE_AGENT); }
__device__ __forceinline__ unsigned xb_xcc_id() { return (unsigned)__builtin_amdgcn_s_getreg((3 << 11) | 20) & 0xFu; }
#define XB_SPIN(cond, bar) do { unsigned _sp = 0; while (cond) { __builtin_amdgcn_s_sleep(1); \
    if ((++_sp & 255u) == 0u) { if (xb_ld(&(bar)[XB_TMO])) break; if (_sp > XB_SPIN_CAP) { atomicAdd(&(bar)[XB_TMO], 1u); break; } } } } while (0)
struct XcdBarrier { unsigned* bar; unsigned x; volatile LAS unsigned* st; };
__device__ __forceinline__ XcdBarrier xcd_barrier_post(unsigned* bar, volatile LAS unsigned* st) {
    XcdBarrier b; b.bar = bar; b.x = xb_xcc_id(); b.st = st;
    if (threadIdx.x == 0) (void)xb_add(&bar[XB_XCNT(b.x)], 1u);
    return b;
}
__device__ __forceinline__ void xcd_barrier_complete(unsigned* bar, unsigned x, unsigned& nloc, unsigned& nx) {
    const unsigned G = gridDim.x * gridDim.y * gridDim.z;
    unsigned sum, cnt, mine, sp = 0u;
    for (;;) {
        sum = 0u; cnt = 0u; mine = 0u;
#pragma unroll
        for (unsigned j = 0; j < 16; ++j) { const unsigned c = xb_ld(&bar[XB_XCNT(j)]); sum += c; cnt += (c > 0u) ? 1u : 0u; mine = (j == x) ? c : mine; }
        if (sum == G) break;
        __builtin_amdgcn_s_sleep(1);
        if ((++sp & 255u) == 0u) { if (xb_ld(&bar[XB_TMO])) break; if (sp > XB_SPIN_CAP) { atomicAdd(&bar[XB_TMO], 1u); break; } }
    }
    nloc = mine > 0u ? mine : 1u; nx = cnt > 0u ? cnt : 1u;
}
__device__ __forceinline__ void xcd_barrier(const XcdBarrier& b) {
    asm volatile("s_waitcnt vmcnt(0)" ::: "memory");
    __syncthreads();
    if (threadIdx.x == 0) {
        unsigned* bar = b.bar;
        __builtin_amdgcn_s_waitcnt(0);
        unsigned nloc = b.st[0], nx = b.st[1];
        if (nloc == 0u) { xcd_barrier_complete(bar, b.x, nloc, nx); b.st[0] = nloc; b.st[1] = nx; }
        const unsigned old = xb_add(&bar[XB_XSUB(b.x)], 1u);
        const unsigned gen = old / nloc;
        if (old + 1u == (gen + 1u) * nloc) {
            __builtin_amdgcn_fence(__ATOMIC_RELEASE, "agent");
            asm volatile("s_waitcnt vmcnt(0)" ::: "memory");
            const unsigned og = xb_add(&bar[XB_TOP], 1u);
            const unsigned tg = og / nx;
            if (og + 1u == (tg + 1u) * nx) xb_add(&bar[XB_TOPGEN], 1u);
            else XB_SPIN(xb_ld(&bar[XB_TOPGEN]) == tg, bar);
            __builtin_amdgcn_fence(__ATOMIC_ACQUIRE, "agent");
            xb_add(&bar[XB_XGEN(b.x)], 1u);
            asm volatile("s_waitcnt vmcnt(0)" ::: "memory");
        } else {
            XB_SPIN(xb_ld(&bar[XB_XGEN(b.x)]) == gen, bar);
            __builtin_amdgcn_fence(__ATOMIC_ACQUIRE, "agent");
            asm volatile("s_waitcnt vmcnt(0)" ::: "memory");
        }
    }
    __syncthreads();
}

struct Args {
    const float* in[28]; float* out; unsigned char* ws; int ph_lo, ph_hi;
};
struct Frame {
    LAS unsigned char* lds; volatile LAS unsigned* MISC; unsigned* ctl; unsigned char* ws;
    int vcu, G, c;
    const float* const* in;
};
#define PHASE_IDS() const int tid = opaque_tid(); const int lane = tid & 63; const int wave = __builtin_amdgcn_readfirstlane(tid >> 6); (void)lane; (void)wave
enum { I_X = 0, I_C, I_CTX, I_CCTX, I_WMOD, I_BMOD, I_N1G, I_N2G, I_WMIX, I_RDF, I_RDB, I_RPB, I_CONVW, I_CONVB, I_GAW, I_GAB, I_GXW, I_GXB, I_LAM, I_WBR, I_WOUT, I_WR, I_BR, I_WUP, I_BUP, I_WDN, I_BDN, I_FNG };

constexpr int P0_I0 = 2 * 3072, P0_I1 = P0_I0 + 6 * 256, P0_I2 = P0_I1 + 2 * 256, P0_I3 = P0_I2 + 64 * 512, P0_I4 = P0_I3 + 64 * 256;
constexpr int P0_CHUNK = 128, P0_NCHUNK = (P0_I4 - P0_I2) / P0_CHUNK;
static_assert((P0_I4 - P0_I2) % P0_CHUNK == 0, "conversion chunks");
__device__ __forceinline__ void p0_decode(Frame& F, int it, const float*& src, unsigned char*& dst, int& N, bool& f8) {
    int kb, nb; const float* W; unsigned char* WT;
    if (it < P0_I0) { const int mi = it / 3072, r = it - mi * 3072; kb = r / 192; nb = r - kb * 192; N = 12288; f8 = false; W = F.in[I_WMIX] + (size_t)mi * 1024 * 12288; WT = F.ws + WS_WMIX + (size_t)mi * 12288 * 2048; }
    else if (it < P0_I1) { const int q = it - P0_I0, mi = q >> 8, r = q & 255; kb = r >> 4; nb = r & 15; N = 1024; f8 = false; W = F.in[I_WBR] + (size_t)mi * 1024 * 1024; WT = F.ws + WS_WBR + (size_t)mi * 1024 * 2048; }
    else if (it < P0_I2) { const int q = it - P0_I1, mi = q >> 8, r = q & 255; kb = r >> 4; nb = r & 15; N = 1024; f8 = false; W = F.in[I_WOUT] + (size_t)mi * 1024 * 1024; WT = F.ws + WS_WOUT + (size_t)mi * 1024 * 2048; }
    else if (it < P0_I3) { const int q = it - P0_I2, mi = q >> 9, r = q & 511; kb = r >> 5; nb = r & 31; N = 2048; f8 = true; W = F.in[I_WUP] + (size_t)mi * 1024 * 2048; WT = F.ws + WS_WUP + (size_t)mi * 2048 * 1024; }
    else { const int q = it - P0_I3, mi = q >> 8, r = q & 255; kb = r >> 4; nb = r & 15; N = 1024; f8 = true; W = F.in[I_WDN] + (size_t)mi * 1024 * 1024; WT = F.ws + WS_WDN + (size_t)mi * 1024 * 1024; }
    src = W + (size_t)(64 * kb) * N + 64 * nb; dst = WT + ((size_t)(64 * nb) * 1024 + 64 * kb) * (f8 ? 1 : 2);
}
__device__ __forceinline__ void p0_convert(Frame& F, int it0, int stride, int it_end, int wave, int lane) {
    LAS float* scr = (LAS float*)(F.lds + wave * 16640);
    const int lr = lane >> 4, lc = 4 * (lane & 15);
    f32x4 cur[16], nxt[16];
    const float* src; unsigned char* dst; int N; bool f8;
    int it = it0;
    if (it < it_end) { p0_decode(F, it, src, dst, N, f8);
#pragma unroll
        for (int i = 0; i < 16; ++i) cur[i] = *(const f32x4*)(src + (size_t)(4 * i + lr) * N + lc); }
    for (; it < it_end; it += stride) {
        unsigned char* dcur = dst; const bool f8c = f8;
        if (it + stride < it_end) { p0_decode(F, it + stride, src, dst, N, f8);
#pragma unroll
            for (int i = 0; i < 16; ++i) nxt[i] = *(const f32x4*)(src + (size_t)(4 * i + lr) * N + lc); }
#pragma unroll
        for (int i = 0; i < 16; ++i) { LAS float* s = scr + (4 * i + lr) * 65 + lc; s[0] = cur[i].x; s[1] = cur[i].y; s[2] = cur[i].z; s[3] = cur[i].w; }
        LDS_WAIT(); asm volatile("" ::: "memory");
        const int c = lane & 7;
        if (!f8c) {
#pragma unroll
            for (int j = 0; j < 8; ++j) { const int n = (lane >> 3) + 8 * j; const LAS float* s = scr + (8 * c) * 65 + n;
                u32x4 o; o.x = pk2(s[0 * 65], s[1 * 65]); o.y = pk2(s[2 * 65], s[3 * 65]); o.z = pk2(s[4 * 65], s[5 * 65]); o.w = pk2(s[6 * 65], s[7 * 65]);
                *(u32x4*)(dcur + (size_t)n * 2048 + 16 * c) = o; }
        } else {
#pragma unroll
            for (int j = 0; j < 8; ++j) { const int n = (lane >> 3) + 8 * j; const LAS float* s = scr + (8 * c) * 65 + n;
                u32x2 o; o.x = pk4_fp8(s[0 * 65] * W8_SCALE, s[1 * 65] * W8_SCALE, s[2 * 65] * W8_SCALE, s[3 * 65] * W8_SCALE); o.y = pk4_fp8(s[4 * 65] * W8_SCALE, s[5 * 65] * W8_SCALE, s[6 * 65] * W8_SCALE, s[7 * 65] * W8_SCALE);
                *(u32x2*)(dcur + (size_t)n * 1024 + 8 * c) = o; }
        }
        LDS_WAIT(); asm volatile("" ::: "memory");
#pragma unroll
        for (int i = 0; i < 16; ++i) cur[i] = nxt[i];
    }
}
__device__ __forceinline__ void p0_prologue(Frame& F, int nrep) {
    PHASE_IDS();
    {
        float2* rope = (float2*)(F.ws + WS_ROPE);
        const int gt = F.c * 512 + tid;
        if (gt < 96 * 32) { const int pos = gt >> 5, i = gt & 31; const float p = (float)(pos < 32 ? pos : pos - 32); const float inv = powf(10000.0f, -(float)i / 32.0f); const float a = p * inv; rope[gt] = make_float2(cosf(a), sinf(a)); }
    }
    if (F.c < 192) {
        LAS float* sil = (LAS float*)F.lds;
        LAS float* red = (LAS float*)(F.lds + 17 * 1024 * 4);
        { float cv[34];
#pragma unroll
          for (int q = 0; q < 34; ++q) { const int i = tid + 512 * q, b = i >> 10, k = i & 1023; cv[q] = b < 16 ? F.in[I_C][b * 1024 + k] : F.in[I_CCTX][k]; }
          PIN8(cv[0], cv[1], cv[2], cv[3], cv[4], cv[5], cv[6], cv[7]); PIN8(cv[8], cv[9], cv[10], cv[11], cv[12], cv[13], cv[14], cv[15]); PIN8(cv[16], cv[17], cv[18], cv[19], cv[20], cv[21], cv[22], cv[23]);
          PIN8(cv[24], cv[25], cv[26], cv[27], cv[28], cv[29], cv[30], cv[31]); PIN4(cv[32], cv[33], cv[0], cv[1]);
#pragma unroll
          for (int q = 0; q < 34; ++q) sil[tid + 512 * q] = cv[q] * sigmoidf_(cv[q]); }
        __syncthreads();
        const int l = F.c / 96, cg = F.c - 96 * l; const float* wm = F.in[I_WMOD] + (size_t)l * 1024 * 6144 + 64 * cg + lane;
        float acc[17];
#pragma unroll
        for (int b = 0; b < 17; ++b) acc[b] = 0.f;
        const int kb = wave * 128;
#pragma unroll 16
        for (int kk = 0; kk < 128; ++kk) { const float wv = wm[(size_t)(kb + kk) * 6144];
#pragma unroll
            for (int b = 0; b < 17; ++b) acc[b] += sil[b * 1024 + kb + kk] * wv; }
#pragma unroll
        for (int b = 0; b < 17; ++b) red[(wave * 17 + b) * 64 + lane] = acc[b];
        __syncthreads();
        float* modv = (float*)(F.ws + WS_MODV);
        for (int i = tid; i < 17 * 64; i += 512) { const int b = i >> 6, n = i & 63; float s = 0.f;
#pragma unroll
            for (int w = 0; w < 8; ++w) s += red[(w * 17 + b) * 64 + n];
            const int col = 64 * cg + n; modv[((size_t)l * 17 + b) * 6144 + col] = s + F.in[I_BMOD][l * 6144 + col]; }
        __syncthreads();
    }
    for (int rep = 0; rep < nrep; ++rep) p0_convert(F, F.vcu * 8 + wave, F.G * 8, P0_I2, wave, lane);
}

__device__ __forceinline__ float row_rstd(const f32x4 (&v)[4]) {
    float s = 0.f;
#pragma unroll
    for (int j = 0; j < 4; ++j) s += (v[j].x * v[j].x + v[j].y * v[j].y) + (v[j].z * v[j].z + v[j].w * v[j].w);
    return rsqrtf(wave_sum(s) * (1.0f / 1024.0f) + NORM_EPS);
}
template <bool F8 = false> __device__ __forceinline__ void modulate_row_pre(f32x4 (&v)[4], const f32x4 (&g4)[4], const f32x4 (&s4)[4], const f32x4 (&h4)[4], bf16* orow, int lane) {
    const float rstd = row_rstd(v);
#pragma unroll
    for (int j = 0; j < 4; ++j) { const int col = 4 * lane + 256 * j;
        v[j] = v[j] * rstd * g4[j] * (s4[j] + 1.0f) + h4[j];
        if constexpr (F8) { *(unsigned*)((unsigned char*)orow + col) = pk4_fp8(v[j].x, v[j].y, v[j].z, v[j].w); }
        else { u32x2 w; w.x = pk2(v[j].x, v[j].y); w.y = pk2(v[j].z, v[j].w); *(u32x2*)(orow + col) = w; } }
}
template <bool F8 = false> __device__ __forceinline__ void modulate_row(f32x4 (&v)[4], const float* g, const float* sc, const float* sh, bf16* orow, int lane) {
    f32x4 g4[4], s4[4], h4[4];
#pragma unroll
    for (int j = 0; j < 4; ++j) { const int col = 4 * lane + 256 * j; g4[j] = *(const f32x4*)(g + col); s4[j] = *(const f32x4*)(sc + col); h4[j] = *(const f32x4*)(sh + col); }
    PIN4(g4[0], g4[1], g4[2], g4[3]); PIN8(s4[0], s4[1], s4[2], s4[3], h4[0], h4[1], h4[2], h4[3]);
    modulate_row_pre<F8>(v, g4, s4, h4, orow, lane);
}
__device__ __forceinline__ const float* in_row(const float* x, const float* ctx, int r) { const int b = r / SROW, s = r - b * SROW; return s < CTXL ? ctx + ((size_t)b * CTXL + s) * D : x + ((size_t)b * SEQ + (s - CTXL)) * D; }
__device__ __forceinline__ void p1_norm1(Frame& F) {
    PHASE_IDS();
    const int gw = F.vcu * 8 + wave, NGW = F.G * 8;
    const float* modv = (const float*)(F.ws + WS_MODV); bf16* H = (bf16*)(F.ws + WS_H);
    f32x4 v[4], nv[4];
    if (gw < NROWS) { const float* xr = in_row(F.in[I_X], F.in[I_CTX], gw);
#pragma unroll
        for (int j = 0; j < 4; ++j) v[j] = *(const f32x4*)(xr + 4 * lane + 256 * j); }
    for (int r = gw; r < NROWS; r += NGW) {
        const int b = r / SROW, s = r - b * SROW; const float* mv = modv + (size_t)(s < CTXL ? 16 : b) * 6144;
        const int rn = r + NGW < NROWS ? r + NGW : r; const float* xn = in_row(F.in[I_X], F.in[I_CTX], rn);
#pragma unroll
        for (int j = 0; j < 4; ++j) nv[j] = *(const f32x4*)(xn + 4 * lane + 256 * j);
        modulate_row(v, F.in[I_N1G], mv + 1024, mv, H + (size_t)r * 1024, lane);
#pragma unroll
        for (int j = 0; j < 4; ++j) v[j] = nv[j];
    }
}
constexpr int WR_STRIDE = 1028;
constexpr int L6_WR = 0, L6_LCNT = 32 * WR_STRIDE * 4, L6_LBASE = L6_LCNT + 128, L6_TAB = L6_LBASE + 128, L6_MAXROWS = 640;
static_assert(L6_TAB + L6_MAXROWS * 48 <= LCTL_OFF, "router LDS");
__device__ __forceinline__ float tred32(const float (&p)[32], int lane) {
    float q16[16], q8[8], q4[4], q2[2], q1;
    { const bool hi = (lane & 32) != 0;
#pragma unroll
      for (int e = 0; e < 16; ++e) { const float keep = hi ? p[e + 16] : p[e], send = hi ? p[e] : p[e + 16]; q16[e] = keep + __shfl_xor(send, 32); } }
    { const bool hi = (lane & 16) != 0;
#pragma unroll
      for (int e = 0; e < 8; ++e) { const float keep = hi ? q16[e + 8] : q16[e], send = hi ? q16[e] : q16[e + 8]; q8[e] = keep + __shfl_xor(send, 16); } }
    { const bool hi = (lane & 8) != 0;
#pragma unroll
      for (int e = 0; e < 4; ++e) { const float keep = hi ? q8[e + 4] : q8[e], send = hi ? q8[e] : q8[e + 4]; q4[e] = keep + __shfl_xor(send, 8); } }
    { const bool hi = (lane & 4) != 0;
#pragma unroll
      for (int e = 0; e < 2; ++e) { const float keep = hi ? q4[e + 2] : q4[e], send = hi ? q4[e] : q4[e + 2]; q2[e] = keep + __shfl_xor(send, 4); } }
    { const bool hi = (lane & 2) != 0; const float keep = hi ? q2[1] : q2[0], send = hi ? q2[0] : q2[1]; q1 = keep + __shfl_xor(send, 2); }
    return q1 + __shfl_xor(q1, 1);
}
__device__ __forceinline__ void route_row(float val, int el, int lane, volatile LAS int* LCNT, LAS int* TAB, int lr) {
    int te[4]; float tv[4];
#pragma unroll
    for (int k = 0; k < 4; ++k) { const float m = wave_max(val); const unsigned long long mask = __ballot(val == m); const int fl = mask ? (int)__builtin_ctzll(mask) : 0;
        te[k] = (fl >> 1) & 31; tv[k] = m; if (el == te[k]) val = -INFINITY; }
    const float e1 = __expf(tv[1] - tv[0]), e2 = __expf(tv[2] - tv[0]), e3 = __expf(tv[3] - tv[0]); const float inv = 1.0f / (1.0f + e1 + e2 + e3);
    if (lane < 4) { const int ek = lane == 0 ? te[0] : lane == 1 ? te[1] : lane == 2 ? te[2] : te[3]; const float wk = (lane == 0 ? 1.0f : lane == 1 ? e1 : lane == 2 ? e2 : e3) * inv;
        const int pos = atomicAdd((int*)(LCNT + ek), 1);
        LAS int* t = TAB + (lr * 4 + lane) * 3; t[0] = ek; t[1] = pos; t[2] = __float_as_int(wk); }
}
__device__ __forceinline__ void p6_router(Frame& F, int l, bool lat) {
    PHASE_IDS();
    LAS float* WR = (LAS float*)(F.lds + L6_WR);
    volatile LAS int* LCNT = (volatile LAS int*)(F.lds + L6_LCNT); volatile LAS int* LBASE = (volatile LAS int*)(F.lds + L6_LBASE);
    LAS int* TAB = (LAS int*)(F.lds + L6_TAB);
    const float* wr = F.in[I_WR] + (size_t)l * 1024 * 32;
    { f32x4 t[16];
#pragma unroll
      for (int i = 0; i < 16; ++i) t[i] = *(const f32x4*)(wr + 4 * (tid + 512 * i));
      PIN8(t[0], t[1], t[2], t[3], t[4], t[5], t[6], t[7]); PIN8(t[8], t[9], t[10], t[11], t[12], t[13], t[14], t[15]);
#pragma unroll
      for (int i = 0; i < 16; ++i) { const int q = tid + 512 * i, d = q >> 3, e0 = 4 * (q & 7); WR[e0 * WR_STRIDE + d] = t[i].x; WR[(e0 + 1) * WR_STRIDE + d] = t[i].y; WR[(e0 + 2) * WR_STRIDE + d] = t[i].z; WR[(e0 + 3) * WR_STRIDE + d] = t[i].w; } }
    if (tid < 32) LCNT[tid] = 0;
    __syncthreads();
    const int RPW = (NROWS + F.G - 1) / F.G; const int rbeg = F.c * RPW; int nloc = NROWS - rbeg; nloc = nloc < 0 ? 0 : (nloc > RPW ? RPW : nloc);
    const float* modv = (const float*)(F.ws + WS_MODV) + (size_t)l * 17 * 6144; const bf16* X = (const bf16*)(F.ws + WS_X); bf16* H = (bf16*)(F.ws + WS_H);
    const float* n2g = F.in[I_N2G] + l * 1024; const float* brt = F.in[I_BR] + l * 32;
    const int el = (lane >> 1) & 31; const float bre = brt[el];
    for (int lr = wave; lr < nloc; lr += 16) {
        const int lr2 = lr + 8; const bool has2 = lr2 < nloc;
        const int r = rbeg + lr, r2 = has2 ? rbeg + lr2 : r; const int b = r / SROW, s = r - b * SROW, b2 = r2 / SROW, s2 = r2 - b2 * SROW;
        const bool skip1 = lat && s < CTXL, skip2 = !has2 || (lat && s2 < CTXL);
        if (skip1 && lane < 4) TAB[(lr * 4 + lane) * 3] = -1;
        if (has2 && skip2 && lane < 4) TAB[(lr2 * 4 + lane) * 3] = -1;
        if (skip1 && skip2) continue;
        const float* mv = modv + (size_t)(s < CTXL ? 16 : b) * 6144; const float* mv2 = modv + (size_t)(s2 < CTXL ? 16 : b2) * 6144;
        f32x4 v[4], v2[4];
#pragma unroll
        for (int j = 0; j < 4; ++j) { const u32x2 t = *(const u32x2*)(X + (size_t)r * 1024 + 4 * lane + 256 * j), t2 = *(const u32x2*)(X + (size_t)r2 * 1024 + 4 * lane + 256 * j); v[j] = bf4(t); v2[j] = bf4(t2); }
        if (!skip1) modulate_row<true>(v, n2g, mv + 4 * 1024, mv + 3 * 1024, (bf16*)((unsigned char*)H + (size_t)r * 1024), lane);
        if (!skip2) modulate_row<true>(v2, n2g, mv2 + 4 * 1024, mv2 + 3 * 1024, (bf16*)((unsigned char*)H + (size_t)r2 * 1024), lane);
        float p[32], p2[32];
#pragma unroll
        for (int e = 0; e < 32; ++e) { float a = 0.f, a2 = 0.f;
#pragma unroll
            for (int j = 0; j < 4; ++j) { const f32x4 w4 = *(const LAS f32x4*)(WR + e * WR_STRIDE + 256 * j + 4 * lane);
                a += (v[j].x * w4.x + v[j].y * w4.y) + (v[j].z * w4.z + v[j].w * w4.w); a2 += (v2[j].x * w4.x + v2[j].y * w4.y) + (v2[j].z * w4.z + v2[j].w * w4.w); }
            p[e] = a; p2[e] = a2; }
        const float val = tred32(p, lane) + bre, val2 = tred32(p2, lane) + bre;
        if (!skip1) route_row(val, el, lane, LCNT, TAB, lr);
        if (!skip2) route_row(val2, el, lane, LCNT, TAB, lr2);
    }
    __syncthreads();
    unsigned* cnt = F.ctl + CW_CNT + l * 64;
    if (tid < 32) LBASE[tid] = (int)atomicAdd(cnt + tid, (unsigned)LCNT[tid]);
    __syncthreads();
    int* toke = (int*)(F.ws + WS_TOKE); int* tokp = (int*)(F.ws + WS_TOKP); int* rowmap = (int*)(F.ws + WS_ROWMAP); float* roww = (float*)(F.ws + WS_ROWW);
    for (int idx = tid; idx < nloc * 4; idx += 512) { const LAS int* t = TAB + idx * 3; const int e = t[0]; const size_t o = (size_t)rbeg * 4 + idx;
        toke[o] = e; if (e >= 0) { const int pos = LBASE[e] + t[1]; tokp[o] = pos; rowmap[(size_t)e * NROWS + pos] = rbeg + (idx >> 2); roww[(size_t)e * NROWS + pos] = __int_as_float(t[2]); } }
    __syncthreads();
}
__device__ __forceinline__ void moe_toff(Frame& F, int l, volatile LAS int* toff) {
    PHASE_IDS();
    if (wave == 0) { unsigned* cnt = F.ctl + CW_CNT + l * 64;
        const int c = lane < NEXP ? (int)__hip_atomic_load(cnt + lane, RLX_AGENT) : 0; const int t = (c + 255) >> 8; int incl = t;
#pragma unroll
        for (int d = 1; d < 32; d <<= 1) { const int o = __shfl_up(incl, d); if (lane >= d) incl += o; }
        if (lane < NEXP) { toff[lane] = incl - t; toff[33 + lane] = c; }
        if (lane == NEXP - 1) toff[NEXP] = incl; }
    __syncthreads();
}
__device__ __forceinline__ void p9_combine(Frame& F, int l, bool last, float* out) {
    PHASE_IDS();
    const int gw = F.vcu * 8 + wave, NGW = F.G * 8;
    volatile LAS int* toff = (volatile LAS int*)(F.lds + LCTL_OFF + 256);
    moe_toff(F, l, toff);
    const int* toke = (const int*)(F.ws + WS_TOKE); const int* tokp = (const int*)(F.ws + WS_TOKP); const unsigned char* Y = (const unsigned char*)(F.ws + WS_H2S);
    bf16* X = (bf16*)(F.ws + WS_X); bf16* H = (bf16*)(F.ws + WS_H);
    const float* modv = (const float*)(F.ws + WS_MODV) + (size_t)l * 17 * 6144;
    f32x4 fg[4];
#pragma unroll
    for (int j = 0; j < 4; ++j) fg[j] = *(const f32x4*)(F.in[I_FNG] + 4 * lane + 256 * j);
    int r = gw; while (r < NROWS && last && (r % SROW) < CTXL) r += NGW;
    i32x4v te = (i32x4v){0, 0, 0, 0}, tp = te;
    if (r < NROWS) { te = *(const i32x4v*)(toke + (size_t)r * 4); tp = *(const i32x4v*)(tokp + (size_t)r * 4); }
    while (r < NROWS) {
        int rn = r + NGW; while (rn < NROWS && last && (rn % SROW) < CTXL) rn += NGW;
        const int b = r / SROW, s = r - b * SROW;
        const int mb = s < CTXL ? 16 : b; const float* g2 = modv + (size_t)mb * 6144 + 5 * 1024;
        const float* mv = (const float*)(F.ws + WS_MODV) + ((size_t)(last ? l : l + 1) * 17 + mb) * 6144; const float* n1g = F.in[I_N1G] + (last ? l : l + 1) * 1024;
        int slot[4];
#pragma unroll
        for (int k = 0; k < 4; ++k) slot[k] = toff[te[k]] * 256 + tp[k];
        f32x4 v[4], gg[4], g4[4], s4[4], h4[4]; int yw[4][4]; u32x2 xb[4];
#pragma unroll
        for (int j = 0; j < 4; ++j) { const int col = 4 * lane + 256 * j; xb[j] = *(const u32x2*)(X + (size_t)r * 1024 + col); gg[j] = *(const f32x4*)(g2 + col);
            g4[j] = *(const f32x4*)(n1g + col); s4[j] = *(const f32x4*)(mv + 1024 + col); h4[j] = *(const f32x4*)(mv + col); }
#pragma unroll
        for (int k = 0; k < 4; ++k)
#pragma unroll
            for (int j = 0; j < 4; ++j) yw[k][j] = *(const int*)(Y + (size_t)slot[k] * 1024 + 4 * lane + 256 * j);
        i32x4v ten = te, tpn = tp;
        if (rn < NROWS) { ten = *(const i32x4v*)(toke + (size_t)rn * 4); tpn = *(const i32x4v*)(tokp + (size_t)rn * 4); }
        PIN8(xb[0], xb[1], xb[2], xb[3], gg[0], gg[1], gg[2], gg[3]); PIN8(g4[0], g4[1], g4[2], g4[3], s4[0], s4[1], s4[2], s4[3]); PIN4(h4[0], h4[1], h4[2], h4[3]);
        PIN8(yw[0][0], yw[0][1], yw[0][2], yw[0][3], yw[1][0], yw[1][1], yw[1][2], yw[1][3]); PIN8(yw[2][0], yw[2][1], yw[2][2], yw[2][3], yw[3][0], yw[3][1], yw[3][2], yw[3][3]);
        f32x4 ys[4];
#pragma unroll
        for (int j = 0; j < 4; ++j) ys[j] = (f32x4){0.f, 0.f, 0.f, 0.f};
#pragma unroll
        for (int k = 0; k < 4; ++k)
#pragma unroll
            for (int j = 0; j < 4; ++j) { const int w = yw[k][j]; const f32x2 lo = __builtin_amdgcn_cvt_pk_f32_fp8(w, false), hi = __builtin_amdgcn_cvt_pk_f32_fp8(w, true); ys[j].x += lo.x; ys[j].y += lo.y; ys[j].z += hi.x; ys[j].w += hi.y; }
#pragma unroll
        for (int j = 0; j < 4; ++j) v[j] = bf4(xb[j]) + gg[j] * (ys[j] * (1.0f / Y8_SCALE));
        if (!last) {
#pragma unroll
            for (int j = 0; j < 4; ++j) { u32x2 w; w.x = pk2(v[j].x, v[j].y); w.y = pk2(v[j].z, v[j].w); *(u32x2*)(X + (size_t)r * 1024 + 4 * lane + 256 * j) = w; }
            modulate_row_pre(v, g4, s4, h4, H + (size_t)r * 1024, lane);
        } else {
            const float rstd = row_rstd(v); float* orow = out + ((size_t)b * SEQ + (s - CTXL)) * 1024;
#pragma unroll
            for (int j = 0; j < 4; ++j) { const int col = 4 * lane + 256 * j; *(f32x4*)(orow + col) = v[j] * rstd * fg[j]; }
        }
        te = ten; tp = tpn; r = rn;
    }
}
__device__ __forceinline__ void chunk_of(int pass, int step, bool& isctx, int& cidx) { isctx = step < 4; cidx = pass == 0 ? (isctx ? step : step - 4) : (isctx ? 3 - step : 35 - step); }

constexpr int RS_Q = 272, RS_T = 144;
constexpr int LR_QS = 0, LR_KS = LR_QS + 64 * RS_Q, LR_KT = LR_KS + 64 * RS_Q, LR_VT = LR_KT + 128 * RS_T, LR_ST = LR_VT + 128 * RS_T, LR_SC = LR_ST + 128 * RS_Q, LR_ROPE = LR_SC + 64 * RS_T, LR_YS = LR_ROPE + 96 * 32 * 8, LR_END = LR_YS + 64 * RS_Q;
static_assert(LR_END <= LCTL_OFF, "retention LDS");
__device__ __forceinline__ void ret_unit(Frame& F, int l, int b, int h, bool need_ctx) {
    LAS unsigned char* Qs = F.lds + LR_QS; LAS unsigned char* Ks = F.lds + LR_KS; LAS unsigned char* KT = F.lds + LR_KT; LAS unsigned char* VT = F.lds + LR_VT;
    LAS unsigned char* ST = F.lds + LR_ST; LAS unsigned char* Sc = F.lds + LR_SC; LAS unsigned char* Ys = F.lds + LR_YS;
    LAS f32x2* ROPE = (LAS f32x2*)(F.lds + LR_ROPE);
    const bf16* Pq = (const bf16*)(F.ws + WS_P) + 0 * PSTR + h * 128; const bf16* Pk = (const bf16*)(F.ws + WS_P) + 1 * PSTR + h * 128;
    const bf16* VTR = (const bf16*)(F.ws + WS_P) + 2 * PSTR + (size_t)(b * 1024 + h * 128) * SROW;
    const bf16* Pg = (const bf16*)(F.ws + WS_P) + 3 * PSTR + h * 128;
    bf16* AA = (bf16*)(F.ws + WS_AA) + h * 128;
    const float xf = F.in[I_RDF][l * 8 + h], xb = F.in[I_RDB][l * 8 + h];
    const float lf2 = -log1pf(expf(-xf)) * LOG2E, lb2 = -log1pf(expf(-xb)) * LOG2E;
    PHASE_IDS(); const int w = wave, fr = lane & 15, g = lane >> 4;
    const int rowb = b * SROW;
    __syncthreads();
    { const f32x2* rg_ = (const f32x2*)(F.ws + WS_ROPE); for (int i = tid; i < 96 * 32; i += 512) ROPE[i] = rg_[i]; }
    const int p = tid >> 3, sub = tid & 7, hf = sub >> 2, ig = sub & 3, d0 = 64 * hf + 8 * ig;
    const int pk_ = (p + 8 * sub) & 63;
    const int sg = tid & 7;
    for (int pass = 0; pass < 2; ++pass) {
        const float lg2 = pass ? lb2 : lf2; const float gC = fexp2(64.0f * lg2);
        f32x4 Sacc[8];
#pragma unroll
        for (int nd = 0; nd < 8; ++nd) Sacc[nd] = (f32x4){0.f, 0.f, 0.f, 0.f};
        __syncthreads();
        for (int i = tid; i < 128 * RS_Q / 4; i += 512) ((LAS unsigned*)ST)[i] = 0u;
        u32x4 qa, qb, ka, kb, vv[2];
#define RET_LOAD(step_) do { bool ic_; int ci_; chunk_of(pass, (step_), ic_, ci_); const int s0_ = ic_ ? 64 * ci_ : CTXL + 64 * ci_; const size_t ro_ = (size_t)(rowb + s0_ + p) * 1024 + d0; \
            ka = *(const u32x4*)(Pk + ro_); kb = *(const u32x4*)(Pk + ro_ + 32); qa = *(const u32x4*)(Pq + ro_); qb = *(const u32x4*)(Pq + ro_ + 32); \
            _Pragma("unroll") for (int i2 = 0; i2 < 2; ++i2) { const int it_ = tid + 512 * i2; vv[i2] = *(const u32x4*)(VTR + (size_t)(it_ >> 3) * SROW + s0_ + 8 * (it_ & 7)); } } while (0)
        RET_LOAD(0);
        for (int step = 0; step < 36; ++step) {
            bool isctx; int cidx; chunk_of(pass, step, isctx, cidx);
            const int row0 = rowb + (isctx ? 64 * cidx : CTXL + 64 * cidx);
            const bool do_out = !isctx || need_ctx;
            const size_t go = (size_t)(row0 + p) * 1024 + 16 * sg;
            {
                float cs[8], sn[8];
                if (!isctx) { const LAS f32x2* tab = ROPE + (hf ? (32 + p) * 32 : cidx * 32) + 8 * ig;
#pragma unroll
                    for (int e = 0; e < 8; ++e) { const f32x2 t = tab[e]; cs[e] = t.x; sn[e] = t.y; } }
                else {
#pragma unroll
                    for (int e = 0; e < 8; ++e) { cs[e] = 1.f; sn[e] = 0.f; } }
                float q1[8], q2[8], k1[8], k2[8];
#pragma unroll
                for (int e = 0; e < 8; ++e) { const float a = bfel(qa, e), c = bfel(qb, e); q1[e] = a * cs[e] - c * sn[e]; q2[e] = a * sn[e] + c * cs[e];
                    const float ak = bfel(ka, e), ck = bfel(kb, e); k1[e] = (ak * cs[e] - ck * sn[e]) * 0.08838834764831845f; k2[e] = (ak * sn[e] + ck * cs[e]) * 0.08838834764831845f; }
                if (do_out) {
                    u32x4 w1, w2;
                    w1.x = pk2(q1[0], q1[1]); w1.y = pk2(q1[2], q1[3]); w1.z = pk2(q1[4], q1[5]); w1.w = pk2(q1[6], q1[7]);
                    w2.x = pk2(q2[0], q2[1]); w2.y = pk2(q2[2], q2[3]); w2.z = pk2(q2[4], q2[5]); w2.w = pk2(q2[6], q2[7]);
                    *(LAS u32x4*)(Qs + p * RS_Q + d0 * 2) = w1; *(LAS u32x4*)(Qs + p * RS_Q + (d0 + 32) * 2) = w2;
                }
                u32x4 x1, x2;
                x1.x = pk2(k1[0], k1[1]); x1.y = pk2(k1[2], k1[3]); x1.z = pk2(k1[4], k1[5]); x1.w = pk2(k1[6], k1[7]);
                x2.x = pk2(k2[0], k2[1]); x2.y = pk2(k2[2], k2[3]); x2.z = pk2(k2[4], k2[5]); x2.w = pk2(k2[6], k2[7]);
                if (pass == 0 && do_out) { *(LAS u32x4*)(Ks + p * RS_Q + d0 * 2) = x1; *(LAS u32x4*)(Ks + p * RS_Q + (d0 + 32) * 2) = x2; }
#pragma unroll
                for (int e = 0; e < 8; ++e) { const unsigned a = x1[e >> 1], c = x2[e >> 1];
                    *(LAS unsigned short*)(KT + (d0 + e) * RS_T + pk_ * 2) = (unsigned short)((e & 1) ? (a >> 16) : (a & 0xffffu));
                    *(LAS unsigned short*)(KT + (d0 + 32 + e) * RS_T + pk_ * 2) = (unsigned short)((e & 1) ? (c >> 16) : (c & 0xffffu)); }
#pragma unroll
                for (int i2 = 0; i2 < 2; ++i2) { const int it = tid + 512 * i2; *(LAS u32x4*)(VT + (it >> 3) * RS_T + (it & 7) * 16) = vv[i2]; }
            }
            if (step + 1 < 36) RET_LOAD(step + 1);
            u32x4 f0 = (u32x4){0u, 0u, 0u, 0u}, f1 = f0, g0 = f0, g1 = f0;
            if (pass == 1 && do_out) { f0 = *(const u32x4*)(AA + go); f1 = *(const u32x4*)(AA + go + 8); g0 = *(const u32x4*)(Pg + go); g1 = *(const u32x4*)(Pg + go + 8); }
            __syncthreads();
            if (pass == 0 && do_out) {
                const int mi = w >> 1;
#pragma unroll
                for (int t = 0; t < 2; ++t) { const int nj = 2 * (w & 1) + t; f32x4 acc = (f32x4){0.f, 0.f, 0.f, 0.f};
#pragma unroll
                    for (int ks = 0; ks < 4; ++ks) { const bf16x8 kk = *(const LAS bf16x8*)(Ks + (16 * nj + fr) * RS_Q + (32 * ks + 8 * g) * 2), qq = *(const LAS bf16x8*)(Qs + (16 * mi + fr) * RS_Q + (32 * ks + 8 * g) * 2);
                        acc = MFMA16(kk, qq, acc); }
                    const int i = 16 * mi + fr; float dv_[4];
#pragma unroll
                    for (int r = 0; r < 4; ++r) { const int j = 16 * nj + 4 * g + r, dd = i - j; dv_[r] = acc[r] * fexp2(dd >= 0 ? (float)dd * lf2 : (float)(-dd) * lb2); }
                    u32x2 o; o.x = pk2(dv_[0], dv_[1]); o.y = pk2(dv_[2], dv_[3]); *(LAS u32x2*)(Sc + i * RS_T + (16 * nj + 4 * g) * 2) = o; }
            }
            if (pass == 0 && do_out) __syncthreads();
            if (do_out) {
                const int mi = w >> 1, nd0 = 4 * (w & 1);
                f32x4 a1[4], a2[4];
#pragma unroll
                for (int t = 0; t < 4; ++t) { a1[t] = (f32x4){0.f, 0.f, 0.f, 0.f}; a2[t] = (f32x4){0.f, 0.f, 0.f, 0.f}; }
                if (pass == 0) {
#pragma unroll
                    for (int ks = 0; ks < 2; ++ks) { const bf16x8 sc = *(const LAS bf16x8*)(Sc + (16 * mi + fr) * RS_T + (32 * ks + 8 * g) * 2);
#pragma unroll
                        for (int t = 0; t < 4; ++t) { const bf16x8 vf = *(const LAS bf16x8*)(VT + (16 * (nd0 + t) + fr) * RS_T + (32 * ks + 8 * g) * 2); a1[t] = MFMA16(vf, sc, a1[t]); } }
                }
#pragma unroll
                for (int ks = 0; ks < 4; ++ks) { const bf16x8 qq = *(const LAS bf16x8*)(Qs + (16 * mi + fr) * RS_Q + (32 * ks + 8 * g) * 2);
#pragma unroll
                    for (int t = 0; t < 4; ++t) { const bf16x8 sf = *(const LAS bf16x8*)(ST + (16 * (nd0 + t) + fr) * RS_Q + (32 * ks + 8 * g) * 2); a2[t] = MFMA16(sf, qq, a2[t]); } }
                const int il = 16 * mi + fr; const float xi = fexp2(pass == 0 ? (float)(il + 1) * lf2 : (float)(64 - il) * lb2);
#pragma unroll
                for (int t = 0; t < 4; ++t) { u32x2 o; o.x = pk2(a1[t][0] + xi * a2[t][0], a1[t][1] + xi * a2[t][1]); o.y = pk2(a1[t][2] + xi * a2[t][2], a1[t][3] + xi * a2[t][3]);
                    *(LAS u32x2*)(Ys + il * RS_Q + (16 * (nd0 + t) + 4 * g) * 2) = o; }
            }
            {
                bf16x8 af[2];
#pragma unroll
                for (int ks = 0; ks < 2; ++ks) { const int row = 16 * w + fr, rot = 8 * ((((row >> 6) << 2) | ((row >> 3) & 3))); const u32x4 kk = *(const LAS u32x4*)(KT + row * RS_T + ((32 * ks + 8 * g + rot) & 63) * 2); float z[8];
#pragma unroll
                    for (int e = 0; e < 8; ++e) { const int tok = 32 * ks + 8 * g + e; z[e] = bfel(kk, e) * fexp2(pass == 0 ? (float)(63 - tok) * lf2 : (float)tok * lb2); }
                    u32x4 o; o.x = pk2(z[0], z[1]); o.y = pk2(z[2], z[3]); o.z = pk2(z[4], z[5]); o.w = pk2(z[6], z[7]); af[ks] = __builtin_bit_cast(bf16x8, o); }
#pragma unroll
                for (int nd = 0; nd < 8; ++nd) { Sacc[nd] = Sacc[nd] * gC;
#pragma unroll
                    for (int ks = 0; ks < 2; ++ks) { const bf16x8 bb = *(const LAS bf16x8*)(VT + (16 * nd + fr) * RS_T + (32 * ks + 8 * g) * 2); Sacc[nd] = MFMA16(af[ks], bb, Sacc[nd]); } }
            }
            __syncthreads();
#pragma unroll
            for (int nd = 0; nd < 8; ++nd) { u32x2 o; o.x = pk2(Sacc[nd][0], Sacc[nd][1]); o.y = pk2(Sacc[nd][2], Sacc[nd][3]); *(LAS u32x2*)(ST + (16 * nd + fr) * RS_Q + (16 * w + 4 * g) * 2) = o; }
            if (do_out) {
                const u32x4 y0 = *(const LAS u32x4*)(Ys + p * RS_Q + 32 * sg), y1 = *(const LAS u32x4*)(Ys + p * RS_Q + 32 * sg + 16);
                if (pass == 0) { *(u32x4*)(AA + go) = y0; *(u32x4*)(AA + go + 8) = y1; }
                else {
                    float tv[16]; float ss = 0.f;
#pragma unroll
                    for (int e = 0; e < 8; ++e) { tv[e] = bfel(y0, e) + bfel(f0, e); tv[8 + e] = bfel(y1, e) + bfel(f1, e); ss += tv[e] * tv[e] + tv[8 + e] * tv[8 + e]; }
                    ss += __shfl_xor(ss, 1); ss += __shfl_xor(ss, 2); ss += __shfl_xor(ss, 4);
                    const float rstd = rsqrtf(ss * (1.0f / 128.0f) + NORM_EPS);
#pragma unroll
                    for (int e = 0; e < 8; ++e) { const float ga = bfel(g0, e), gb = bfel(g1, e); tv[e] *= rstd * ga * sigmoidf_(ga); tv[8 + e] *= rstd * gb * sigmoidf_(gb); }
                    u32x4 o0, o1;
                    o0.x = pk2(tv[0], tv[1]); o0.y = pk2(tv[2], tv[3]); o0.z = pk2(tv[4], tv[5]); o0.w = pk2(tv[6], tv[7]);
                    o1.x = pk2(tv[8], tv[9]); o1.y = pk2(tv[10], tv[11]); o1.z = pk2(tv[12], tv[13]); o1.w = pk2(tv[14], tv[15]);
                    *(u32x4*)(AA + go) = o0; *(u32x4*)(AA + go + 8) = o1;
                }
            }
        }
#undef RET_LOAD
    }
}
constexpr int NA_SC = 528, NA_SL = 1168;
constexpr int LN_VC = 0, LN_VL = LN_VC + 64 * NA_SC, LN_RPB = LN_VL + 64 * NA_SL, LN_END = LN_RPB + 512 * 4;
static_assert(LN_END <= LCTL_OFF, "NA LDS");
__device__ __forceinline__ int clampi(int v, int lo, int hi) { return v < lo ? lo : (v > hi ? hi : v); }
__device__ __forceinline__ void na_block(float (&s)[8], float& m, float& lsum, f32x4 (&O)[4], const u32x2 (&v)[4][2]) {
    const float mb = xrow_max(fmaxf(fmaxf(fmaxf(s[0], s[1]), fmaxf(s[2], s[3])), fmaxf(fmaxf(s[4], s[5]), fmaxf(s[6], s[7]))));
    const float mn = fmaxf(m, mb); const float alpha = fexp2(m - mn); m = mn;
    float ps = 0.f;
#pragma unroll
    for (int e = 0; e < 8; ++e) { s[e] = fexp2(s[e] - mn); ps += s[e]; }
    lsum = lsum * alpha + ps;
#pragma unroll
    for (int dt = 0; dt < 4; ++dt) O[dt] = O[dt] * alpha;
    u32x4 pw; pw.x = pk2(s[0], s[1]); pw.y = pk2(s[2], s[3]); pw.z = pk2(s[4], s[5]); pw.w = pk2(s[6], s[7]);
    const bf16x8 pf = __builtin_bit_cast(bf16x8, pw);
#pragma unroll
    for (int dt = 0; dt < 4; ++dt) { u32x4 vw; vw.x = v[dt][0].x; vw.y = v[dt][0].y; vw.z = v[dt][1].x; vw.w = v[dt][1].y; O[dt] = MFMA16(__builtin_bit_cast(bf16x8, vw), pf, O[dt]); }
}
__device__ __forceinline__ void na_block_loc(const float (&sv)[4], const bool (&sel)[4], float& m, float& lsum, f32x4 (&O)[4], const u32x2 (&v)[4][2]) {
    const float mb = xrow_max(fmaxf(fmaxf(sv[0], sv[1]), fmaxf(sv[2], sv[3])));
    const float mn = fmaxf(m, mb); const float alpha = fexp2(m - mn); m = mn;
    float e[4]; float ps = 0.f;
#pragma unroll
    for (int r = 0; r < 4; ++r) { e[r] = fexp2(sv[r] - mn); ps += e[r]; }
    lsum = lsum * alpha + ps;
#pragma unroll
    for (int dt = 0; dt < 4; ++dt) O[dt] = O[dt] * alpha;
    u32x4 pw; pw.x = pk2(sel[0] ? e[0] : 0.f, sel[1] ? e[1] : 0.f); pw.y = pk2(sel[2] ? e[2] : 0.f, sel[3] ? e[3] : 0.f);
    pw.z = pk2(sel[0] ? 0.f : e[0], sel[1] ? 0.f : e[1]); pw.w = pk2(sel[2] ? 0.f : e[2], sel[3] ? 0.f : e[3]);
    const bf16x8 pf = __builtin_bit_cast(bf16x8, pw);
#pragma unroll
    for (int dt = 0; dt < 4; ++dt) { u32x4 vw; vw.x = v[dt][0].x; vw.y = v[dt][0].y; vw.z = v[dt][1].x; vw.w = v[dt][1].y; O[dt] = MFMA16(__builtin_bit_cast(bf16x8, vw), pf, O[dt]); }
}
constexpr int LN_KC = LN_RPB + 512 * 4, LN2_END = LN_KC + 256 * 144;
static_assert(LN2_END <= LCTL_OFF, "NA LDS");
__device__ __forceinline__ int na_hi(int rp) { return clampi(2 * rp - 3, 0, 24) + 7; }
__device__ __forceinline__ void na_unit(Frame& F, int l, int b, int h, int rp0, int nrp) {
    LAS unsigned char* VC = F.lds + LN_VC; LAS unsigned char* VL = F.lds + LN_VL; LAS float* RPB = (LAS float*)(F.lds + LN_RPB); LAS unsigned char* KC = F.lds + LN_KC;
    const bf16* Pq = (const bf16*)(F.ws + WS_P) + 4 * PSTR + h * 64; const bf16* Pk = (const bf16*)(F.ws + WS_P) + 5 * PSTR + h * 64;
    const bf16* VTG = (const bf16*)(F.ws + WS_P) + 6 * PSTR + (size_t)(b * 16 + h) * 64 * SROW;
    bf16* AB = (bf16*)(F.ws + WS_AA) + PSTR + h * 64;
    PHASE_IDS(); const int w = wave, fr = lane & 15, g = lane >> 4;
    const int rowb = b * SROW;
    __syncthreads();
    const int sdh = tid >> 3, sch = tid & 7;
    const int rlo0 = clampi(2 * rp0 - 4, 0, 24);
    { u32x4 tk[4], tv[4], tl[9]; float rb = 0.f;
#pragma unroll
      for (int i = 0; i < 4; ++i) { const int it = tid + 512 * i; tk[i] = *(const u32x4*)(Pk + (size_t)(rowb + (it >> 3)) * 1024 + 8 * (it & 7)); tv[i] = *(const u32x4*)(VTG + (size_t)(it >> 5) * SROW + 8 * (it & 31)); }
#pragma unroll
      for (int i = 0; i < 9; ++i) tl[i] = *(const u32x4*)(VTG + (size_t)sdh * SROW + CTXL + (rlo0 + i) * 64 + 8 * sch);
      if (tid < 465) rb = F.in[I_RPB][((size_t)l * 16 + h) * 465 + tid];
      PIN8(tk[0], tk[1], tk[2], tk[3], tv[0], tv[1], tv[2], tv[3]); PIN8(tl[0], tl[1], tl[2], tl[3], tl[4], tl[5], tl[6], tl[7]); PIN4(tl[8], rb, tk[0], tk[1]);
#pragma unroll
      for (int i = 0; i < 4; ++i) { const int it = tid + 512 * i; *(LAS u32x4*)(KC + (it >> 3) * 144 + (it & 7) * 16) = tk[i]; *(LAS u32x4*)(VC + (it >> 5) * NA_SC + (it & 31) * 16) = tv[i]; }
#pragma unroll
      for (int i = 0; i < 9; ++i) *(LAS u32x4*)(VL + sdh * NA_SL + ((rlo0 + i) % 9) * 128 + sch * 16) = tl[i];
      if (tid < 465) RPB[tid] = rb * LOG2E; }
    const float qs = 0.125f * LOG2E;
    bf16x8 qfn[2], kn[4];
#define NA_LOADK(dst, R_) do { _Pragma("unroll") for (int t = 0; t < 2; ++t) { const bf16* kp = Pk + (size_t)(rowb + CTXL + (R_) * 64 + cspan + 16 * t + fr) * 1024 + 8 * g; dst[2 * t] = *(const bf16x8*)kp; dst[2 * t + 1] = *(const bf16x8*)(kp + 32); } } while (0)
    { const int q0 = 16 * (w & 3), cspan = clampi(q0 - 8, 0, 32), qr = 2 * rp0 + (w >> 2);
      NA_LOADK(kn, clampi(qr - 4, 0, 24));
#pragma unroll
      for (int ks = 0; ks < 2; ++ks) qfn[ks] = *(const bf16x8*)(Pq + (size_t)(rowb + CTXL + qr * 64 + q0 + fr) * 1024 + 32 * ks + 8 * g); }
    for (int rp = rp0; rp < rp0 + nrp; ++rp) {
        u32x4 nr0 = (u32x4){0u, 0u, 0u, 0u}, nr1 = nr0; const int hcur = na_hi(rp), hnxt = rp < rp0 + nrp - 1 ? na_hi(rp + 1) : hcur;
        if (hnxt > hcur) nr0 = *(const u32x4*)(VTG + (size_t)sdh * SROW + CTXL + (hcur + 1) * 64 + 8 * sch);
        if (hnxt > hcur + 1) nr1 = *(const u32x4*)(VTG + (size_t)sdh * SROW + CTXL + (hcur + 2) * 64 + 8 * sch);
        __syncthreads();
        const int ra = 2 * rp;
        const int qr = ra + (w >> 2), q0 = 16 * (w & 3); const int qrow = rowb + CTXL + qr * 64 + q0 + fr;
        bf16x8 qf[2]; qf[0] = qfn[0]; qf[1] = qfn[1];
        float m = -INFINITY, lsum = 0.f; f32x4 O[4]; float m2 = -INFINITY, lsum2 = 0.f; f32x4 O2[4];
#pragma unroll
        for (int dt = 0; dt < 4; ++dt) { O[dt] = (f32x4){0.f, 0.f, 0.f, 0.f}; O2[dt] = (f32x4){0.f, 0.f, 0.f, 0.f}; }
        const int r0 = clampi(qr - 4, 0, 24), cspan = clampi(q0 - 8, 0, 32); const int cq = q0 + fr, wst = clampi(cq - 8, 0, 48);
        bool sel[4]; int cixs[4];
#pragma unroll
        for (int r = 0; r < 4; ++r) { const int c0 = cspan + 4 * g + r; sel[r] = c0 >= wst; cixs[r] = clampi((sel[r] ? c0 : c0 + 16) - cq + 15, 0, 30); }
#pragma unroll
        for (int kb = 0; kb < 8; ++kb) {
            const int R = r0 + kb;
            u32x4 kc[2][2]; u32x2 vc[4][2], vl[4][2]; float rb[4];
#pragma unroll
            for (int t = 0; t < 2; ++t) { const LAS unsigned char* kp = KC + (32 * kb + 16 * t + fr) * 144 + 16 * g; kc[t][0] = *(const LAS u32x4*)kp; kc[t][1] = *(const LAS u32x4*)(kp + 64); }
#pragma unroll
            for (int r = 0; r < 4; ++r) rb[r] = RPB[(R - qr + 7) * 31 + cixs[r]];
#pragma unroll
            for (int dt = 0; dt < 4; ++dt) { const LAS unsigned char* vp = VC + (16 * dt + fr) * NA_SC + (32 * kb + 4 * g) * 2; vc[dt][0] = *(const LAS u32x2*)vp; vc[dt][1] = *(const LAS u32x2*)(vp + 32);
                const LAS unsigned char* vq = VL + (16 * dt + fr) * NA_SL + ((R % 9) * 64 + cspan + 4 * g) * 2; vl[dt][0] = *(const LAS u32x2*)vq; vl[dt][1] = *(const LAS u32x2*)(vq + 32); }
            __builtin_amdgcn_sched_barrier(0);
            float s[8];
#pragma unroll
            for (int t = 0; t < 2; ++t) { f32x4 a = (f32x4){0.f, 0.f, 0.f, 0.f};
                a = MFMA16(__builtin_bit_cast(bf16x8, kc[t][0]), qf[0], a); a = MFMA16(__builtin_bit_cast(bf16x8, kc[t][1]), qf[1], a);
#pragma unroll
                for (int r = 0; r < 4; ++r) s[4 * t + r] = a[r] * qs; }
            float sv[4];
            { f32x4 a0 = (f32x4){0.f, 0.f, 0.f, 0.f}, a1 = a0;
              a0 = MFMA16(kn[0], qf[0], a0); a0 = MFMA16(kn[1], qf[1], a0); a1 = MFMA16(kn[2], qf[0], a1); a1 = MFMA16(kn[3], qf[1], a1);
#pragma unroll
              for (int r = 0; r < 4; ++r) sv[r] = (sel[r] ? a0[r] : a1[r]) * qs + rb[r]; }
            if (kb < 7) NA_LOADK(kn, R + 1);
            else if (rp + 1 < rp0 + nrp) { const int qrn = ra + 2 + (w >> 2);
                NA_LOADK(kn, clampi(qrn - 4, 0, 24));
#pragma unroll
                for (int ks = 0; ks < 2; ++ks) qfn[ks] = *(const bf16x8*)(Pq + (size_t)(rowb + CTXL + qrn * 64 + q0 + fr) * 1024 + 32 * ks + 8 * g); }
            na_block(s, m, lsum, O, vc);
            na_block_loc(sv, sel, m2, lsum2, O2, vl);
        }
        { const float mm = fmaxf(m, m2); const float c1 = fexp2(m - mm), c2 = fexp2(m2 - mm); lsum = lsum * c1 + lsum2 * c2;
#pragma unroll
          for (int dt = 0; dt < 4; ++dt) O[dt] = O[dt] * c1 + O2[dt] * c2; }
        lsum = xrow_sum(lsum);
        const float inv = 1.0f / lsum;
#pragma unroll
        for (int dt = 0; dt < 4; ++dt) { u32x2 o; o.x = pk2(O[dt][0] * inv, O[dt][1] * inv); o.y = pk2(O[dt][2] * inv, O[dt][3] * inv); *(u32x2*)(AB + (size_t)qrow * 1024 + 16 * dt + 4 * g) = o; }
        __syncthreads();
        if (hnxt > hcur) *(LAS u32x4*)(VL + sdh * NA_SL + ((hcur + 1) % 9) * 128 + sch * 16) = nr0;
        if (hnxt > hcur + 1) *(LAS u32x4*)(VL + sdh * NA_SL + ((hcur + 2) % 9) * 128 + sch * 16) = nr1;
    }
#undef NA_LOADK
    __syncthreads();
}
constexpr int RS_UF = 528;
constexpr int LL_UB = 0, LL_UF = LL_UB + 64 * RS_Q, LL_HB = LL_UF + 64 * RS_UF, LL_CW = LL_HB + 64 * RS_UF, LL_END = LL_CW + 5 * 128 * 4;
static_assert(LL_END <= LCTL_OFF, "LRU LDS");
__device__ __forceinline__ float fsig(float x) { return __builtin_amdgcn_rcpf(1.0f + __builtin_amdgcn_exp2f(-x * LOG2E)); }
__device__ __forceinline__ float fgelu(float y) { const float z = 0.7978845608028654f * (y + 0.044715f * y * y * y); const float t = 1.0f - 2.0f * __builtin_amdgcn_rcpf(__builtin_amdgcn_exp2f(2.0f * LOG2E * z) + 1.0f); return 0.5f * y * (1.0f + t); }
template <int DIR> __device__ __forceinline__ void lru_scan(const float (&av)[4][4], const float (&bv)[4][4], float& hcar, LAS unsigned char* Hb, int co, int fr, int g) {
    float hl[4][4], cm[4][4], ce[4], he[4];
#pragma unroll
    for (int mt = 0; mt < 4; ++mt) { float h_ = 0.f, c_ = 1.f;
#pragma unroll
        for (int ri = 0; ri < 4; ++ri) { const int r = DIR == 0 ? ri : 3 - ri; h_ = av[mt][r] * h_ + bv[mt][r]; c_ *= av[mt][r]; hl[mt][r] = h_; cm[mt][r] = c_; }
        ce[mt] = c_; he[mt] = h_; }
    float P[4][4], H[4][4];
#pragma unroll
    for (int mt = 0; mt < 4; ++mt)
#pragma unroll
        for (int gg = 0; gg < 4; ++gg) { P[mt][gg] = __shfl(ce[mt], fr + 16 * gg); H[mt][gg] = __shfl(he[mt], fr + 16 * gg); }
    PIN8(P[0][0], P[0][1], P[0][2], P[0][3], H[0][0], H[0][1], H[0][2], H[0][3]); PIN8(P[1][0], P[1][1], P[1][2], P[1][3], H[1][0], H[1][1], H[1][2], H[1][3]);
    PIN8(P[2][0], P[2][1], P[2][2], P[2][3], H[2][0], H[2][1], H[2][2], H[2][3]); PIN8(P[3][0], P[3][1], P[3][2], P[3][3], H[3][0], H[3][1], H[3][2], H[3][3]);
    float x = hcar;
#pragma unroll
    for (int mi = 0; mi < 4; ++mi) { const int mt = DIR == 0 ? mi : 3 - mi; float xin = x;
#pragma unroll
        for (int gi = 0; gi < 4; ++gi) { const int gg = DIR == 0 ? gi : 3 - gi; if (g == gg) xin = x; x = P[mt][gg] * x + H[mt][gg]; }
#pragma unroll
        for (int r = 0; r < 4; ++r) *(LAS float*)(Hb + (16 * mt + 4 * g + r) * RS_UF + co * 4) = hl[mt][r] + cm[mt][r] * xin; }
    hcar = x;
}
__device__ __forceinline__ void lru_unit(Frame& F, int l, int b, int kblk, bool need_ctx) {
    LAS unsigned char* Ub = F.lds + LL_UB; LAS unsigned char* Uf = F.lds + LL_UF; LAS unsigned char* Hb = F.lds + LL_HB; LAS float* CW = (LAS float*)(F.lds + LL_CW);
    const int ch0 = 128 * kblk;
    const bf16* Plx = (const bf16*)(F.ws + WS_P) + 7 * PSTR + ch0; const bf16* Ply = (const bf16*)(F.ws + WS_P) + 8 * PSTR + ch0;
    bf16* AC = (bf16*)(F.ws + WS_AA) + 2 * PSTR + ch0;
    PHASE_IDS(); const int w = wave, fr = lane & 15, g = lane >> 4;
    const int rowb = b * SROW;
    __syncthreads();
    for (int i = tid; i < 5 * 128; i += 512) { const int j = i >> 7, c = i & 127; CW[i] = j < 4 ? F.in[I_CONVW][((size_t)l * 4 + j) * 1024 + ch0 + c] : F.in[I_CONVB][(size_t)l * 1024 + ch0 + c]; }
    __syncthreads();
    const int co = 16 * w + fr;
    const int p = tid >> 3, c0 = 16 * (tid & 7);
    for (int pass = 0; pass < 2; ++pass) {
        bf16x8 Bfa[4], Bfx[4];
        { const float* wa = F.in[I_GAW] + ((((size_t)l * 2 + pass) * 8 + kblk) * 128) * 128 + co; const float* wx = F.in[I_GXW] + ((((size_t)l * 2 + pass) * 8 + kblk) * 128) * 128 + co;
#pragma unroll
          for (int ks = 0; ks < 4; ++ks) { float ta[8], tx[8];
#pragma unroll
              for (int e = 0; e < 8; ++e) { const int ci = 32 * ks + 8 * g + e; ta[e] = wa[(size_t)ci * 128]; tx[e] = wx[(size_t)ci * 128]; }
              u32x4 oa, ox; oa.x = pk2(ta[0], ta[1]); oa.y = pk2(ta[2], ta[3]); oa.z = pk2(ta[4], ta[5]); oa.w = pk2(ta[6], ta[7]);
              ox.x = pk2(tx[0], tx[1]); ox.y = pk2(tx[2], tx[3]); ox.z = pk2(tx[4], tx[5]); ox.w = pk2(tx[6], tx[7]);
              Bfa[ks] = __builtin_bit_cast(bf16x8, oa); Bfx[ks] = __builtin_bit_cast(bf16x8, ox); } }
        const size_t vo = ((size_t)l * 2 + pass) * 1024 + ch0 + co;
        const float ba = F.in[I_GAB][vo], bx = F.in[I_GXB][vo]; const float nsp8 = -8.0f * LOG2E * log1pf(expf(-F.in[I_LAM][vo]));
        float hcar = 0.f;
        u32x4 xr[4][2];
#define LRU_LOAD_X(step_) do { bool ic_; int ci_; chunk_of(pass, (step_), ic_, ci_); const int sb_ = rowb + (ic_ ? 0 : CTXL), sl_ = ic_ ? CTXL : SEQ, tb_ = 64 * ci_; \
            _Pragma("unroll") for (int j = 0; j < 4; ++j) { const int tt = tb_ + p + j - 1; if (tt >= 0 && tt < sl_) { const bf16* xp = Plx + (size_t)(sb_ + tt) * 1024 + c0; xr[j][0] = *(const u32x4*)xp; xr[j][1] = *(const u32x4*)(xp + 8); } \
                else { xr[j][0] = (u32x4){0u, 0u, 0u, 0u}; xr[j][1] = (u32x4){0u, 0u, 0u, 0u}; } } } while (0)
        LRU_LOAD_X(0);
        for (int step = 0; step < 36; ++step) {
            bool isctx; int cidx; chunk_of(pass, step, isctx, cidx);
            const int segb = rowb + (isctx ? 0 : CTXL), t0 = 64 * cidx;
            const bool do_out = !isctx || need_ctx;
            const size_t go = (size_t)(segb + t0 + p) * 1024 + c0;
            { float u[16];
#pragma unroll
              for (int e = 0; e < 16; ++e) u[e] = CW[4 * 128 + c0 + e];
#pragma unroll
              for (int j = 0; j < 4; ++j) {
#pragma unroll
                  for (int e = 0; e < 8; ++e) { u[e] += CW[j * 128 + c0 + e] * bfel(xr[j][0], e); u[8 + e] += CW[j * 128 + c0 + 8 + e] * bfel(xr[j][1], e); } }
              u32x4 o0, o1; o0.x = pk2(u[0], u[1]); o0.y = pk2(u[2], u[3]); o0.z = pk2(u[4], u[5]); o0.w = pk2(u[6], u[7]);
              o1.x = pk2(u[8], u[9]); o1.y = pk2(u[10], u[11]); o1.z = pk2(u[12], u[13]); o1.w = pk2(u[14], u[15]);
              *(LAS u32x4*)(Ub + p * RS_Q + c0 * 2) = o0; *(LAS u32x4*)(Ub + p * RS_Q + c0 * 2 + 16) = o1;
#pragma unroll
              for (int q = 0; q < 4; ++q) *(LAS f32x4*)(Uf + p * RS_UF + (c0 + 4 * q) * 4) = (f32x4){u[4 * q], u[4 * q + 1], u[4 * q + 2], u[4 * q + 3]}; }
            if (step + 1 < 36) LRU_LOAD_X(step + 1);
            u32x4 pf0 = (u32x4){0u, 0u, 0u, 0u}, pf1 = pf0, py0 = pf0, py1 = pf0;
            if (pass == 1 && do_out) { pf0 = *(const u32x4*)(AC + go); pf1 = *(const u32x4*)(AC + go + 8); py0 = *(const u32x4*)(Ply + go); py1 = *(const u32x4*)(Ply + go + 8); }
            __syncthreads();
            float av[4][4], bv[4][4];
#pragma unroll
            for (int mh = 0; mh < 2; ++mh) {
                u32x4 af[2][4]; float uu[2][4];
#pragma unroll
                for (int mm = 0; mm < 2; ++mm) {
#pragma unroll
                    for (int ks = 0; ks < 4; ++ks) af[mm][ks] = *(const LAS u32x4*)(Ub + (16 * (2 * mh + mm) + fr) * RS_Q + (32 * ks + 8 * g) * 2);
#pragma unroll
                    for (int r = 0; r < 4; ++r) uu[mm][r] = *(const LAS float*)(Uf + (16 * (2 * mh + mm) + 4 * g + r) * RS_UF + co * 4); }
                PIN8(af[0][0], af[0][1], af[0][2], af[0][3], af[1][0], af[1][1], af[1][2], af[1][3]); PIN8(uu[0][0], uu[0][1], uu[0][2], uu[0][3], uu[1][0], uu[1][1], uu[1][2], uu[1][3]);
#pragma unroll
                for (int mm = 0; mm < 2; ++mm) { const int mt = 2 * mh + mm; f32x4 ga = (f32x4){0.f, 0.f, 0.f, 0.f}, gx = ga;
#pragma unroll
                    for (int ks = 0; ks < 4; ++ks) { const bf16x8 a = __builtin_bit_cast(bf16x8, af[mm][ks]); ga = MFMA16(a, Bfa[ks], ga); gx = MFMA16(a, Bfx[ks], gx); }
#pragma unroll
                    for (int r = 0; r < 4; ++r) { const float rr = fsig(ga[r] + ba), ii = fsig(gx[r] + bx);
                        const float a_ = __builtin_amdgcn_exp2f(nsp8 * rr);
                        av[mt][r] = a_; bv[mt][r] = __builtin_amdgcn_sqrtf(fmaxf(1.0f - a_ * a_, 0.f)) * ii * uu[mm][r]; } } }
            if (pass == 0) lru_scan<0>(av, bv, hcar, Hb, co, fr, g); else lru_scan<1>(av, bv, hcar, Hb, co, fr, g);
            __syncthreads();
            if (do_out) { float hv[16];
#pragma unroll
                for (int q = 0; q < 4; ++q) { const f32x4 t = *(const LAS f32x4*)(Hb + p * RS_UF + (c0 + 4 * q) * 4); hv[4 * q] = t.x; hv[4 * q + 1] = t.y; hv[4 * q + 2] = t.z; hv[4 * q + 3] = t.w; }
                if (pass == 1) {
#pragma unroll
                    for (int e = 0; e < 8; ++e) { hv[e] = (hv[e] + bfel(pf0, e)) * fgelu(bfel(py0, e)); hv[8 + e] = (hv[8 + e] + bfel(pf1, e)) * fgelu(bfel(py1, e)); } }
                u32x4 o0, o1; o0.x = pk2(hv[0], hv[1]); o0.y = pk2(hv[2], hv[3]); o0.z = pk2(hv[4], hv[5]); o0.w = pk2(hv[6], hv[7]);
                o1.x = pk2(hv[8], hv[9]); o1.y = pk2(hv[10], hv[11]); o1.z = pk2(hv[12], hv[13]); o1.w = pk2(hv[14], hv[15]);
                *(u32x4*)(AC + go) = o0; *(u32x4*)(AC + go + 8) = o1; }
        }
#undef LRU_LOAD_X
        __syncthreads();
    }
}

__device__ __forceinline__ int queue_pop(Frame& F, unsigned* q) {
    __syncthreads();
    if (threadIdx.x == 0) F.MISC[0] = atomicAdd(q, 1u);
    __syncthreads();
    return (int)F.MISC[0];
}
#ifndef PHMASK
#define PHMASK 0xffff
#endif
#define PHM(b) ((PHMASK >> (b)) & 1)
__device__ __forceinline__ void p3_convert_chunks(Frame& F, unsigned* qc) {
    for (;;) { const int q = queue_pop(F, qc); if (q >= P0_NCHUNK) break; PHASE_IDS(); p0_convert(F, P0_I2 + q * P0_CHUNK + wave, 8, P0_I2 + (q + 1) * P0_CHUNK, wave, lane); }
}
__device__ __forceinline__ void p3_mixers(Frame& F, int l, bool need_ctx, int rep, int qmask) {
    unsigned* q = F.ctl + CW_Q + (l * 3 + rep * 6) * 64;
    const bool conv = (l == 0 && rep == 0); unsigned* qc = F.ctl + CW_Q + 13 * 64;
    if (PHM(3) && (qmask & 1)) for (;;) { const int u = queue_pop(F, q); if (u >= NB * 8) break; ret_unit(F, l, u >> 3, u & 7, need_ctx); }
    if (PHM(4) && (qmask & 2)) for (;;) { const int u = queue_pop(F, q + 64); if (u >= NB * 8) break; lru_unit(F, l, u >> 3, u & 7, need_ctx); }
    bool cleft = conv;
    if (PHM(5) && (qmask & 4)) for (;;) { const int u = queue_pop(F, q + 128); if (u >= 640) break;
        const int v = u - 384; const int pr = u < 384 ? (u >> 1) : 192 + (v >> 2); const int r0_ = u < 384 ? 8 * (u & 1) : 4 * (v & 3);
        na_unit(F, l, pr >> 4, pr & 15, r0_, u < 384 ? 8 : 4);
        if (cleft && u >= 128) { const int qq = queue_pop(F, qc); if (qq < P0_NCHUNK) { PHASE_IDS(); p0_convert(F, P0_I2 + qq * P0_CHUNK + wave, 8, P0_I2 + (qq + 1) * P0_CHUNK, wave, lane); } else cleft = false; } }
    if (cleft) p3_convert_chunks(F, qc);
}
__global__ void __launch_bounds__(512, 2) fwd_kernel(Args args) {
    extern __shared__ __attribute__((aligned(16))) unsigned char lds[];
    Frame F;
    F.lds = (LAS unsigned char*)lds; F.MISC = (volatile LAS unsigned*)(F.lds + LCTL_OFF);
    F.G = gridDim.x; F.c = blockIdx.x; F.vcu = (F.G % 8 == 0) ? (F.c % 8) * (F.G / 8) + F.c / 8 : F.c;
    F.ws = args.ws; F.ctl = (unsigned*)(args.ws + WS_CTL); F.in = args.in;
    for (int u = threadIdx.x; u < (LDS_BYTES - LCTL_OFF) / 4; u += 512) ((LAS unsigned*)(F.lds + LCTL_OFF))[u] = 0u;
    __syncthreads();
    XcdBarrier bar; bar.bar = F.ctl + CW_BAR; bar.x = 0; bar.st = nullptr;
    if (!MK_PER_PHASE) bar = xcd_barrier_post(F.ctl + CW_BAR, F.MISC + 8);
    const int lo = args.ph_lo, hi = args.ph_hi;
#ifndef PHMASK
#define PHMASK 0xffff
#endif
#define PHM(b) ((PHMASK >> (b)) & 1)
#define IN(k) (lo <= (k) && (k) < hi)
#define SEAM(k) do { if (IN(k) && IN((k) + 1)) xcd_barrier(bar); } while (0)
    volatile LAS int* toff = (volatile LAS int*)(F.lds + LCTL_OFF + 256);

    if (PHM(0) && IN(0)) { p0_prologue(F, 1 + ((REP_MASK >> 2) & 1)); } SEAM(0);
    if (PHM(1) && IN(1)) { p1_norm1(F); } SEAM(1);
    for (int l = 0; l < DEPTH; ++l) {
        const int pb = 2 + 9 * l; const bool last = (l == DEPTH - 1);
        if (PHM(2) && IN(pb + 0)) {
            SchedDense S; S.init(F.ws + WS_H, F.ws + WS_WMIX + (size_t)l * 12288 * 1024 * 2, 1024, 48, false, F.G, F.c, true);
            EpiProj E{(bf16*)(F.ws + WS_P)};
            for (int rep = 0; rep < 1 + (REP_MASK & 1); ++rep) pg8::gemm_phase<EpiProj, SchedDense, true>(F.lds, 1024, S, E);
        } SEAM(pb + 0);
        if (IN(pb + 1)) { constexpr int nrep = 1 + (((REP_MASK >> 3) & 7) ? 1 : 0); for (int rep = 0; rep < nrep; ++rep) { p3_mixers(F, l, !last, rep, rep == 0 ? 7 : ((REP_MASK >> 3) & 7)); if (rep + 1 < nrep) xcd_barrier(bar); } } SEAM(pb + 1);
        if (PHM(6) && IN(pb + 2)) {
            SchedBranch S; S.init(F.ws + WS_AA, F.ws + WS_WBR + (size_t)l * 3 * 1024 * 1024 * 2, last, F.G, F.c);
            EpiBranch E{(const bf16*)(F.ws + WS_P) + 9 * PSTR, (bf16*)(F.ws + WS_MB)};
            for (int rep = 0; rep < 1 + (REP_MASK & 1); ++rep) pg8::gemm_phase<EpiBranch, SchedBranch, true>(F.lds, 1024, S, E);
        } SEAM(pb + 2);
        if (PHM(7) && IN(pb + 3)) {
            SchedDense S; S.init(F.ws + WS_MB, F.ws + WS_WOUT + (size_t)l * 1024 * 1024 * 2, 1024, 4, last, F.G, F.c);
            if (l == 0) { EpiOut<true> E{F.in[I_X], F.in[I_CTX], (bf16*)(F.ws + WS_X), (const float*)(F.ws + WS_MODV)}; pg8::gemm_phase<EpiOut<true>, SchedDense, true>(F.lds, 1024, S, E); }
            else { EpiOut<false> E{F.in[I_X], F.in[I_CTX], (bf16*)(F.ws + WS_X), (const float*)(F.ws + WS_MODV) + (size_t)l * 17 * 6144}; pg8::gemm_phase<EpiOut<false>, SchedDense, true>(F.lds, 1024, S, E); }
        } SEAM(pb + 3);
        if (PHM(8) && IN(pb + 4)) { p6_router(F, l, last); } SEAM(pb + 4);
        if (PHM(10) && IN(pb + 6)) {
            moe_toff(F, l, toff);
            SchedMoE<true> S; S.init(F.ws + WS_H, F.ws + WS_WUP + (size_t)l * 32 * 2048 * 1024, (size_t)2048 * 1024, toff, 8, F.G, F.c, (const int*)(F.ws + WS_ROWMAP));
            EpiUp E{(unsigned char*)(F.ws + WS_ACT), F.in[I_BUP] + (size_t)l * 32 * 2048};
            for (int rep = 0; rep < 1 + (REP_MASK & 1); ++rep) pg8::gemm_phase<EpiUp, SchedMoE<true>, true>(F.lds, 512, S, E);
        } SEAM(pb + 6);
        if (PHM(11) && IN(pb + 7)) {
            moe_toff(F, l, toff);
            SchedMoE<false> S; S.init(F.ws + WS_ACT, F.ws + WS_WDN + (size_t)l * 32 * 1024 * 1024, (size_t)1024 * 1024, toff, 4, F.G, F.c, nullptr);
            EpiDown E{(unsigned char*)(F.ws + WS_H2S), F.in[I_BDN] + (size_t)l * 32 * 1024, (const float*)(F.ws + WS_ROWW)};
            for (int rep = 0; rep < 1 + (REP_MASK & 1); ++rep) pg8::gemm_phase<EpiDown, SchedMoE<false>, true>(F.lds, 512, S, E);
        } SEAM(pb + 7);
        if (PHM(12) && IN(pb + 8)) { p9_combine(F, l, last, args.out); } SEAM(pb + 8);
    }
#undef IN
#undef SEAM
}

extern "C" void kernel_launch(void* const* d_in, const int* in_sizes, int n_in, void* d_out, int out_size, void* d_ws, size_t ws_size, hipStream_t stream) {
    static int grid = 0;
    if (grid == 0) {
        if (n_in != 28 || ws_size < WS_END) { fprintf(stderr, "kernel_launch: expected 28 inputs and >= %zu bytes of workspace; got %d, %zu\n", (size_t)WS_END, n_in, ws_size); grid = -1; return; }
        int dev = 0, cus = 0, per_cu = 0;
        if (hipGetDevice(&dev) != hipSuccess || hipDeviceGetAttribute(&cus, hipDeviceAttributeMultiprocessorCount, dev) != hipSuccess) { grid = -1; return; }
        if (hipFuncSetAttribute((const void*)fwd_kernel, hipFuncAttributeMaxDynamicSharedMemorySize, LDS_BYTES) != hipSuccess) { fprintf(stderr, "kernel_launch: hipFuncSetAttribute failed\n"); grid = -1; return; }
        if (hipOccupancyMaxActiveBlocksPerMultiprocessor(&per_cu, (const void*)fwd_kernel, 512, LDS_BYTES) != hipSuccess || per_cu < 1) fprintf(stderr, "kernel_launch: occupancy query reports %d\n", per_cu);
        (void)hipGetLastError();
        grid = cus > 256 ? 256 : cus;
    }
    if (grid < 0) return;
    if (hipMemsetAsync((char*)d_ws + WS_CTL, 0, CTL_ZERO_BYTES, stream) != hipSuccess) return;
    Args a{};
    for (int i = 0; i < 28; ++i) a.in[i] = (const float*)d_in[i];
    a.out = (float*)d_out; a.ws = (unsigned char*)d_ws;
#if MK_PER_PHASE
    for (int p = 0; p < N_PHASES; ++p) { a.ph_lo = p; a.ph_hi = p + 1; hipLaunchKernelGGL(fwd_kernel, dim3(grid), dim3(512), LDS_BYTES, stream, a); }
#else
    a.ph_lo = 0; a.ph_hi = N_PHASES;
    hipLaunchKernelGGL(fwd_kernel, dim3(grid), dim3(512), LDS_BYTES, stream, a);
#endif
    const hipError_t le = hipPeekAtLastError();
    if (le != hipSuccess) fprintf(stderr, "kernel_launch: launch failed: %s\n", hipGetErrorName(le));
}
```

```cpp
#include <hip/hip_runtime.h>
#include <cstdio>
#include <cstdint>

#define GAS __attribute__((address_space(1)))
#define LAS __attribute__((address_space(3)))
typedef unsigned short bf16;
typedef short bf16x8 __attribute__((ext_vector_type(8)));
typedef float f32x4 __attribute__((ext_vector_type(4)));
typedef float f32x2 __attribute__((ext_vector_type(2)));
typedef unsigned u32x4 __attribute__((ext_vector_type(4)));
typedef unsigned u32x2 __attribute__((ext_vector_type(2)));
typedef GAS unsigned gu32;

constexpr int D = 1024, NB = 16, SEQ = 2048, CTXL = 256, SROW = CTXL + SEQ, NROWS = NB * SROW, DEPTH = 2;
constexpr int INW = 12288, NEXP = 32, DEXP = 1024;
constexpr size_t PSTR = (size_t)NROWS * 1024;
constexpr int MAXSORT = NROWS * 4 + NEXP * 256;
constexpr float NORM_EPS = 1e-6f;
constexpr float LOG2E = 1.4426950408889634f;

constexpr size_t MiB = 1u << 20;
constexpr size_t WS_CTL = 0, CTL_ZERO_BYTES = 1 * MiB;
constexpr size_t WS_MODV = 1 * MiB;
constexpr size_t WS_ROPE = 2 * MiB;
constexpr size_t WS_TOKE = 3 * MiB, WS_TOKP = 4 * MiB, WS_TOKW = 5 * MiB;
constexpr size_t WS_WMIX = 8 * MiB;
constexpr size_t WS_WBR = 56 * MiB;
constexpr size_t WS_WOUT = 68 * MiB;
constexpr size_t WS_WUP = 72 * MiB;
constexpr size_t WS_WDN = 328 * MiB;
constexpr size_t WS_X = 456 * MiB;
constexpr size_t WS_H8IN = 528 * MiB;
constexpr size_t WS_H = 600 * MiB;
constexpr size_t WS_P = 672 * MiB;
constexpr size_t WS_AA = 1536 * MiB;
constexpr size_t WS_END = 1752 * MiB;
constexpr size_t WS_ROWMAP = WS_P + 10 * 72 * MiB;
constexpr size_t WS_ROWW = WS_ROWMAP + 8 * MiB;
constexpr size_t WS_M32 = WS_P;
constexpr size_t WS_MB = WS_P + 2 * 72 * MiB;
constexpr size_t WS_ACT = WS_P;
constexpr size_t WS_H2S = WS_P + 5 * 72 * MiB;
static_assert(PSTR * 2 == 72 * MiB && (size_t)MAXSORT * 2048 == 304 * MiB && WS_H2S + 304 * MiB <= WS_AA, "ws map");
constexpr int CW_TMO = 0, CW_BAR = 4096, CW_Q = 8192, CW_CNT = 10240;
constexpr int LDS_BYTES = 163840, LCTL_OFF = 162816;
constexpr int N_PHASES = 20;
#ifndef REP_MASK
#define REP_MASK 0
#endif
#ifndef MK_PER_PHASE
#define MK_PER_PHASE 0
#endif

__device__ __forceinline__ float bflo(unsigned w) { return __uint_as_float(w << 16); }
__device__ __forceinline__ float bfhi(unsigned w) { return __uint_as_float(w & 0xffff0000u); }
__device__ __forceinline__ float xrow_max(float x) {
    { const auto r = __builtin_amdgcn_permlane16_swap(__float_as_uint(x), __float_as_uint(x), false, false); x = fmaxf(__uint_as_float(r[0]), __uint_as_float(r[1])); }
    { const auto r = __builtin_amdgcn_permlane32_swap(__float_as_uint(x), __float_as_uint(x), false, false); x = fmaxf(__uint_as_float(r[0]), __uint_as_float(r[1])); }
    return x;
}
__device__ __forceinline__ float xrow_sum(float x) {
    { const auto r = __builtin_amdgcn_permlane16_swap(__float_as_uint(x), __float_as_uint(x), false, false); x = __uint_as_float(r[0]) + __uint_as_float(r[1]); }
    { const auto r = __builtin_amdgcn_permlane32_swap(__float_as_uint(x), __float_as_uint(x), false, false); x = __uint_as_float(r[0]) + __uint_as_float(r[1]); }
    return x;
}
#define PIN4(a, b, c, d) asm volatile("" : "+v"(a), "+v"(b), "+v"(c), "+v"(d))
#define PIN8(a, b, c, d, e, f, g, h) asm volatile("" : "+v"(a), "+v"(b), "+v"(c), "+v"(d), "+v"(e), "+v"(f), "+v"(g), "+v"(h))
__device__ __forceinline__ f32x4 bf4(const u32x2& w) { return (f32x4){bflo(w.x), bfhi(w.x), bflo(w.y), bfhi(w.y)}; }
__device__ __forceinline__ float bfel(const u32x4& w, int e) { const unsigned x = w[e >> 1]; return (e & 1) ? bfhi(x) : bflo(x); }
__device__ __forceinline__ unsigned f2bf(float f) { unsigned u = __float_as_uint(f); return (u + 0x7fffu + ((u >> 16) & 1u)) >> 16; }
typedef __bf16 bf16x2_t __attribute__((ext_vector_type(2)));
__device__ __forceinline__ unsigned pk2(float lo, float hi) { const f32x2 v = {lo, hi}; return __builtin_bit_cast(unsigned, __builtin_convertvector(v, bf16x2_t)); }
__device__ __forceinline__ float wave_sum(float v) {
#pragma unroll
    for (int o = 1; o < 64; o <<= 1) v += __shfl_xor(v, o);
    return v;
}
__device__ __forceinline__ float wave_max(float v) {
#pragma unroll
    for (int o = 1; o < 64; o <<= 1) v = fmaxf(v, __shfl_xor(v, o));
    return v;
}
__device__ __forceinline__ float fexp2(float x) { return __builtin_amdgcn_exp2f(x); }
__device__ __forceinline__ float sigmoidf_(float x) { return __builtin_amdgcn_rcpf(1.0f + __builtin_amdgcn_exp2f(-x * LOG2E)); }
__device__ __forceinline__ float gelu_tanh(float y) { const float z = 0.7978845608028654f * (y + 0.044715f * y * y * y); const float t = 1.0f - 2.0f / (__expf(2.0f * z) + 1.0f); return 0.5f * y * (1.0f + t); }
#define LDS_WAIT() asm volatile("s_waitcnt lgkmcnt(0)" ::: "memory")
#define VM_WAIT() asm volatile("s_waitcnt vmcnt(0)" ::: "memory")
#define RLX_AGENT __ATOMIC_RELAXED, __HIP_MEMORY_SCOPE_AGENT
#define MFMA16(a, b, c) __builtin_amdgcn_mfma_f32_16x16x32_bf16((a), (b), (c), 0, 0, 0)
__device__ __forceinline__ int opaque_tid() { int t = threadIdx.x; asm volatile("" : "+v"(t)); return t; }
typedef int i32x4v __attribute__((ext_vector_type(4)));
typedef int i32x8v __attribute__((ext_vector_type(8)));
__device__ __forceinline__ unsigned pk4_fp8(float a, float b, float c, float d) { int p = 0; p = __builtin_amdgcn_cvt_pk_fp8_f32(a, b, p, false); p = __builtin_amdgcn_cvt_pk_fp8_f32(c, d, p, true); return (unsigned)p; }
constexpr float W8_SCALE = 32.0f, ACT8_SCALE = 4.0f, Y8_SCALE = 16.0f;
constexpr int E8_ONE = 0x7F7F7F7F, E8_W = 0x7A7A7A7A, E8_ACT = 0x7D7D7D7D;
#ifndef RELAX_EPI
#define RELAX_EPI 0
#endif
#ifndef STAGGER_TICKS
#define STAGGER_TICKS 0
#endif
namespace pg8 {
#define PG8_LAS __attribute__((address_space(3)))
constexpr int BM = 256, BK = 64, HALF = 128, HTB = HALF * BK * 2, STAGE_BYTES = 8 * HTB, NXCD = 8, WGM = 8;
__host__ __device__ __forceinline__ int lds_byte(int r, int c) { const int st = (r >> 4) * 2 + (c >> 5), rr = r & 15, cc = c & 31, ob = rr * 64 + cc * 2; return st * 1024 + (ob ^ (((ob >> 9) & 1) << 5)); }
__host__ __device__ __forceinline__ void stage_rc(int b, int& R, int& C) { const int st = b / 1024, sb = b % 1024, swz = sb ^ (((sb >> 9) & 1) << 5); R = (st >> 1) * 16 + swz / 64; C = (st & 1) * 32 + (swz % 64) / 2; }
__host__ __device__ __forceinline__ int perm32(int rho) { const int n = rho >> 4, i = rho & 15; return 8 * (i >> 2) + 4 * n + (i & 3); }
struct Unit { int pm, pn, aux, lt; };
struct StaticOrder {
    int nM, nN, nwg, G, c;
    __device__ __forceinline__ void init(int nM_, int nN_, int G_, int c_) { nM = nM_; nN = nN_; nwg = nM * nN; G = G_; c = c_; }
    __device__ __forceinline__ bool next(int i, int& pm, int& pn) const {
        const long L = (long)i * G + c; if (L >= nwg) return false;
        int wgid = (int)L; { const int q = nwg / NXCD, r = nwg % NXCD, xcd = wgid % NXCD, off = wgid / NXCD; wgid = (xcd < r ? xcd * (q + 1) : r * (q + 1) + (xcd - r) * q) + off; }
        const int nig = WGM * nN, gid = wgid / nig, fm = gid * WGM, gsz = (nM - fm) < WGM ? (nM - fm) : WGM;
        pm = fm + ((wgid % nig) % gsz); pn = (wgid % nig) / gsz; return true;
    }
};
template <class Epi, class Sched, bool ALIGN_EPI>
__device__ __forceinline__ void gemm_phase(PG8_LAS unsigned char* lds, const int K, const Sched& S, const Epi& E) {
    const int tid = opaque_tid(), wid = __builtin_amdgcn_readfirstlane(tid >> 6), lane = tid & 63, wr = wid >> 2, wc = wid & 3, fr = lane & 15, fq = lane >> 4;
    const int nt = K / BK;
    constexpr int NE = Epi::NST < 48 ? Epi::NST : 48;
    unsigned voffA[2], voffB[2];
#pragma unroll
    for (int i = 0; i < 2; ++i) { int R, C; stage_rc(tid * 16 + i * 8192, R, C); const int Rb = Epi::PERM ? ((R & ~31) + perm32(R & 31)) : R;
        voffA[i] = (unsigned)(R * K + C) * 2u; voffB[i] = (unsigned)(Rb * K + C) * 2u; }
    unsigned cao[2][2], nao[2][2];
#define PG8_GMAP_ISSUE(u_) do { _Pragma("unroll") for (int h_ = 0; h_ < 2; ++h_) _Pragma("unroll") for (int i_ = 0; i_ < 2; ++i_) \
        { int R_, C_; int t_ = opaque_tid(); stage_rc(t_ * 16 + i_ * 8192, R_, C_); __builtin_amdgcn_global_load_lds((const unsigned*)S.row_ptr((u_), h_ * 128 + R_), (PG8_LAS unsigned*)(lds + Sched::GMAP_OFF + wid * 1024 + (h_ * 2 + i_) * 256), 4, 0, 0); } } while (0)
#define PG8_GMAP_READ(dst, u_) do { _Pragma("unroll") for (int h_ = 0; h_ < 2; ++h_) _Pragma("unroll") for (int i_ = 0; i_ < 2; ++i_) { \
        int R_, C_; int t_ = opaque_tid(); stage_rc(t_ * 16 + i_ * 8192, R_, C_); \
        const unsigned tok_ = *(const volatile PG8_LAS unsigned*)(lds + Sched::GMAP_OFF + wid * 1024 + (h_ * 2 + i_) * 256 + (t_ & 63) * 4); \
        dst[h_][i_] = (S.row_valid((u_), h_ * 128 + R_) ? tok_ : 0u) * (unsigned)(K * 2) + (unsigned)(C_ * 2); } } while (0)
    const size_t kstep = (size_t)(BK * 2);
    const size_t hstep = (size_t)HALF * K * 2;
    const unsigned ldsw = (unsigned)wid * 1024u;
    const int aoff = lds_byte(wr * 64 + fr, fq * 8), boff = lds_byte(wc * 32 + fr, fq * 8);
#define PG8_SA(b, h) (((b) * 2 + (h)) * HTB)
#define PG8_SB(b, h) ((4 + (b) * 2 + (h)) * HTB)
#define PG8_STAGE(bufoff, gbase, voff) do { _Pragma("unroll") for (int _i = 0; _i < 2; ++_i) \
        __builtin_amdgcn_global_load_lds((const unsigned*)((const char*)(gbase) + (voff)[_i]), (PG8_LAS unsigned*)(lds + (bufoff) + ldsw + _i * 8192), 16, 0, 0); } while (0)
#define PG8_LDA(dst, b, h) do { if constexpr (Sched::FP8) { _Pragma("unroll") for (int m = 0; m < 4; ++m) { const i32x4v lo_ = *(const PG8_LAS i32x4v*)(lds + PG8_SA(b, h) + aoff + m * 2048), hi_ = *(const PG8_LAS i32x4v*)(lds + PG8_SA(b, h) + aoff + m * 2048 + 1024); \
            dst##8[m] = __builtin_shufflevector(lo_, hi_, 0, 1, 2, 3, 4, 5, 6, 7); } } \
        else { _Pragma("unroll") for (int m = 0; m < 4; ++m) _Pragma("unroll") for (int k = 0; k < 2; ++k) dst[m][k] = *(const PG8_LAS bf16x8*)(lds + PG8_SA(b, h) + aoff + m * 2048 + k * 1024); } } while (0)
#define PG8_LDB(dst, b, h) do { if constexpr (Sched::FP8) { _Pragma("unroll") for (int n = 0; n < 2; ++n) { const i32x4v lo_ = *(const PG8_LAS i32x4v*)(lds + PG8_SB(b, h) + boff + n * 2048), hi_ = *(const PG8_LAS i32x4v*)(lds + PG8_SB(b, h) + boff + n * 2048 + 1024); \
            dst##8[n] = __builtin_shufflevector(lo_, hi_, 0, 1, 2, 3, 4, 5, 6, 7); } } \
        else { _Pragma("unroll") for (int n = 0; n < 2; ++n) _Pragma("unroll") for (int k = 0; k < 2; ++k) dst[n][k] = *(const PG8_LAS bf16x8*)(lds + PG8_SB(b, h) + boff + n * 2048 + k * 1024); } } while (0)
#define PG8_MMA(ai, bj, At, Bt) do { __builtin_amdgcn_s_setprio(1); \
        if constexpr (Sched::FP8) { _Pragma("unroll") for (int m = 0; m < 4; ++m) _Pragma("unroll") for (int n = 0; n < 2; ++n) \
            asm volatile("v_mfma_scale_f32_16x16x128_f8f6f4 %0, %1, %2, %0, %3, %4 op_sel_hi:[0,0,0]" : "+v"(acc[ai][bj][m][n]) : "v"(Bt##8[n]), "v"(At##8[m]), "v"(e8b_), "v"(e8a_)); } \
        else { _Pragma("unroll") for (int m = 0; m < 4; ++m) _Pragma("unroll") for (int n = 0; n < 2; ++n) _Pragma("unroll") for (int k = 0; k < 2; ++k) \
            acc[ai][bj][m][n] = __builtin_amdgcn_mfma_f32_16x16x32_bf16(Bt[n][k], At[m][k], acc[ai][bj][m][n], 0, 0, 0); } \
        __builtin_amdgcn_s_setprio(0); } while (0)
#define PG8_WAIT_V(n) asm volatile("s_waitcnt vmcnt(" #n ")" ::: "memory")
#define PG8_WAIT_VN(N) asm volatile("s_waitcnt vmcnt(%0)" :: "n"(N) : "memory")
#define PG8_WAIT_L(n) asm volatile("s_waitcnt lgkmcnt(" #n ")" ::: "memory")
#define PG8_BAR __builtin_amdgcn_s_barrier()
#define PG8_SCHED __builtin_amdgcn_sched_barrier(0)
    Unit cur, nxt; int ui = 0;
    if (!S.next(0, cur)) return;
    if (STAGGER_TICKS > 0) {
        const unsigned long long t0 = __builtin_amdgcn_s_memrealtime(); const unsigned long long dl = (unsigned long long)((blockIdx.x >> 3) & 15) * STAGGER_TICKS;
        while (__builtin_amdgcn_s_memrealtime() - t0 < dl) __builtin_amdgcn_s_sleep(16);
    }
    f32x4 acc[2][2][4][2];
#pragma unroll
    for (int a = 0; a < 2; ++a)
#pragma unroll
        for (int b = 0; b < 2; ++b)
#pragma unroll
            for (int m = 0; m < 4; ++m)
#pragma unroll
                for (int n = 0; n < 2; ++n) acc[a][b][m][n] = (f32x4){0.f, 0.f, 0.f, 0.f};
    bf16x8 At[4][2], B0[2][2], B1[2][2]; i32x8v At8[4], B08[2], B18[2]; const int e8a_ = Sched::E8_A, e8b_ = Sched::E8_B; (void)e8a_; (void)e8b_;
    const char* cA = S.a_base(cur); const char* cB = S.b_base(cur);
    if constexpr (Sched::GATHER) { PG8_GMAP_ISSUE(cur); asm volatile("s_waitcnt vmcnt(0)" ::: "memory"); PG8_GMAP_READ(cao, cur); }
#define PG8_STAGE_A(bufoff, h, ptr, kb, useN) do { if constexpr (Sched::GATHER) { unsigned so_[2]; so_[0] = (useN) ? nao[h][0] : cao[h][0]; so_[1] = (useN) ? nao[h][1] : cao[h][1]; PG8_STAGE(bufoff, S.a_gather_base() + (kb), so_); } \
        else { PG8_STAGE(bufoff, ptr, voffA); } } while (0)
    PG8_STAGE(PG8_SB(0, 0), cB, voffB); PG8_STAGE(PG8_SB(0, 1), cB + hstep, voffB); PG8_STAGE_A(PG8_SA(0, 0), 0, cA, 0, false); PG8_STAGE_A(PG8_SA(0, 1), 1, cA + hstep, 0, false);
    if (wr == 1) PG8_BAR;
    PG8_WAIT_V(2); PG8_BAR;
    PG8_STAGE(PG8_SB(1, 0), cB + kstep, voffB); PG8_STAGE_A(PG8_SA(1, 0), 0, cA + kstep, kstep, false); PG8_STAGE(PG8_SB(1, 1), cB + hstep + kstep, voffB);
    PG8_WAIT_V(6); PG8_BAR;
    for (;;) {
        const bool has_next = S.next(ui + 1, nxt);
        const char* nA = has_next ? S.a_base(nxt) : cA; const char* nB = has_next ? S.b_base(nxt) : cB;
        if constexpr (Sched::GATHER) { if (has_next) PG8_GMAP_ISSUE(nxt); }
#pragma nounroll
        for (int t = 0; t < nt; t += 2) {
            const bool last = (t == nt - 2);
            const char* a1 = cA + (size_t)(t + 1) * kstep;
            const char* a2 = last ? nA : cA + (size_t)(t + 2) * kstep; const char* b2 = last ? nB : cB + (size_t)(t + 2) * kstep;
            const char* a3 = a2 + kstep; const char* b3 = b2 + kstep;
            const size_t kb2 = last ? 0 : (size_t)(t + 2) * kstep;
            if constexpr (Sched::GATHER) { if (last) { if (has_next) { PG8_GMAP_READ(nao, nxt); } else {
#pragma unroll
                for (int h_ = 0; h_ < 2; ++h_) { nao[h_][0] = cao[h_][0]; nao[h_][1] = cao[h_][1]; } } } }
            const bool rlx = RELAX_EPI && Epi::RELAX && t == 0 && ui > 0;
            PG8_LDB(B0, 0, 0); PG8_LDB(B1, 0, 1); PG8_SCHED; PG8_LDA(At, 0, 0); if (!rlx) PG8_STAGE_A(PG8_SA(1, 1), 1, a1 + hstep, (size_t)(t + 1) * kstep, false);
            if (rlx) PG8_WAIT_VN(8 + NE); else PG8_WAIT_V(8);
            PG8_WAIT_L(0); PG8_BAR; PG8_MMA(0, 0, At, B0); PG8_MMA(0, 1, At, B1); PG8_BAR; PG8_SCHED;
            PG8_LDA(At, 0, 1); PG8_STAGE(PG8_SB(0, 0), b2, voffB); PG8_STAGE(PG8_SB(0, 1), b2 + hstep, voffB); PG8_STAGE_A(PG8_SA(0, 0), 0, a2, kb2, last);
            if (rlx) PG8_WAIT_VN(14 + NE); else PG8_WAIT_V(8);
            PG8_WAIT_L(0); PG8_BAR; PG8_MMA(1, 0, At, B0); PG8_MMA(1, 1, At, B1); PG8_BAR; PG8_SCHED;
            PG8_LDB(B0, 1, 0); PG8_LDB(B1, 1, 1); PG8_SCHED; PG8_LDA(At, 1, 0); PG8_STAGE_A(PG8_SA(0, 1), 1, a2 + hstep, kb2, last);
            if (rlx) PG8_WAIT_VN(8 + NE); else PG8_WAIT_V(8);
            PG8_WAIT_L(0); PG8_BAR; PG8_MMA(0, 0, At, B0); PG8_MMA(0, 1, At, B1); PG8_BAR; PG8_SCHED;
            PG8_LDA(At, 1, 1); PG8_STAGE(PG8_SB(1, 0), b3, voffB); PG8_STAGE(PG8_SB(1, 1), b3 + hstep, voffB); PG8_STAGE_A(PG8_SA(1, 0), 0, a3, kb2 + kstep, last);
            if (rlx) PG8_WAIT_VN(14 + NE); else PG8_WAIT_V(8);
            PG8_WAIT_L(0); PG8_BAR; PG8_MMA(1, 0, At, B0); PG8_MMA(1, 1, At, B1); PG8_BAR; PG8_SCHED;
        }
        if (RELAX_EPI && Epi::RELAX) { PG8_STAGE(PG8_SA(1, 1), nA + kstep + hstep, voffA); asm volatile("" ::: "memory"); }
        if constexpr (Sched::FP8) { asm volatile("s_nop 15\n\ts_nop 7" ::: "memory"); }
        if constexpr (ALIGN_EPI) { if (wr == 0) PG8_BAR; }
        E(acc, cur, wr, wc, fr, fq);
        if (!has_next) break;
        if constexpr (!Epi::KEEP_ACC)
#pragma unroll
        for (int a = 0; a < 2; ++a)
#pragma unroll
            for (int b = 0; b < 2; ++b)
#pragma unroll
                for (int m = 0; m < 4; ++m)
#pragma unroll
                    for (int n = 0; n < 2; ++n) acc[a][b][m][n] = (f32x4){0.f, 0.f, 0.f, 0.f};
        cur = nxt; cA = nA; cB = nB; ++ui;
        if constexpr (Sched::GATHER) {
#pragma unroll
            for (int h_ = 0; h_ < 2; ++h_) { cao[h_][0] = nao[h_][0]; cao[h_][1] = nao[h_][1]; } }
        if constexpr (ALIGN_EPI) { if (wr == 1) PG8_BAR; }
    }
    PG8_WAIT_V(0);
    if constexpr (!ALIGN_EPI) { if (wr == 0) PG8_BAR; }
    PG8_BAR;
#undef PG8_SA
#undef PG8_STAGE_A
#undef PG8_GMAP_ISSUE
#undef PG8_GMAP_READ
#undef PG8_SB
#undef PG8_STAGE
#undef PG8_LDA
#undef PG8_LDB
#undef PG8_MMA
#undef PG8_WAIT_V
#undef PG8_WAIT_VN
#undef PG8_WAIT_L
#undef PG8_BAR
#undef PG8_SCHED
}
}

struct SchedDense {
    static constexpr bool GATHER = false; static constexpr bool FP8 = false; static constexpr int E8_A = 0, E8_B = 0;
    pg8::StaticOrder so; const char* A; const char* B; int K; bool lat; bool skipv;
    __device__ __forceinline__ void init(const void* A_, const void* B_, int K_, int nN, bool lat_, int G, int c, bool skipv_ = false) { A = (const char*)A_; B = (const char*)B_; K = K_; lat = lat_; skipv = skipv_; so.init(lat_ ? 128 : 144, nN, G, c); }
    __device__ __forceinline__ bool next(int i, pg8::Unit& u) const { int pm, pn; if (!so.next(i, pm, pn)) return false; if (lat) pm = (pm >> 3) * 9 + 1 + (pm & 7); if (skipv) pn = pn < 8 ? pn : (pn < 20 ? pn + 4 : pn + 8); u.pm = pm; u.pn = pn; u.aux = 0; return true; }
    __device__ __forceinline__ const char* a_base(const pg8::Unit& u) const { return A + (size_t)u.pm * 256 * K * 2; }
    __device__ __forceinline__ const char* b_base(const pg8::Unit& u) const { return B + (size_t)u.pn * 256 * K * 2; }
};
struct SchedV8 {
    static constexpr bool GATHER = false; static constexpr bool FP8 = true; static constexpr int E8_A = E8_W, E8_B = E8_ONE;
    pg8::StaticOrder so; const char* H8; const char* W;
    __device__ __forceinline__ void init(const void* H8_, const void* Wl_, int G, int c) { H8 = (const char*)H8_; W = (const char*)Wl_; so.init(144, 8, G, G - 1 - c); }
    __device__ __forceinline__ bool next(int i, pg8::Unit& u) const { int pm, pn; if (!so.next(i, pm, pn)) return false; u.pm = pm; u.pn = pn < 4 ? 8 + pn : 20 + pn; u.aux = 0; return true; }
    __device__ __forceinline__ const char* a_base(const pg8::Unit& u) const { return W + (size_t)(u.pn >> 2) * 1024 * 2048 + (size_t)(u.pn & 3) * 256 * 1024; }
    __device__ __forceinline__ const char* b_base(const pg8::Unit& u) const { return H8 + (size_t)u.pm * 256 * 1024; }
};
struct SchedBranch {
    static constexpr bool GATHER = false; static constexpr bool FP8 = false; static constexpr int E8_A = 0, E8_B = 0;
    pg8::StaticOrder so; const char* A; const char* B; bool lat;
    __device__ __forceinline__ void init(const void* A_, const void* B_, bool lat_, int G, int c) { A = (const char*)A_; B = (const char*)B_; lat = lat_; so.init(lat_ ? 128 : 144, 4, G, c); }
    __device__ __forceinline__ bool next(int i, pg8::Unit& u) const { int pm, pn; const int it = i / 3; if (!so.next(it, pm, pn)) return false; if (lat) pm = (pm >> 3) * 9 + 1 + (pm & 7); u.pm = pm; u.pn = pn; u.aux = i - 3 * it; return true; }
    __device__ __forceinline__ const char* a_base(const pg8::Unit& u) const { return A + (size_t)u.aux * PSTR * 2 + (size_t)u.pm * 256 * 1024 * 2; }
    __device__ __forceinline__ const char* b_base(const pg8::Unit& u) const { return B + (size_t)u.aux * 1024 * 1024 * 2 + (size_t)u.pn * 256 * 1024 * 2; }
};
constexpr int MOE_CAP = NROWS;
template <bool G_> struct SchedMoE {
    static constexpr bool GATHER = G_; static constexpr int GMAP_OFF = 131072;
    static constexpr bool FP8 = true; static constexpr int E8_B = E8_W, E8_A = G_ ? E8_ONE : E8_ACT;
    const volatile LAS int* toff; int TT, npn, xcd, j, nwx, G, c; const char* A; const char* B; size_t bexp; const int* rowmap;
    __device__ __forceinline__ void init(const void* A_, const void* B_, size_t bexp_, const volatile LAS int* toff_, int npn_, int G_g, int c_, const int* rowmap_) {
        A = (const char*)A_; B = (const char*)B_; bexp = bexp_; toff = toff_; TT = toff_[NEXP]; npn = npn_; G = G_g; c = c_; xcd = c_ & 7; j = c_ >> 3; nwx = G_g >> 3; rowmap = rowmap_; }
    __device__ __forceinline__ bool next(int i, pg8::Unit& u) const {
        int tm, pn;
        if ((G & 7) == 0) { const int q = i * nwx + j; const int t = q / npn; tm = xcd + 8 * t; pn = q - t * npn; }
        else { const int L = i * G + c; tm = L / npn; pn = L - tm * npn; }
        if (tm >= TT) return false;
        const int ln = (int)__builtin_amdgcn_mbcnt_hi(~0u, __builtin_amdgcn_mbcnt_lo(~0u, 0u));
        const int tv = toff[ln < NEXP - 1 ? ln + 1 : NEXP];
        const int e = (int)__builtin_popcountll(__ballot(ln < NEXP - 1 && tv <= tm));
        const int tb = __builtin_amdgcn_readlane(tv, e > 0 ? e - 1 : 0);
        u.pm = tm; u.pn = pn; u.aux = e; u.lt = tm - (e > 0 ? tb : 0); return true;
    }
    __device__ __forceinline__ const char* a_base(const pg8::Unit& u) const { return A + (size_t)u.pm * 256 * 1024; }
    __device__ __forceinline__ const char* b_base(const pg8::Unit& u) const { return B + (size_t)u.aux * bexp + (size_t)u.pn * 256 * 1024; }
    __device__ __forceinline__ const char* a_gather_base() const { return A; }
    __device__ __forceinline__ const int* row_ptr(const pg8::Unit& u, int lr) const { return rowmap + (size_t)u.aux * MOE_CAP + u.lt * 256 + lr; }
    __device__ __forceinline__ bool row_valid(const pg8::Unit& u, int lr) const { return u.lt * 256 + lr < toff[33 + u.aux]; }
};

typedef f32x4 AccT[2][2][4][2];
struct EpiProj {
    static constexpr bool KEEP_ACC = false; static constexpr bool RELAX = true; static constexpr bool PERM = true; static constexpr int NST = 16; bf16* P;
    __device__ __forceinline__ void operator()(AccT& acc, const pg8::Unit& u, int wr, int wc, int fr, int fq) const {
        const int grp = u.pn >> 2; const bool tr = (grp == 2 || grp == 6);
        const int b = u.pm / 9; const int ld = tr ? SROW : 1024;
        bf16* base = P + (size_t)grp * PSTR + (tr ? (size_t)b * 1024 * SROW + (size_t)(u.pn & 3) * 256 * SROW + (size_t)(u.pm - 9 * b) * 256 : (size_t)u.pm * 256 * 1024 + (size_t)(u.pn & 3) * 256);
        const int row0 = wr * 64 + fr, col0 = wc * 32 + 8 * fq;
#pragma unroll
        for (int ai = 0; ai < 2; ++ai)
#pragma unroll
            for (int m = 0; m < 4; ++m) { bf16* rowp = base + (size_t)(row0 + ai * 128 + m * 16) * ld + col0;
#pragma unroll
                for (int bj = 0; bj < 2; ++bj) { const f32x4 v0 = acc[ai][bj][m][0], v1 = acc[ai][bj][m][1];
                    u32x4 w; w.x = pk2(v0[0], v0[1]); w.y = pk2(v0[2], v0[3]); w.z = pk2(v1[0], v1[1]); w.w = pk2(v1[2], v1[3]);
                    *(u32x4*)(rowp + bj * 128) = w; } }
    }
};
struct EpiBranch {
    static constexpr bool KEEP_ACC = true; static constexpr bool RELAX = false; static constexpr bool PERM = true; static constexpr int NST = 0; const bf16* G; bf16* MB;
    static __device__ __forceinline__ void ratio4(f32x4& v, unsigned g01, unsigned g23, unsigned n01, unsigned n23) {
        const float n0 = 1.0f + fminf(__builtin_amdgcn_exp2f(-bflo(n01) * LOG2E), 1e30f), n1 = 1.0f + fminf(__builtin_amdgcn_exp2f(-bfhi(n01) * LOG2E), 1e30f);
        const float n2 = 1.0f + fminf(__builtin_amdgcn_exp2f(-bflo(n23) * LOG2E), 1e30f), n3 = 1.0f + fminf(__builtin_amdgcn_exp2f(-bfhi(n23) * LOG2E), 1e30f);
        v[0] *= sigmoidf_(bflo(g01)) * n0; v[1] *= sigmoidf_(bfhi(g01)) * n1; v[2] *= sigmoidf_(bflo(g23)) * n2; v[3] *= sigmoidf_(bfhi(g23)) * n3;
    }
    static __device__ __forceinline__ void gate4(f32x4& v, unsigned g01, unsigned g23) { v[0] *= sigmoidf_(bflo(g01)); v[1] *= sigmoidf_(bfhi(g01)); v[2] *= sigmoidf_(bflo(g23)); v[3] *= sigmoidf_(bfhi(g23)); }
    __device__ __forceinline__ void operator()(AccT& acc, const pg8::Unit& u, int wr, int wc, int fr, int fq) const {
        const int j = u.aux; const bf16* gate = G + (size_t)j * PSTR; const bf16* gnext = G + (size_t)(j < 2 ? j + 1 : j) * PSTR;
        int fr_ = fr; asm volatile("" : "+v"(fr_));
        const int row0 = u.pm * 256 + wr * 64 + fr_, col0 = u.pn * 256 + wc * 32 + 8 * fq;
#pragma unroll
        for (int ai = 0; ai < 2; ++ai)
#pragma unroll
        for (int mh = 0; mh < 2; ++mh) { u32x4 gw[2][2], gn[2][2];
#pragma unroll
            for (int mm = 0; mm < 2; ++mm)
#pragma unroll
                for (int bj = 0; bj < 2; ++bj) { const size_t off = (size_t)(row0 + ai * 128 + (2 * mh + mm) * 16) * 1024 + col0 + bj * 128; gw[mm][bj] = *(const u32x4*)(gate + off); gn[mm][bj] = *(const u32x4*)(gnext + off); }
            PIN8(gw[0][0], gw[0][1], gw[1][0], gw[1][1], gn[0][0], gn[0][1], gn[1][0], gn[1][1]);
#pragma unroll
            for (int mm = 0; mm < 2; ++mm) { const int m = 2 * mh + mm;
                if (j < 2) {
#pragma unroll
                    for (int bj = 0; bj < 2; ++bj) { ratio4(acc[ai][bj][m][0], gw[mm][bj].x, gw[mm][bj].y, gn[mm][bj].x, gn[mm][bj].y); ratio4(acc[ai][bj][m][1], gw[mm][bj].z, gw[mm][bj].w, gn[mm][bj].z, gn[mm][bj].w); }
                } else {
#pragma unroll
                    for (int bj = 0; bj < 2; ++bj) { f32x4 v0 = acc[ai][bj][m][0], v1 = acc[ai][bj][m][1];
                        gate4(v0, gw[mm][bj].x, gw[mm][bj].y); gate4(v1, gw[mm][bj].z, gw[mm][bj].w);
                        u32x4 w; w.x = pk2(v0[0], v0[1]); w.y = pk2(v0[2], v0[3]); w.z = pk2(v1[0], v1[1]); w.w = pk2(v1[2], v1[3]);
                        *(u32x4*)(MB + (size_t)(row0 + ai * 128 + m * 16) * 1024 + col0 + bj * 128) = w;
                        acc[ai][bj][m][0] = (f32x4){0.f, 0.f, 0.f, 0.f}; acc[ai][bj][m][1] = (f32x4){0.f, 0.f, 0.f, 0.f}; }
                } } }
    }
};
template <bool FIRST> struct EpiOut {
    static constexpr bool KEEP_ACC = false; static constexpr bool RELAX = false; static constexpr bool PERM = true; static constexpr int NST = 16; const float* xin_x; const float* xin_ctx; bf16* X; const float* modv_l;
    __device__ __forceinline__ void operator()(AccT& acc, const pg8::Unit& u, int wr, int wc, int fr, int fq) const {
        const int b = u.pm / 9, jt = u.pm - 9 * b; const float* g1 = modv_l + (size_t)(jt == 0 ? 16 : b) * 6144 + 2 * 1024;
        const float* src = jt == 0 ? xin_ctx + (size_t)b * CTXL * 1024 : xin_x + ((size_t)b * SEQ + (size_t)(jt - 1) * 256) * 1024;
        bf16* dst = X + (size_t)u.pm * 256 * 1024;
        int fr_ = fr; asm volatile("" : "+v"(fr_));
        const int lr0 = wr * 64 + fr_, col0 = u.pn * 256 + wc * 32 + 8 * fq;
        f32x4 gv[2][2];
#pragma unroll
        for (int bj = 0; bj < 2; ++bj)
#pragma unroll
            for (int n = 0; n < 2; ++n) gv[bj][n] = *(const f32x4*)(g1 + col0 + bj * 128 + n * 4);
        if constexpr (FIRST) {
#pragma unroll
            for (int ai = 0; ai < 2; ++ai)
#pragma unroll
                for (int mh = 0; mh < 2; ++mh) { f32x4 xo[2][2][2];
#pragma unroll
                    for (int mm = 0; mm < 2; ++mm)
#pragma unroll
                        for (int bj = 0; bj < 2; ++bj)
#pragma unroll
                            for (int n = 0; n < 2; ++n) xo[mm][bj][n] = *(const f32x4*)(src + (size_t)(lr0 + ai * 128 + (2 * mh + mm) * 16) * 1024 + col0 + bj * 128 + n * 4);
                    PIN8(xo[0][0][0], xo[0][0][1], xo[0][1][0], xo[0][1][1], xo[1][0][0], xo[1][0][1], xo[1][1][0], xo[1][1][1]);
#pragma unroll
                    for (int mm = 0; mm < 2; ++mm)
#pragma unroll
                        for (int bj = 0; bj < 2; ++bj) { const f32x4 x0 = xo[mm][bj][0] + gv[bj][0] * acc[ai][bj][2 * mh + mm][0], x1 = xo[mm][bj][1] + gv[bj][1] * acc[ai][bj][2 * mh + mm][1];
                            u32x4 w; w.x = pk2(x0[0], x0[1]); w.y = pk2(x0[2], x0[3]); w.z = pk2(x1[0], x1[1]); w.w = pk2(x1[2], x1[3]);
                            *(u32x4*)(dst + (size_t)(lr0 + ai * 128 + (2 * mh + mm) * 16) * 1024 + col0 + bj * 128) = w; } }
        } else {
#pragma unroll
            for (int ai = 0; ai < 2; ++ai) { u32x4 xb[4][2];
#pragma unroll
                for (int m = 0; m < 4; ++m)
#pragma unroll
                    for (int bj = 0; bj < 2; ++bj) xb[m][bj] = *(const u32x4*)(dst + (size_t)(lr0 + ai * 128 + m * 16) * 1024 + col0 + bj * 128);
                PIN8(xb[0][0], xb[0][1], xb[1][0], xb[1][1], xb[2][0], xb[2][1], xb[3][0], xb[3][1]);
#pragma unroll
                for (int m = 0; m < 4; ++m)
#pragma unroll
                    for (int bj = 0; bj < 2; ++bj) { const u32x4 t = xb[m][bj];
                        const f32x4 x0 = (f32x4){bflo(t.x), bfhi(t.x), bflo(t.y), bfhi(t.y)} + gv[bj][0] * acc[ai][bj][m][0], x1 = (f32x4){bflo(t.z), bfhi(t.z), bflo(t.w), bfhi(t.w)} + gv[bj][1] * acc[ai][bj][m][1];
                        u32x4 w; w.x = pk2(x0[0], x0[1]); w.y = pk2(x0[2], x0[3]); w.z = pk2(x1[0], x1[1]); w.w = pk2(x1[2], x1[3]);
                        *(u32x4*)(dst + (size_t)(lr0 + ai * 128 + m * 16) * 1024 + col0 + bj * 128) = w; } }
        }
    }
};
__device__ __forceinline__ float swiglu_(float gl, float li) { gl = fminf(gl, 7.0f); li = fminf(fmaxf(li, -7.0f), 7.0f);
    const float r = __builtin_amdgcn_rcpf(1.0f + __builtin_amdgcn_exp2f(gl * (-1.702f * LOG2E))); return (gl * r) * fmaf(li, ACT8_SCALE, ACT8_SCALE); }
struct EpiUp {
    static constexpr bool KEEP_ACC = false; static constexpr bool RELAX = true; static constexpr bool PERM = true; static constexpr int NST = 16; unsigned char* ACT; const float* bup;
    __device__ __forceinline__ void operator()(AccT& acc, const pg8::Unit& u, int wr, int wc, int fr, int fq) const {
        const float* bias = bup + (size_t)u.aux * 2048; const int row0 = u.pm * 256 + wr * 64 + fr, colb = u.pn * 256 + wc * 32 + 8 * fq;
        f32x4 bv[2][2];
#pragma unroll
        for (int bj = 0; bj < 2; ++bj)
#pragma unroll
            for (int n = 0; n < 2; ++n) bv[bj][n] = *(const f32x4*)(bias + colb + bj * 128 + 4 * n);
#pragma unroll
        for (int ai = 0; ai < 2; ++ai)
#pragma unroll
            for (int m = 0; m < 4; ++m) { unsigned char* rowp = ACT + (size_t)(row0 + ai * 128 + m * 16) * 1024 + (colb >> 1);
#pragma unroll
                for (int bj = 0; bj < 2; ++bj) { const f32x4 v0 = acc[ai][bj][m][0] + bv[bj][0], v1 = acc[ai][bj][m][1] + bv[bj][1];
                    *(unsigned*)(rowp + bj * 64) = pk4_fp8(swiglu_(v0[0], v0[1]), swiglu_(v0[2], v0[3]), swiglu_(v1[0], v1[1]), swiglu_(v1[2], v1[3])); } }
    }
};
struct EpiDown {
    static constexpr bool KEEP_ACC = false; static constexpr bool RELAX = true; static constexpr bool PERM = true; static constexpr int NST = 16; unsigned char* Y; const float* bdn; const float* roww;
    __device__ __forceinline__ void operator()(AccT& acc, const pg8::Unit& u, int wr, int wc, int fr, int fq) const {
        const float* bias = bdn + (size_t)u.aux * 1024; const int row0 = u.pm * 256 + wr * 64 + fr, col0 = u.pn * 256 + wc * 32 + 8 * fq;
        f32x4 bv[2][2];
#pragma unroll
        for (int bj = 0; bj < 2; ++bj)
#pragma unroll
            for (int n = 0; n < 2; ++n) bv[bj][n] = *(const f32x4*)(bias + col0 + bj * 128 + 4 * n);
        float rw[2][4];
#pragma unroll
        for (int ai = 0; ai < 2; ++ai)
#pragma unroll
            for (int m = 0; m < 4; ++m) rw[ai][m] = roww[(size_t)u.aux * MOE_CAP + u.lt * 256 + (wr * 64 + fr + ai * 128 + m * 16)];
        PIN8(rw[0][0], rw[0][1], rw[0][2], rw[0][3], rw[1][0], rw[1][1], rw[1][2], rw[1][3]);
#pragma unroll
        for (int ai = 0; ai < 2; ++ai)
#pragma unroll
            for (int m = 0; m < 4; ++m) { const int row = row0 + ai * 128 + m * 16; const float w8 = rw[ai][m] * Y8_SCALE; unsigned char* rowp = Y + (size_t)row * 1024 + col0;
#pragma unroll
                for (int bj = 0; bj < 2; ++bj) { const f32x4 v0 = (acc[ai][bj][m][0] + bv[bj][0]) * w8, v1 = (acc[ai][bj][m][1] + bv[bj][1]) * w8;
                    u32x2 w; w.x = pk4_fp8(v0[0], v0[1], v0[2], v0[3]); w.y = pk4_fp8(v1[0], v1[1], v1[2], v1[3]);
                    *(u32x2*)(rowp + bj * 128) = w; } }
    }
};
#define XB_TMO      128
#define XB_XCNT(j)  (256  + 64 * (j))
#define XB_XSUB(j)  (1280 + 64 * (j))
#define XB_XGEN(j)  (2304 + 64 * (j))
#define XB_TOP      3328
#define XB_TOPGEN   3392
#define XCD_BAR_WORDS 3456
#define XB_SPIN_CAP (1u << 18)
__device__ __forceinline__ unsigned xb_ld(unsigned* p)              { return __hip_atomic_load(p, __ATOMIC_RELAXED, __HIP_MEMORY_SCOPE_AGENT); }
__device__ __forceinline__ unsigned xb_add(unsigned* p, unsigned v) { return __hip_atomic_fetch_add(p, v, __ATOMIC_RELAXED, __HIP_MEMORY_SCOPE_AGENT); }
__device__ __forceinline__ unsigned xb_xcc_id() { return (unsigned)__builtin_amdgcn_s_getreg((3 << 11) | 20) & 0xFu; }
#define XB_SPIN(cond, bar) do { unsigned _sp = 0; while (cond) { __builtin_amdgcn_s_sleep(1); \
    if ((++_sp & 255u) == 0u) { if (xb_ld(&(bar)[XB_TMO])) break; if (_sp > XB_SPIN_CAP) { atomicAdd(&(bar)[XB_TMO], 1u); break; } } } } while (0)
struct XcdBarrier { unsigned* bar; unsigned x; volatile LAS unsigned* st; };
__device__ __forceinline__ XcdBarrier xcd_barrier_post(unsigned* bar, volatile LAS unsigned* st) {
    XcdBarrier b; b.bar = bar; b.x = xb_xcc_id(); b.st = st;
    if (threadIdx.x == 0) (void)xb_add(&bar[XB_XCNT(b.x)], 1u);
    return b;
}
__device__ __forceinline__ void xcd_barrier_complete(unsigned* bar, unsigned x, unsigned& nloc, unsigned& nx) {
    const unsigned G = gridDim.x * gridDim.y * gridDim.z;
    unsigned sum, cnt, mine, sp = 0u;
    for (;;) {
        sum = 0u; cnt = 0u; mine = 0u;
#pragma unroll
        for (unsigned j = 0; j < 16; ++j) { const unsigned c = xb_ld(&bar[XB_XCNT(j)]); sum += c; cnt += (c > 0u) ? 1u : 0u; mine = (j == x) ? c : mine; }
        if (sum == G) break;
        __builtin_amdgcn_s_sleep(1);
        if ((++sp & 255u) == 0u) { if (xb_ld(&bar[XB_TMO])) break; if (sp > XB_SPIN_CAP) { atomicAdd(&bar[XB_TMO], 1u); break; } }
    }
    nloc = mine > 0u ? mine : 1u; nx = cnt > 0u ? cnt : 1u;
}
__device__ __forceinline__ void xcd_barrier(const XcdBarrier& b) {
    asm volatile("s_waitcnt vmcnt(0)" ::: "memory");
    __syncthreads();
    if (threadIdx.x == 0) {
        unsigned* bar = b.bar;
        __builtin_amdgcn_s_waitcnt(0);
        unsigned nloc = b.st[0], nx = b.st[1];
        if (nloc == 0u) { xcd_barrier_complete(bar, b.x, nloc, nx); b.st[0] = nloc; b.st[1] = nx; }
        const unsigned old = xb_add(&bar[XB_XSUB(b.x)], 1u);
        const unsigned gen = old / nloc;
        if (old + 1u == (gen + 1u) * nloc) {
            __builtin_amdgcn_fence(__ATOMIC_RELEASE, "agent");
            asm volatile("s_waitcnt vmcnt(0)" ::: "memory");
            const unsigned og = xb_add(&bar[XB_TOP], 1u);
            const unsigned tg = og / nx;
            if (og + 1u == (tg + 1u) * nx) xb_add(&bar[XB_TOPGEN], 1u);
            else XB_SPIN(xb_ld(&bar[XB_TOPGEN]) == tg, bar);
            __builtin_amdgcn_fence(__ATOMIC_ACQUIRE, "agent");
            xb_add(&bar[XB_XGEN(b.x)], 1u);
            asm volatile("s_waitcnt vmcnt(0)" ::: "memory");
        } else {
            XB_SPIN(xb_ld(&bar[XB_XGEN(b.x)]) == gen, bar);
            __builtin_amdgcn_fence(__ATOMIC_ACQUIRE, "agent");
            asm volatile("s_waitcnt vmcnt(0)" ::: "memory");
        }
    }
    __syncthreads();
}

struct Args {
    const float* in[28]; float* out; unsigned char* ws; int ph_lo, ph_hi;
};
struct Frame {
    LAS unsigned char* lds; volatile LAS unsigned* MISC; unsigned* ctl; unsigned char* ws;
    int vcu, G, c;
    const float* const* in;
};
#define PHASE_IDS() const int tid = opaque_tid(); const int lane = tid & 63; const int wave = __builtin_amdgcn_readfirstlane(tid >> 6); (void)lane; (void)wave
enum { I_X = 0, I_C, I_CTX, I_CCTX, I_WMOD, I_BMOD, I_N1G, I_N2G, I_WMIX, I_RDF, I_RDB, I_RPB, I_CONVW, I_CONVB, I_GAW, I_GAB, I_GXW, I_GXB, I_LAM, I_WBR, I_WOUT, I_WR, I_BR, I_WUP, I_BUP, I_WDN, I_BDN, I_FNG };

constexpr int P0_I0 = 2 * 3072, P0_I1 = P0_I0 + 6 * 256, P0_I2 = P0_I1 + 2 * 256, P0_I3 = P0_I2 + 64 * 512, P0_I4 = P0_I3 + 64 * 256;
constexpr int P0_CHUNK = 128, P0_NCHUNK = (P0_I4 - P0_I2) / P0_CHUNK;
static_assert((P0_I4 - P0_I2) % P0_CHUNK == 0, "conversion chunks");
__device__ __forceinline__ void p0_decode(Frame& F, int it, const float*& src, unsigned char*& dst, int& N, bool& f8) {
    int kb, nb; const float* W; unsigned char* WT;
    if (it < P0_I0) { const int mi = it / 3072, r = it - mi * 3072; kb = r / 192; nb = r - kb * 192; N = 12288; W = F.in[I_WMIX] + (size_t)mi * 1024 * 12288; WT = F.ws + WS_WMIX + (size_t)mi * 12288 * 2048;
        const int grp = nb >> 4; f8 = (grp == 2 || grp == 6);
        if (f8) { src = W + (size_t)(64 * kb) * N + 64 * nb; dst = WT + (size_t)grp * 1024 * 2048 + (size_t)(64 * (nb & 15)) * 1024 + 64 * kb; return; } }
    else if (it < P0_I1) { const int q = it - P0_I0, mi = q >> 8, r = q & 255; kb = r >> 4; nb = r & 15; N = 1024; f8 = false; W = F.in[I_WBR] + (size_t)mi * 1024 * 1024; WT = F.ws + WS_WBR + (size_t)mi * 1024 * 2048; }
    else if (it < P0_I2) { const int q = it - P0_I1, mi = q >> 8, r = q & 255; kb = r >> 4; nb = r & 15; N = 1024; f8 = false; W = F.in[I_WOUT] + (size_t)mi * 1024 * 1024; WT = F.ws + WS_WOUT + (size_t)mi * 1024 * 2048; }
    else if (it < P0_I3) { const int q = it - P0_I2, mi = q >> 9, r = q & 511; kb = r >> 5; nb = r & 31; N = 2048; f8 = true; W = F.in[I_WUP] + (size_t)mi * 1024 * 2048; WT = F.ws + WS_WUP + (size_t)mi * 2048 * 1024; }
    else { const int q = it - P0_I3, mi = q >> 8, r = q & 255; kb = r >> 4; nb = r & 15; N = 1024; f8 = true; W = F.in[I_WDN] + (size_t)mi * 1024 * 1024; WT = F.ws + WS_WDN + (size_t)mi * 1024 * 1024; }
    src = W + (size_t)(64 * kb) * N + 64 * nb; dst = WT + ((size_t)(64 * nb) * 1024 + 64 * kb) * (f8 ? 1 : 2);
}
__device__ __forceinline__ void p0_convert(Frame& F, int it0, int stride, int it_end, int wave, int lane) {
    LAS float* scr = (LAS float*)(F.lds + wave * 16640);
    const int lr = lane >> 4, lc = 4 * (lane & 15);
    f32x4 cur[16], nxt[16];
    const float* src; unsigned char* dst; int N; bool f8;
    int it = it0;
    if (it < it_end) { p0_decode(F, it, src, dst, N, f8);
#pragma unroll
        for (int i = 0; i < 16; ++i) cur[i] = *(const f32x4*)(src + (size_t)(4 * i + lr) * N + lc); }
    for (; it < it_end; it += stride) {
        unsigned char* dcur = dst; const bool f8c = f8;
        if (it + stride < it_end) { p0_decode(F, it + stride, src, dst, N, f8);
#pragma unroll
            for (int i = 0; i < 16; ++i) nxt[i] = *(const f32x4*)(src + (size_t)(4 * i + lr) * N + lc); }
#pragma unroll
        for (int i = 0; i < 16; ++i) { LAS float* s = scr + (4 * i + lr) * 65 + lc; s[0] = cur[i].x; s[1] = cur[i].y; s[2] = cur[i].z; s[3] = cur[i].w; }
        LDS_WAIT(); asm volatile("" ::: "memory");
        const int c = lane & 7;
        if (!f8c) {
#pragma unroll
            for (int j = 0; j < 8; ++j) { const int n = (lane >> 3) + 8 * j; const LAS float* s = scr + (8 * c) * 65 + n;
                u32x4 o; o.x = pk2(s[0 * 65], s[1 * 65]); o.y = pk2(s[2 * 65], s[3 * 65]); o.z = pk2(s[4 * 65], s[5 * 65]); o.w = pk2(s[6 * 65], s[7 * 65]);
                *(u32x4*)(dcur + (size_t)n * 2048 + 16 * c) = o; }
        } else {
#pragma unroll
            for (int j = 0; j < 8; ++j) { const int n = (lane >> 3) + 8 * j; const LAS float* s = scr + (8 * c) * 65 + n;
                u32x2 o; o.x = pk4_fp8(s[0 * 65] * W8_SCALE, s[1 * 65] * W8_SCALE, s[2 * 65] * W8_SCALE, s[3 * 65] * W8_SCALE); o.y = pk4_fp8(s[4 * 65] * W8_SCALE, s[5 * 65] * W8_SCALE, s[6 * 65] * W8_SCALE, s[7 * 65] * W8_SCALE);
                *(u32x2*)(dcur + (size_t)n * 1024 + 8 * c) = o; }
        }
        LDS_WAIT(); asm volatile("" ::: "memory");
#pragma unroll
        for (int i = 0; i < 16; ++i) cur[i] = nxt[i];
    }
}
__device__ __forceinline__ void p0_prologue(Frame& F, int nrep) {
    PHASE_IDS();
    {
        float2* rope = (float2*)(F.ws + WS_ROPE);
        const int gt = F.c * 512 + tid;
        if (gt < 96 * 32) { const int pos = gt >> 5, i = gt & 31; const float p = (float)(pos < 32 ? pos : pos - 32); const float inv = powf(10000.0f, -(float)i / 32.0f); const float a = p * inv; rope[gt] = make_float2(cosf(a), sinf(a)); }
    }
    if (F.c < 192) {
        LAS float* sil = (LAS float*)F.lds;
        LAS float* red = (LAS float*)(F.lds + 17 * 1024 * 4);
        { float cv[34];
#pragma unroll
          for (int q = 0; q < 34; ++q) { const int i = tid + 512 * q, b = i >> 10, k = i & 1023; cv[q] = b < 16 ? F.in[I_C][b * 1024 + k] : F.in[I_CCTX][k]; }
          PIN8(cv[0], cv[1], cv[2], cv[3], cv[4], cv[5], cv[6], cv[7]); PIN8(cv[8], cv[9], cv[10], cv[11], cv[12], cv[13], cv[14], cv[15]); PIN8(cv[16], cv[17], cv[18], cv[19], cv[20], cv[21], cv[22], cv[23]);
          PIN8(cv[24], cv[25], cv[26], cv[27], cv[28], cv[29], cv[30], cv[31]); PIN4(cv[32], cv[33], cv[0], cv[1]);
#pragma unroll
          for (int q = 0; q < 34; ++q) sil[tid + 512 * q] = cv[q] * sigmoidf_(cv[q]); }
        __syncthreads();
        const int l = F.c / 96, cg = F.c - 96 * l; const float* wm = F.in[I_WMOD] + (size_t)l * 1024 * 6144 + 64 * cg + lane;
        float acc[17];
#pragma unroll
        for (int b = 0; b < 17; ++b) acc[b] = 0.f;
        const int kb = wave * 128;
#pragma unroll 16
        for (int kk = 0; kk < 128; ++kk) { const float wv = wm[(size_t)(kb + kk) * 6144];
#pragma unroll
            for (int b = 0; b < 17; ++b) acc[b] += sil[b * 1024 + kb + kk] * wv; }
#pragma unroll
        for (int b = 0; b < 17; ++b) red[(wave * 17 + b) * 64 + lane] = acc[b];
        __syncthreads();
        float* modv = (float*)(F.ws + WS_MODV);
        for (int i = tid; i < 17 * 64; i += 512) { const int b = i >> 6, n = i & 63; float s = 0.f;
#pragma unroll
            for (int w = 0; w < 8; ++w) s += red[(w * 17 + b) * 64 + n];
            const int col = 64 * cg + n; modv[((size_t)l * 17 + b) * 6144 + col] = s + F.in[I_BMOD][l * 6144 + col]; }
        __syncthreads();
    }
    for (int rep = 0; rep < nrep; ++rep) p0_convert(F, F.vcu * 8 + wave, F.G * 8, P0_I2, wave, lane);
}

__device__ __forceinline__ float row_rstd(const f32x4 (&v)[4]) {
    float s = 0.f;
#pragma unroll
    for (int j = 0; j < 4; ++j) s += (v[j].x * v[j].x + v[j].y * v[j].y) + (v[j].z * v[j].z + v[j].w * v[j].w);
    return rsqrtf(wave_sum(s) * (1.0f / 1024.0f) + NORM_EPS);
}
template <bool F8 = false, bool BOTH = false> __device__ __forceinline__ void modulate_row_pre(f32x4 (&v)[4], const f32x4 (&g4)[4], const f32x4 (&s4)[4], const f32x4 (&h4)[4], bf16* orow, int lane, unsigned char* orow8 = nullptr) {
    const float rstd = row_rstd(v);
#pragma unroll
    for (int j = 0; j < 4; ++j) { const int col = 4 * lane + 256 * j;
        v[j] = v[j] * rstd * g4[j] * (s4[j] + 1.0f) + h4[j];
        if constexpr (F8) { *(unsigned*)((unsigned char*)orow + col) = pk4_fp8(v[j].x, v[j].y, v[j].z, v[j].w); }
        else { u32x2 w; w.x = pk2(v[j].x, v[j].y); w.y = pk2(v[j].z, v[j].w); *(u32x2*)(orow + col) = w;
            if constexpr (BOTH) *(unsigned*)(orow8 + col) = pk4_fp8(v[j].x, v[j].y, v[j].z, v[j].w); } }
}
template <bool F8 = false, bool BOTH = false> __device__ __forceinline__ void modulate_row(f32x4 (&v)[4], const float* g, const float* sc, const float* sh, bf16* orow, int lane, unsigned char* orow8 = nullptr) {
    f32x4 g4[4], s4[4], h4[4];
#pragma unroll
    for (int j = 0; j < 4; ++j) { const int col = 4 * lane + 256 * j; g4[j] = *(const f32x4*)(g + col); s4[j] = *(const f32x4*)(sc + col); h4[j] = *(const f32x4*)(sh + col); }
    PIN4(g4[0], g4[1], g4[2], g4[3]); PIN8(s4[0], s4[1], s4[2], s4[3], h4[0], h4[1], h4[2], h4[3]);
    modulate_row_pre<F8, BOTH>(v, g4, s4, h4, orow, lane, orow8);
}
__device__ __forceinline__ const float* in_row(const float* x, const float* ctx, int r) { const int b = r / SROW, s = r - b * SROW; return s < CTXL ? ctx + ((size_t)b * CTXL + s) * D : x + ((size_t)b * SEQ + (s - CTXL)) * D; }
__device__ __forceinline__ void p1_norm1(Frame& F) {
    PHASE_IDS();
    const int gw = F.vcu * 8 + wave, NGW = F.G * 8;
    const float* modv = (const float*)(F.ws + WS_MODV); bf16* H = (bf16*)(F.ws + WS_H);
    f32x4 v[4], nv[4];
    if (gw < NROWS) { const float* xr = in_row(F.in[I_X], F.in[I_CTX], gw);
#pragma unroll
        for (int j = 0; j < 4; ++j) v[j] = *(const f32x4*)(xr + 4 * lane + 256 * j); }
    for (int r = gw; r < NROWS; r += NGW) {
        const int b = r / SROW, s = r - b * SROW; const float* mv = modv + (size_t)(s < CTXL ? 16 : b) * 6144;
        const int rn = r + NGW < NROWS ? r + NGW : r; const float* xn = in_row(F.in[I_X], F.in[I_CTX], rn);
#pragma unroll
        for (int j = 0; j < 4; ++j) nv[j] = *(const f32x4*)(xn + 4 * lane + 256 * j);
        modulate_row<false, true>(v, F.in[I_N1G], mv + 1024, mv, H + (size_t)r * 1024, lane, F.ws + WS_H8IN + (size_t)r * 1024);
#pragma unroll
        for (int j = 0; j < 4; ++j) v[j] = nv[j];
    }
}
constexpr int WR_STRIDE = 1028;
constexpr int L6_WR = 0, L6_LCNT = 32 * WR_STRIDE * 4, L6_LBASE = L6_LCNT + 128, L6_TAB = L6_LBASE + 128, L6_MAXROWS = 640;
static_assert(L6_TAB + L6_MAXROWS * 48 <= LCTL_OFF, "router LDS");
__device__ __forceinline__ float tred32(const float (&p)[32], int lane) {
    float q16[16], q8[8], q4[4], q2[2], q1;
    { const bool hi = (lane & 32) != 0;
#pragma unroll
      for (int e = 0; e < 16; ++e) { const float keep = hi ? p[e + 16] : p[e], send = hi ? p[e] : p[e + 16]; q16[e] = keep + __shfl_xor(send, 32); } }
    { const bool hi = (lane & 16) != 0;
#pragma unroll
      for (int e = 0; e < 8; ++e) { const float keep = hi ? q16[e + 8] : q16[e], send = hi ? q16[e] : q16[e + 8]; q8[e] = keep + __shfl_xor(send, 16); } }
    { const bool hi = (lane & 8) != 0;
#pragma unroll
      for (int e = 0; e < 4; ++e) { const float keep = hi ? q8[e + 4] : q8[e], send = hi ? q8[e] : q8[e + 4]; q4[e] = keep + __shfl_xor(send, 8); } }
    { const bool hi = (lane & 4) != 0;
#pragma unroll
      for (int e = 0; e < 2; ++e) { const float keep = hi ? q4[e + 2] : q4[e], send = hi ? q4[e] : q4[e + 2]; q2[e] = keep + __shfl_xor(send, 4); } }
    { const bool hi = (lane & 2) != 0; const float keep = hi ? q2[1] : q2[0], send = hi ? q2[0] : q2[1]; q1 = keep + __shfl_xor(send, 2); }
    return q1 + __shfl_xor(q1, 1);
}
__device__ __forceinline__ void route_row(float val, int el, int lane, volatile LAS int* LCNT, LAS int* TAB, int lr) {
    int te[4]; float tv[4];
#pragma unroll
    for (int k = 0; k < 4; ++k) { const float m = wave_max(val); const unsigned long long mask = __ballot(val == m); const int fl = mask ? (int)__builtin_ctzll(mask) : 0;
        te[k] = (fl >> 1) & 31; tv[k] = m; if (el == te[k]) val = -INFINITY; }
    const float e1 = __expf(tv[1] - tv[0]), e2 = __expf(tv[2] - tv[0]), e3 = __expf(tv[3] - tv[0]); const float inv = 1.0f / (1.0f + e1 + e2 + e3);
    if (lane < 4) { const int ek = lane == 0 ? te[0] : lane == 1 ? te[1] : lane == 2 ? te[2] : te[3]; const float wk = (lane == 0 ? 1.0f : lane == 1 ? e1 : lane == 2 ? e2 : e3) * inv;
        const int pos = atomicAdd((int*)(LCNT + ek), 1);
        LAS int* t = TAB + (lr * 4 + lane) * 3; t[0] = ek; t[1] = pos; t[2] = __float_as_int(wk); }
}
__device__ __forceinline__ void p6_router(Frame& F, int l, bool lat) {
    PHASE_IDS();
    LAS float* WR = (LAS float*)(F.lds + L6_WR);
    volatile LAS int* LCNT = (volatile LAS int*)(F.lds + L6_LCNT); volatile LAS int* LBASE = (volatile LAS int*)(F.lds + L6_LBASE);
    LAS int* TAB = (LAS int*)(F.lds + L6_TAB);
    const float* wr = F.in[I_WR] + (size_t)l * 1024 * 32;
    { f32x4 t[16];
#pragma unroll
      for (int i = 0; i < 16; ++i) t[i] = *(const f32x4*)(wr + 4 * (tid + 512 * i));
      PIN8(t[0], t[1], t[2], t[3], t[4], t[5], t[6], t[7]); PIN8(t[8], t[9], t[10], t[11], t[12], t[13], t[14], t[15]);
#pragma unroll
      for (int i = 0; i < 16; ++i) { const int q = tid + 512 * i, d = q >> 3, e0 = 4 * (q & 7); WR[e0 * WR_STRIDE + d] = t[i].x; WR[(e0 + 1) * WR_STRIDE + d] = t[i].y; WR[(e0 + 2) * WR_STRIDE + d] = t[i].z; WR[(e0 + 3) * WR_STRIDE + d] = t[i].w; } }
    if (tid < 32) LCNT[tid] = 0;
    __syncthreads();
    const int RPW = (NROWS + F.G - 1) / F.G; const int rbeg = F.c * RPW; int nloc = NROWS - rbeg; nloc = nloc < 0 ? 0 : (nloc > RPW ? RPW : nloc);
    const float* modv = (const float*)(F.ws + WS_MODV) + (size_t)l * 17 * 6144; const bf16* X = (const bf16*)(F.ws + WS_X); bf16* H = (bf16*)(F.ws + WS_H);
    const float* n2g = F.in[I_N2G] + l * 1024; const float* brt = F.in[I_BR] + l * 32;
    const int el = (lane >> 1) & 31; const float bre = brt[el];
    for (int lr = wave; lr < nloc; lr += 16) {
        const int lr2 = lr + 8; const bool has2 = lr2 < nloc;
        const int r = rbeg + lr, r2 = has2 ? rbeg + lr2 : r; const int b = r / SROW, s = r - b * SROW, b2 = r2 / SROW, s2 = r2 - b2 * SROW;
        const bool skip1 = lat && s < CTXL, skip2 = !has2 || (lat && s2 < CTXL);
        if (skip1 && lane < 4) TAB[(lr * 4 + lane) * 3] = -1;
        if (has2 && skip2 && lane < 4) TAB[(lr2 * 4 + lane) * 3] = -1;
        if (skip1 && skip2) continue;
        const float* mv = modv + (size_t)(s < CTXL ? 16 : b) * 6144; const float* mv2 = modv + (size_t)(s2 < CTXL ? 16 : b2) * 6144;
        f32x4 v[4], v2[4];
#pragma unroll
        for (int j = 0; j < 4; ++j) { const u32x2 t = *(const u32x2*)(X + (size_t)r * 1024 + 4 * lane + 256 * j), t2 = *(const u32x2*)(X + (size_t)r2 * 1024 + 4 * lane + 256 * j); v[j] = bf4(t); v2[j] = bf4(t2); }
        if (!skip1) modulate_row<true>(v, n2g, mv + 4 * 1024, mv + 3 * 1024, (bf16*)((unsigned char*)H + (size_t)r * 1024), lane);
        if (!skip2) modulate_row<true>(v2, n2g, mv2 + 4 * 1024, mv2 + 3 * 1024, (bf16*)((unsigned char*)H + (size_t)r2 * 1024), lane);
        float p[32], p2[32];
#pragma unroll
        for (int e = 0; e < 32; ++e) { float a = 0.f, a2 = 0.f;
#pragma unroll
            for (int j = 0; j < 4; ++j) { const f32x4 w4 = *(const LAS f32x4*)(WR + e * WR_STRIDE + 256 * j + 4 * lane);
                a += (v[j].x * w4.x + v[j].y * w4.y) + (v[j].z * w4.z + v[j].w * w4.w); a2 += (v2[j].x * w4.x + v2[j].y * w4.y) + (v2[j].z * w4.z + v2[j].w * w4.w); }
            p[e] = a; p2[e] = a2; }
        const float val = tred32(p, lane) + bre, val2 = tred32(p2, lane) + bre;
        if (!skip1) route_row(val, el, lane, LCNT, TAB, lr);
        if (!skip2) route_row(val2, el, lane, LCNT, TAB, lr2);
    }
    __syncthreads();
    unsigned* cnt = F.ctl + CW_CNT + l * 64;
    if (tid < 32) LBASE[tid] = (int)atomicAdd(cnt + tid, (unsigned)LCNT[tid]);
    __syncthreads();
    int* toke = (int*)(F.ws + WS_TOKE); int* tokp = (int*)(F.ws + WS_TOKP); int* rowmap = (int*)(F.ws + WS_ROWMAP); float* roww = (float*)(F.ws + WS_ROWW);
    for (int idx = tid; idx < nloc * 4; idx += 512) { const LAS int* t = TAB + idx * 3; const int e = t[0]; const size_t o = (size_t)rbeg * 4 + idx;
        toke[o] = e; if (e >= 0) { const int pos = LBASE[e] + t[1]; tokp[o] = pos; rowmap[(size_t)e * NROWS + pos] = rbeg + (idx >> 2); roww[(size_t)e * NROWS + pos] = __int_as_float(t[2]); } }
    __syncthreads();
}
__device__ __forceinline__ void moe_toff(Frame& F, int l, volatile LAS int* toff) {
    PHASE_IDS();
    if (wave == 0) { unsigned* cnt = F.ctl + CW_CNT + l * 64;
        const int c = lane < NEXP ? (int)__hip_atomic_load(cnt + lane, RLX_AGENT) : 0; const int t = (c + 255) >> 8; int incl = t;
#pragma unroll
        for (int d = 1; d < 32; d <<= 1) { const int o = __shfl_up(incl, d); if (lane >= d) incl += o; }
        if (lane < NEXP) { toff[lane] = incl - t; toff[33 + lane] = c; }
        if (lane == NEXP - 1) toff[NEXP] = incl; }
    __syncthreads();
}
__device__ __forceinline__ void p9_combine(Frame& F, int l, bool last, float* out) {
    PHASE_IDS();
    const int gw = F.vcu * 8 + wave, NGW = F.G * 8;
    volatile LAS int* toff = (volatile LAS int*)(F.lds + LCTL_OFF + 256);
    moe_toff(F, l, toff);
    const int* toke = (const int*)(F.ws + WS_TOKE); const int* tokp = (const int*)(F.ws + WS_TOKP); const unsigned char* Y = (const unsigned char*)(F.ws + WS_H2S);
    bf16* X = (bf16*)(F.ws + WS_X); bf16* H = (bf16*)(F.ws + WS_H);
    const float* modv = (const float*)(F.ws + WS_MODV) + (size_t)l * 17 * 6144;
    f32x4 fg[4];
#pragma unroll
    for (int j = 0; j < 4; ++j) fg[j] = *(const f32x4*)(F.in[I_FNG] + 4 * lane + 256 * j);
    int r = gw; while (r < NROWS && last && (r % SROW) < CTXL) r += NGW;
    i32x4v te = (i32x4v){0, 0, 0, 0}, tp = te;
    if (r < NROWS) { te = *(const i32x4v*)(toke + (size_t)r * 4); tp = *(const i32x4v*)(tokp + (size_t)r * 4); }
    while (r < NROWS) {
        int rn = r + NGW; while (rn < NROWS && last && (rn % SROW) < CTXL) rn += NGW;
        const int b = r / SROW, s = r - b * SROW;
        const int mb = s < CTXL ? 16 : b; const float* g2 = modv + (size_t)mb * 6144 + 5 * 1024;
        const float* mv = (const float*)(F.ws + WS_MODV) + ((size_t)(last ? l : l + 1) * 17 + mb) * 6144; const float* n1g = F.in[I_N1G] + (last ? l : l + 1) * 1024;
        int slot[4];
#pragma unroll
        for (int k = 0; k < 4; ++k) slot[k] = toff[te[k]] * 256 + tp[k];
        f32x4 v[4], gg[4], g4[4], s4[4], h4[4]; int yw[4][4]; u32x2 xb[4];
#pragma unroll
        for (int j = 0; j < 4; ++j) { const int col = 4 * lane + 256 * j; xb[j] = *(const u32x2*)(X + (size_t)r * 1024 + col); gg[j] = *(const f32x4*)(g2 + col);
            g4[j] = *(const f32x4*)(n1g + col); s4[j] = *(const f32x4*)(mv + 1024 + col); h4[j] = *(const f32x4*)(mv + col); }
#pragma unroll
        for (int k = 0; k < 4; ++k)
#pragma unroll
            for (int j = 0; j < 4; ++j) yw[k][j] = *(const int*)(Y + (size_t)slot[k] * 1024 + 4 * lane + 256 * j);
        i32x4v ten = te, tpn = tp;
        if (rn < NROWS) { ten = *(const i32x4v*)(toke + (size_t)rn * 4); tpn = *(const i32x4v*)(tokp + (size_t)rn * 4); }
        PIN8(xb[0], xb[1], xb[2], xb[3], gg[0], gg[1], gg[2], gg[3]); PIN8(g4[0], g4[1], g4[2], g4[3], s4[0], s4[1], s4[2], s4[3]); PIN4(h4[0], h4[1], h4[2], h4[3]);
        PIN8(yw[0][0], yw[0][1], yw[0][2], yw[0][3], yw[1][0], yw[1][1], yw[1][2], yw[1][3]); PIN8(yw[2][0], yw[2][1], yw[2][2], yw[2][3], yw[3][0], yw[3][1], yw[3][2], yw[3][3]);
        f32x4 ys[4];
#pragma unroll
        for (int j = 0; j < 4; ++j) ys[j] = (f32x4){0.f, 0.f, 0.f, 0.f};
#pragma unroll
        for (int k = 0; k < 4; ++k)
#pragma unroll
            for (int j = 0; j < 4; ++j) { const int w = yw[k][j]; const f32x2 lo = __builtin_amdgcn_cvt_pk_f32_fp8(w, false), hi = __builtin_amdgcn_cvt_pk_f32_fp8(w, true); ys[j].x += lo.x; ys[j].y += lo.y; ys[j].z += hi.x; ys[j].w += hi.y; }
#pragma unroll
        for (int j = 0; j < 4; ++j) v[j] = bf4(xb[j]) + gg[j] * (ys[j] * (1.0f / Y8_SCALE));
        if (!last) {
#pragma unroll
            for (int j = 0; j < 4; ++j) { u32x2 w; w.x = pk2(v[j].x, v[j].y); w.y = pk2(v[j].z, v[j].w); *(u32x2*)(X + (size_t)r * 1024 + 4 * lane + 256 * j) = w; }
            modulate_row_pre<false, true>(v, g4, s4, h4, H + (size_t)r * 1024, lane, F.ws + WS_H8IN + (size_t)r * 1024);
        } else {
            const float rstd = row_rstd(v); float* orow = out + ((size_t)b * SEQ + (s - CTXL)) * 1024;
#pragma unroll
            for (int j = 0; j < 4; ++j) { const int col = 4 * lane + 256 * j; *(f32x4*)(orow + col) = v[j] * rstd * fg[j]; }
        }
        te = ten; tp = tpn; r = rn;
    }
}
__device__ __forceinline__ void chunk_of(int pass, int step, bool& isctx, int& cidx) { isctx = step < 4; cidx = pass == 0 ? (isctx ? step : step - 4) : (isctx ? 3 - step : 35 - step); }

#define LDF(p_) (*(const LAS u32x4*)(p_))
#define BF8(x_) __builtin_bit_cast(bf16x8, (x_))
constexpr int RS_Q = 272, RS_T = 144;
constexpr int LR_QS = 0, LR_KS = LR_QS + 64 * RS_Q, LR_KT = LR_KS + 64 * RS_Q, LR_VT = LR_KT + 128 * RS_T, LR_ST = LR_VT + 128 * RS_T, LR_SC = LR_ST + 128 * RS_Q, LR_ROPE = LR_SC + 64 * RS_T, LR_YS = LR_ROPE + 96 * 32 * 8, LR_END = LR_YS + 64 * RS_Q;
static_assert(LR_END <= LCTL_OFF, "retention LDS");
__device__ __forceinline__ void ret_unit(Frame& F, int l, int b, int h, bool need_ctx) {
    LAS unsigned char* Qs = F.lds + LR_QS; LAS unsigned char* Ks = F.lds + LR_KS; LAS unsigned char* KT = F.lds + LR_KT; LAS unsigned char* VT = F.lds + LR_VT;
    LAS unsigned char* ST = F.lds + LR_ST; LAS unsigned char* Sc = F.lds + LR_SC; LAS unsigned char* Ys = F.lds + LR_YS;
    LAS f32x2* ROPE = (LAS f32x2*)(F.lds + LR_ROPE);
    const bf16* Pq = (const bf16*)(F.ws + WS_P) + 0 * PSTR + h * 128; const bf16* Pk = (const bf16*)(F.ws + WS_P) + 1 * PSTR + h * 128;
    const bf16* VTR = (const bf16*)(F.ws + WS_P) + 2 * PSTR + (size_t)(b * 1024 + h * 128) * SROW;
    const bf16* Pg = (const bf16*)(F.ws + WS_P) + 3 * PSTR + h * 128;
    bf16* AA = (bf16*)(F.ws + WS_AA) + h * 128;
    const float xf = F.in[I_RDF][l * 8 + h], xb = F.in[I_RDB][l * 8 + h];
    const float lf2 = -log1pf(expf(-xf)) * LOG2E, lb2 = -log1pf(expf(-xb)) * LOG2E;
    PHASE_IDS(); const int w = wave, fr = lane & 15, g = lane >> 4;
    const int rowb = b * SROW;
    __syncthreads();
    { const f32x2* rg_ = (const f32x2*)(F.ws + WS_ROPE); for (int i = tid; i < 96 * 32; i += 512) ROPE[i] = rg_[i]; }
    const int p = tid >> 3, sub = tid & 7, hf = sub >> 2, ig = sub & 3, d0 = 64 * hf + 8 * ig;
    const int sg = tid & 7;
    for (int pass = 0; pass < 2; ++pass) {
        const float lg2 = pass ? lb2 : lf2; const float gC = fexp2(64.0f * lg2);
        f32x4 Sacc[8];
#pragma unroll
        for (int nd = 0; nd < 8; ++nd) Sacc[nd] = (f32x4){0.f, 0.f, 0.f, 0.f};
        __syncthreads();
        for (int i = tid; i < 128 * RS_Q / 4; i += 512) ((LAS unsigned*)ST)[i] = 0u;
        u32x4 qa, qb, ka, kb, vv[2];
#define RET_LOAD(step_) do { bool ic_; int ci_; chunk_of(pass, (step_), ic_, ci_); const int s0_ = ic_ ? 64 * ci_ : CTXL + 64 * ci_; const size_t ro_ = (size_t)(rowb + s0_ + p) * 1024 + d0; \
            ka = *(const u32x4*)(Pk + ro_); kb = *(const u32x4*)(Pk + ro_ + 32); qa = *(const u32x4*)(Pq + ro_); qb = *(const u32x4*)(Pq + ro_ + 32); \
            _Pragma("unroll") for (int i2 = 0; i2 < 2; ++i2) { const int it_ = tid + 512 * i2; vv[i2] = *(const u32x4*)(VTR + (size_t)(it_ >> 3) * SROW + s0_ + 8 * (it_ & 7)); } } while (0)
        RET_LOAD(0);
        for (int step = 0; step < 36; ++step) {
            bool isctx; int cidx; chunk_of(pass, step, isctx, cidx);
            const int row0 = rowb + (isctx ? 64 * cidx : CTXL + 64 * cidx);
            const bool do_out = !isctx || need_ctx;
            const size_t go = (size_t)(row0 + p) * 1024 + 16 * sg;
            {
                float cs[8], sn[8];
                if (!isctx) { const LAS f32x2* tab = ROPE + (hf ? (32 + p) * 32 : cidx * 32) + 8 * ig;
#pragma unroll
                    for (int e = 0; e < 8; ++e) { const f32x2 t = tab[e]; cs[e] = t.x; sn[e] = t.y; } }
                else {
#pragma unroll
                    for (int e = 0; e < 8; ++e) { cs[e] = 1.f; sn[e] = 0.f; } }
                float q1[8], q2[8], k1[8], k2[8];
#pragma unroll
                for (int e = 0; e < 8; ++e) { const float a = bfel(qa, e), c = bfel(qb, e); q1[e] = a * cs[e] - c * sn[e]; q2[e] = a * sn[e] + c * cs[e];
                    const float ak = bfel(ka, e), ck = bfel(kb, e); k1[e] = (ak * cs[e] - ck * sn[e]) * 0.08838834764831845f; k2[e] = (ak * sn[e] + ck * cs[e]) * 0.08838834764831845f; }
                if (do_out) {
                    u32x4 w1, w2;
                    w1.x = pk2(q1[0], q1[1]); w1.y = pk2(q1[2], q1[3]); w1.z = pk2(q1[4], q1[5]); w1.w = pk2(q1[6], q1[7]);
                    w2.x = pk2(q2[0], q2[1]); w2.y = pk2(q2[2], q2[3]); w2.z = pk2(q2[4], q2[5]); w2.w = pk2(q2[6], q2[7]);
                    *(LAS u32x4*)(Qs + p * RS_Q + d0 * 2) = w1; *(LAS u32x4*)(Qs + p * RS_Q + (d0 + 32) * 2) = w2;
                }
                u32x4 x1, x2;
                x1.x = pk2(k1[0], k1[1]); x1.y = pk2(k1[2], k1[3]); x1.z = pk2(k1[4], k1[5]); x1.w = pk2(k1[6], k1[7]);
                x2.x = pk2(k2[0], k2[1]); x2.y = pk2(k2[2], k2[3]); x2.z = pk2(k2[4], k2[5]); x2.w = pk2(k2[6], k2[7]);
                if (pass == 0 && do_out) { *(LAS u32x4*)(Ks + p * RS_Q + d0 * 2) = x1; *(LAS u32x4*)(Ks + p * RS_Q + (d0 + 32) * 2) = x2; }
#pragma unroll
                for (int e = 0; e < 8; ++e) { const unsigned a = x1[e >> 1], c = x2[e >> 1];
                    *(LAS unsigned short*)(KT + (d0 + e) * RS_T + p * 2) = (unsigned short)((e & 1) ? (a >> 16) : (a & 0xffffu));
                    *(LAS unsigned short*)(KT + (d0 + 32 + e) * RS_T + p * 2) = (unsigned short)((e & 1) ? (c >> 16) : (c & 0xffffu)); }
#pragma unroll
                for (int i2 = 0; i2 < 2; ++i2) { const int it = tid + 512 * i2; *(LAS u32x4*)(VT + (it >> 3) * RS_T + (it & 7) * 16) = vv[i2]; }
            }
            if (step + 1 < 36) RET_LOAD(step + 1);
            u32x4 f0 = (u32x4){0u, 0u, 0u, 0u}, f1 = f0, g0 = f0, g1 = f0;
            if (pass == 1 && do_out) { f0 = *(const u32x4*)(AA + go); f1 = *(const u32x4*)(AA + go + 8); g0 = *(const u32x4*)(Pg + go); g1 = *(const u32x4*)(Pg + go + 8); }
            __syncthreads();
            if (pass == 0 && do_out) {
                const int mi = w >> 1;
                u32x4 qq[4];
#pragma unroll
                for (int ks = 0; ks < 4; ++ks) qq[ks] = LDF(Qs + (16 * mi + fr) * RS_Q + (32 * ks + 8 * g) * 2);
#pragma unroll
                for (int t = 0; t < 2; ++t) { const int nj = 2 * (w & 1) + t; f32x4 acc = (f32x4){0.f, 0.f, 0.f, 0.f}; u32x4 kk[4];
#pragma unroll
                    for (int ks = 0; ks < 4; ++ks) kk[ks] = LDF(Ks + (16 * nj + fr) * RS_Q + (32 * ks + 8 * g) * 2);
                    if (t == 0) PIN8(qq[0], qq[1], qq[2], qq[3], kk[0], kk[1], kk[2], kk[3]); else PIN4(kk[0], kk[1], kk[2], kk[3]);
#pragma unroll
                    for (int ks = 0; ks < 4; ++ks) acc = MFMA16(BF8(kk[ks]), BF8(qq[ks]), acc);
                    const int i = 16 * mi + fr; float dv_[4];
#pragma unroll
                    for (int r = 0; r < 4; ++r) { const int j = 16 * nj + 4 * g + r, dd = i - j; dv_[r] = acc[r] * fexp2(dd >= 0 ? (float)dd * lf2 : (float)(-dd) * lb2); }
                    u32x2 o; o.x = pk2(dv_[0], dv_[1]); o.y = pk2(dv_[2], dv_[3]); *(LAS u32x2*)(Sc + i * RS_T + (16 * nj + 4 * g) * 2) = o; }
            }
            if (pass == 0 && do_out) __syncthreads();
            if (do_out) {
                const int mi = w >> 1, nd0 = 4 * (w & 1);
                f32x4 a1[4], a2[4];
#pragma unroll
                for (int t = 0; t < 4; ++t) { a1[t] = (f32x4){0.f, 0.f, 0.f, 0.f}; a2[t] = (f32x4){0.f, 0.f, 0.f, 0.f}; }
                if (pass == 0) {
#pragma unroll
                    for (int ks = 0; ks < 2; ++ks) { u32x4 sc, vf[4]; sc = LDF(Sc + (16 * mi + fr) * RS_T + (32 * ks + 8 * g) * 2);
#pragma unroll
                        for (int t = 0; t < 4; ++t) vf[t] = LDF(VT + (16 * (nd0 + t) + fr) * RS_T + (32 * ks + 8 * g) * 2);
                        PIN4(vf[0], vf[1], vf[2], vf[3]);
#pragma unroll
                        for (int t = 0; t < 4; ++t) a1[t] = MFMA16(BF8(vf[t]), BF8(sc), a1[t]); }
                }
#pragma unroll
                for (int ks = 0; ks < 4; ++ks) { u32x4 qq, sf[4]; qq = LDF(Qs + (16 * mi + fr) * RS_Q + (32 * ks + 8 * g) * 2);
#pragma unroll
                    for (int t = 0; t < 4; ++t) sf[t] = LDF(ST + (16 * (nd0 + t) + fr) * RS_Q + (32 * ks + 8 * g) * 2);
                    PIN4(sf[0], sf[1], sf[2], sf[3]);
#pragma unroll
                    for (int t = 0; t < 4; ++t) a2[t] = MFMA16(BF8(sf[t]), BF8(qq), a2[t]); }
                const int il = 16 * mi + fr; const float xi = fexp2(pass == 0 ? (float)(il + 1) * lf2 : (float)(64 - il) * lb2);
#pragma unroll
                for (int t = 0; t < 4; ++t) { u32x2 o; o.x = pk2(a1[t][0] + xi * a2[t][0], a1[t][1] + xi * a2[t][1]); o.y = pk2(a1[t][2] + xi * a2[t][2], a1[t][3] + xi * a2[t][3]);
                    *(LAS u32x2*)(Ys + il * RS_Q + (16 * (nd0 + t) + 4 * g) * 2) = o; }
            }
            {
                bf16x8 af[2]; u32x4 kt[2];
#pragma unroll
                for (int ks = 0; ks < 2; ++ks) kt[ks] = LDF(KT + (16 * w + fr) * RS_T + (32 * ks + 8 * g) * 2);
#pragma unroll
                for (int nh = 0; nh < 4; ++nh) { u32x4 bb[2][2];
#pragma unroll
                    for (int n2 = 0; n2 < 2; ++n2)
#pragma unroll
                        for (int ks = 0; ks < 2; ++ks) bb[n2][ks] = LDF(VT + (16 * (2 * nh + n2) + fr) * RS_T + (32 * ks + 8 * g) * 2);
                    PIN4(bb[0][0], bb[0][1], bb[1][0], bb[1][1]);
                    if (nh == 0) {
#pragma unroll
                        for (int ks = 0; ks < 2; ++ks) { const u32x4 kk = kt[ks]; float z[8];
#pragma unroll
                            for (int e = 0; e < 8; ++e) { const int tok = 32 * ks + 8 * g + e; z[e] = bfel(kk, e) * fexp2(pass == 0 ? (float)(63 - tok) * lf2 : (float)tok * lb2); }
                            u32x4 o; o.x = pk2(z[0], z[1]); o.y = pk2(z[2], z[3]); o.z = pk2(z[4], z[5]); o.w = pk2(z[6], z[7]); af[ks] = __builtin_bit_cast(bf16x8, o); } }
#pragma unroll
                    for (int n2 = 0; n2 < 2; ++n2) { const int nd = 2 * nh + n2; Sacc[nd] = Sacc[nd] * gC;
#pragma unroll
                        for (int ks = 0; ks < 2; ++ks) Sacc[nd] = MFMA16(af[ks], BF8(bb[n2][ks]), Sacc[nd]); } }
            }
            __syncthreads();
#pragma unroll
            for (int nd = 0; nd < 8; ++nd) { u32x2 o; o.x = pk2(Sacc[nd][0], Sacc[nd][1]); o.y = pk2(Sacc[nd][2], Sacc[nd][3]); *(LAS u32x2*)(ST + (16 * nd + fr) * RS_Q + (16 * w + 4 * g) * 2) = o; }
            if (do_out) {
                const u32x4 y0 = *(const LAS u32x4*)(Ys + p * RS_Q + 32 * sg), y1 = *(const LAS u32x4*)(Ys + p * RS_Q + 32 * sg + 16);
                if (pass == 0) { *(u32x4*)(AA + go) = y0; *(u32x4*)(AA + go + 8) = y1; }
                else {
                    float tv[16]; float ss = 0.f;
#pragma unroll
                    for (int e = 0; e < 8; ++e) { tv[e] = bfel(y0, e) + bfel(f0, e); tv[8 + e] = bfel(y1, e) + bfel(f1, e); ss += tv[e] * tv[e] + tv[8 + e] * tv[8 + e]; }
                    ss += __shfl_xor(ss, 1); ss += __shfl_xor(ss, 2); ss += __shfl_xor(ss, 4);
                    const float rstd = rsqrtf(ss * (1.0f / 128.0f) + NORM_EPS);
#pragma unroll
                    for (int e = 0; e < 8; ++e) { const float ga = bfel(g0, e), gb = bfel(g1, e); tv[e] *= rstd * ga * sigmoidf_(ga); tv[8 + e] *= rstd * gb * sigmoidf_(gb); }
                    u32x4 o0, o1;
                    o0.x = pk2(tv[0], tv[1]); o0.y = pk2(tv[2], tv[3]); o0.z = pk2(tv[4], tv[5]); o0.w = pk2(tv[6], tv[7]);
                    o1.x = pk2(tv[8], tv[9]); o1.y = pk2(tv[10], tv[11]); o1.z = pk2(tv[12], tv[13]); o1.w = pk2(tv[14], tv[15]);
                    *(u32x4*)(AA + go) = o0; *(u32x4*)(AA + go + 8) = o1;
                }
            }
        }
#undef RET_LOAD
    }
}
constexpr int NA_SC = 528, NA_SL = 1168;
constexpr int LN_VC = 0, LN_VL = LN_VC + 64 * NA_SC, LN_RPB = LN_VL + 64 * NA_SL, LN_END = LN_RPB + 512 * 4;
static_assert(LN_END <= LCTL_OFF, "NA LDS");
__device__ __forceinline__ int clampi(int v, int lo, int hi) { return v < lo ? lo : (v > hi ? hi : v); }
__device__ __forceinline__ void na_block(float (&s)[8], float& m, float& lsum, f32x4 (&O)[4], const u32x2 (&v)[4][2]) {
    const float mb = xrow_max(fmaxf(fmaxf(fmaxf(s[0], s[1]), fmaxf(s[2], s[3])), fmaxf(fmaxf(s[4], s[5]), fmaxf(s[6], s[7]))));
    const float mn = fmaxf(m, mb); const float alpha = fexp2(m - mn); m = mn;
    float ps = 0.f;
#pragma unroll
    for (int e = 0; e < 8; ++e) { s[e] = fexp2(s[e] - mn); ps += s[e]; }
    lsum = lsum * alpha + ps;
#pragma unroll
    for (int dt = 0; dt < 4; ++dt) O[dt] = O[dt] * alpha;
    u32x4 pw; pw.x = pk2(s[0], s[1]); pw.y = pk2(s[2], s[3]); pw.z = pk2(s[4], s[5]); pw.w = pk2(s[6], s[7]);
    const bf16x8 pf = __builtin_bit_cast(bf16x8, pw);
#pragma unroll
    for (int dt = 0; dt < 4; ++dt) { u32x4 vw; vw.x = v[dt][0].x; vw.y = v[dt][0].y; vw.z = v[dt][1].x; vw.w = v[dt][1].y; O[dt] = MFMA16(__builtin_bit_cast(bf16x8, vw), pf, O[dt]); }
}
__device__ __forceinline__ void na_block_loc(const float (&sv)[4], const bool (&sel)[4], float& m, float& lsum, f32x4 (&O)[4], const u32x2 (&v)[4][2]) {
    const float mb = xrow_max(fmaxf(fmaxf(sv[0], sv[1]), fmaxf(sv[2], sv[3])));
    const float mn = fmaxf(m, mb); const float alpha = fexp2(m - mn); m = mn;
    float e[4]; float ps = 0.f;
#pragma unroll
    for (int r = 0; r < 4; ++r) { e[r] = fexp2(sv[r] - mn); ps += e[r]; }
    lsum = lsum * alpha + ps;
#pragma unroll
    for (int dt = 0; dt < 4; ++dt) O[dt] = O[dt] * alpha;
    u32x4 pw; pw.x = pk2(sel[0] ? e[0] : 0.f, sel[1] ? e[1] : 0.f); pw.y = pk2(sel[2] ? e[2] : 0.f, sel[3] ? e[3] : 0.f);
    pw.z = pk2(sel[0] ? 0.f : e[0], sel[1] ? 0.f : e[1]); pw.w = pk2(sel[2] ? 0.f : e[2], sel[3] ? 0.f : e[3]);
    const bf16x8 pf = __builtin_bit_cast(bf16x8, pw);
#pragma unroll
    for (int dt = 0; dt < 4; ++dt) { u32x4 vw; vw.x = v[dt][0].x; vw.y = v[dt][0].y; vw.z = v[dt][1].x; vw.w = v[dt][1].y; O[dt] = MFMA16(__builtin_bit_cast(bf16x8, vw), pf, O[dt]); }
}
constexpr int LN_KC = LN_RPB + 512 * 4, LN2_END = LN_KC + 256 * 144;
static_assert(LN2_END <= LCTL_OFF, "NA LDS");
__device__ __forceinline__ int na_hi(int rp) { return clampi(2 * rp - 3, 0, 24) + 7; }
__device__ __forceinline__ void na_unit(Frame& F, int l, int b, int h, int rp0, int nrp) {
    LAS unsigned char* VC = F.lds + LN_VC; LAS unsigned char* VL = F.lds + LN_VL; LAS float* RPB = (LAS float*)(F.lds + LN_RPB); LAS unsigned char* KC = F.lds + LN_KC;
    const bf16* Pq = (const bf16*)(F.ws + WS_P) + 4 * PSTR + h * 64; const bf16* Pk = (const bf16*)(F.ws + WS_P) + 5 * PSTR + h * 64;
    const bf16* VTG = (const bf16*)(F.ws + WS_P) + 6 * PSTR + (size_t)(b * 16 + h) * 64 * SROW;
    bf16* AB = (bf16*)(F.ws + WS_AA) + PSTR + h * 64;
    PHASE_IDS(); const int w = wave, fr = lane & 15, g = lane >> 4;
    const int rowb = b * SROW;
    __syncthreads();
    const int sdh = tid >> 3, sch = tid & 7;
    const int rlo0 = clampi(2 * rp0 - 4, 0, 24);
    { u32x4 tk[4], tv[4], tl[9]; float rb = 0.f;
#pragma unroll
      for (int i = 0; i < 4; ++i) { const int it = tid + 512 * i; tk[i] = *(const u32x4*)(Pk + (size_t)(rowb + (it >> 3)) * 1024 + 8 * (it & 7)); tv[i] = *(const u32x4*)(VTG + (size_t)(it >> 5) * SROW + 8 * (it & 31)); }
#pragma unroll
      for (int i = 0; i < 9; ++i) tl[i] = *(const u32x4*)(VTG + (size_t)sdh * SROW + CTXL + (rlo0 + i) * 64 + 8 * sch);
      if (tid < 465) rb = F.in[I_RPB][((size_t)l * 16 + h) * 465 + tid];
      PIN8(tk[0], tk[1], tk[2], tk[3], tv[0], tv[1], tv[2], tv[3]); PIN8(tl[0], tl[1], tl[2], tl[3], tl[4], tl[5], tl[6], tl[7]); PIN4(tl[8], rb, tk[0], tk[1]);
#pragma unroll
      for (int i = 0; i < 4; ++i) { const int it = tid + 512 * i; *(LAS u32x4*)(KC + (it >> 3) * 144 + (it & 7) * 16) = tk[i]; *(LAS u32x4*)(VC + (it >> 5) * NA_SC + (it & 31) * 16) = tv[i]; }
#pragma unroll
      for (int i = 0; i < 9; ++i) *(LAS u32x4*)(VL + sdh * NA_SL + ((rlo0 + i) % 9) * 128 + sch * 16) = tl[i];
      if (tid < 465) RPB[tid] = rb * LOG2E; }
    const float qs = 0.125f * LOG2E;
    bf16x8 qfn[2], kn[4];
#define NA_LOADK(dst, R_) do { _Pragma("unroll") for (int t = 0; t < 2; ++t) { const bf16* kp = Pk + (size_t)(rowb + CTXL + (R_) * 64 + cspan + 16 * t + fr) * 1024 + 8 * g; dst[2 * t] = *(const bf16x8*)kp; dst[2 * t + 1] = *(const bf16x8*)(kp + 32); } } while (0)
    { const int q0 = 16 * (w & 3), cspan = clampi(q0 - 8, 0, 32), qr = 2 * rp0 + (w >> 2);
      NA_LOADK(kn, clampi(qr - 4, 0, 24));
#pragma unroll
      for (int ks = 0; ks < 2; ++ks) qfn[ks] = *(const bf16x8*)(Pq + (size_t)(rowb + CTXL + qr * 64 + q0 + fr) * 1024 + 32 * ks + 8 * g); }
    for (int rp = rp0; rp < rp0 + nrp; ++rp) {
        u32x4 nr0 = (u32x4){0u, 0u, 0u, 0u}, nr1 = nr0; const int hcur = na_hi(rp), hnxt = rp < rp0 + nrp - 1 ? na_hi(rp + 1) : hcur;
        if (hnxt > hcur) nr0 = *(const u32x4*)(VTG + (size_t)sdh * SROW + CTXL + (hcur + 1) * 64 + 8 * sch);
        if (hnxt > hcur + 1) nr1 = *(const u32x4*)(VTG + (size_t)sdh * SROW + CTXL + (hcur + 2) * 64 + 8 * sch);
        __syncthreads();
        const int ra = 2 * rp;
        const int qr = ra + (w >> 2), q0 = 16 * (w & 3); const int qrow = rowb + CTXL + qr * 64 + q0 + fr;
        bf16x8 qf[2]; qf[0] = qfn[0]; qf[1] = qfn[1];
        float m = -INFINITY, lsum = 0.f; f32x4 O[4]; float m2 = -INFINITY, lsum2 = 0.f; f32x4 O2[4];
#pragma unroll
        for (int dt = 0; dt < 4; ++dt) { O[dt] = (f32x4){0.f, 0.f, 0.f, 0.f}; O2[dt] = (f32x4){0.f, 0.f, 0.f, 0.f}; }
        const int r0 = clampi(qr - 4, 0, 24), cspan = clampi(q0 - 8, 0, 32); const int cq = q0 + fr, wst = clampi(cq - 8, 0, 48);
        bool sel[4]; int cixs[4];
#pragma unroll
        for (int r = 0; r < 4; ++r) { const int c0 = cspan + 4 * g + r; sel[r] = c0 >= wst; cixs[r] = clampi((sel[r] ? c0 : c0 + 16) - cq + 15, 0, 30); }
#pragma unroll
        for (int kb = 0; kb < 8; ++kb) {
            const int R = r0 + kb;
            u32x4 kc[2][2]; u32x2 vc[4][2], vl[4][2]; float rb[4];
#pragma unroll
            for (int t = 0; t < 2; ++t) { const LAS unsigned char* kp = KC + (32 * kb + 16 * t + fr) * 144 + 16 * g; kc[t][0] = *(const LAS u32x4*)kp; kc[t][1] = *(const LAS u32x4*)(kp + 64); }
#pragma unroll
            for (int r = 0; r < 4; ++r) rb[r] = RPB[(R - qr + 7) * 31 + cixs[r]];
#pragma unroll
            for (int dt = 0; dt < 4; ++dt) { const LAS unsigned char* vp = VC + (16 * dt + fr) * NA_SC + (32 * kb + 4 * g) * 2; vc[dt][0] = *(const LAS u32x2*)vp; vc[dt][1] = *(const LAS u32x2*)(vp + 32);
                const LAS unsigned char* vq = VL + (16 * dt + fr) * NA_SL + ((R % 9) * 64 + cspan + 4 * g) * 2; vl[dt][0] = *(const LAS u32x2*)vq; vl[dt][1] = *(const LAS u32x2*)(vq + 32); }
            __builtin_amdgcn_sched_barrier(0);
            float s[8];
#pragma unroll
            for (int t = 0; t < 2; ++t) { f32x4 a = (f32x4){0.f, 0.f, 0.f, 0.f};
                a = MFMA16(__builtin_bit_cast(bf16x8, kc[t][0]), qf[0], a); a = MFMA16(__builtin_bit_cast(bf16x8, kc[t][1]), qf[1], a);
#pragma unroll
                for (int r = 0; r < 4; ++r) s[4 * t + r] = a[r] * qs; }
            float sv[4];
            { f32x4 a0 = (f32x4){0.f, 0.f, 0.f, 0.f}, a1 = a0;
              a0 = MFMA16(kn[0], qf[0], a0); a0 = MFMA16(kn[1], qf[1], a0); a1 = MFMA16(kn[2], qf[0], a1); a1 = MFMA16(kn[3], qf[1], a1);
#pragma unroll
              for (int r = 0; r < 4; ++r) sv[r] = (sel[r] ? a0[r] : a1[r]) * qs + rb[r]; }
            if (kb < 7) NA_LOADK(kn, R + 1);
            else if (rp + 1 < rp0 + nrp) { const int qrn = ra + 2 + (w >> 2);
                NA_LOADK(kn, clampi(qrn - 4, 0, 24));
#pragma unroll
                for (int ks = 0; ks < 2; ++ks) qfn[ks] = *(const bf16x8*)(Pq + (size_t)(rowb + CTXL + qrn * 64 + q0 + fr) * 1024 + 32 * ks + 8 * g); }
            na_block(s, m, lsum, O, vc);
            na_block_loc(sv, sel, m2, lsum2, O2, vl);
        }
        { const float mm = fmaxf(m, m2); const float c1 = fexp2(m - mm), c2 = fexp2(m2 - mm); lsum = lsum * c1 + lsum2 * c2;
#pragma unroll
          for (int dt = 0; dt < 4; ++dt) O[dt] = O[dt] * c1 + O2[dt] * c2; }
        lsum = xrow_sum(lsum);
        const float inv = 1.0f / lsum;
        int fr_o = fr; asm volatile("" : "+v"(fr_o)); const int qrow_o = rowb + CTXL + qr * 64 + q0 + fr_o;
#pragma unroll
        for (int dt = 0; dt < 4; ++dt) { u32x2 o; o.x = pk2(O[dt][0] * inv, O[dt][1] * inv); o.y = pk2(O[dt][2] * inv, O[dt][3] * inv); *(u32x2*)(AB + (size_t)qrow_o * 1024 + 16 * dt + 4 * g) = o; }
        __syncthreads();
        if (hnxt > hcur) *(LAS u32x4*)(VL + sdh * NA_SL + ((hcur + 1) % 9) * 128 + sch * 16) = nr0;
        if (hnxt > hcur + 1) *(LAS u32x4*)(VL + sdh * NA_SL + ((hcur + 2) % 9) * 128 + sch * 16) = nr1;
    }
#undef NA_LOADK
    __syncthreads();
}
constexpr int RS_UF = 528;
constexpr int LL_UB = 0, LL_UF = LL_UB + 64 * RS_Q, LL_HB = LL_UF + 64 * RS_UF, LL_CW = LL_HB + 64 * RS_UF, LL_END = LL_CW + 5 * 128 * 4;
static_assert(LL_END <= LCTL_OFF, "LRU LDS");
__device__ __forceinline__ float fsig(float x) { return __builtin_amdgcn_rcpf(1.0f + __builtin_amdgcn_exp2f(-x * LOG2E)); }
__device__ __forceinline__ float fgelu(float y) { const float z = 0.7978845608028654f * (y + 0.044715f * y * y * y); const float t = 1.0f - 2.0f * __builtin_amdgcn_rcpf(__builtin_amdgcn_exp2f(2.0f * LOG2E * z) + 1.0f); return 0.5f * y * (1.0f + t); }
template <int DIR> __device__ __forceinline__ void lru_scan(const float (&av)[4][4], const float (&bv)[4][4], float& hcar, LAS unsigned char* Hb, int co, int fr, int g) {
    float hl[4][4], cm[4][4], ce[4], he[4];
#pragma unroll
    for (int mt = 0; mt < 4; ++mt) { float h_ = 0.f, c_ = 1.f;
#pragma unroll
        for (int ri = 0; ri < 4; ++ri) { const int r = DIR == 0 ? ri : 3 - ri; h_ = av[mt][r] * h_ + bv[mt][r]; c_ *= av[mt][r]; hl[mt][r] = h_; cm[mt][r] = c_; }
        ce[mt] = c_; he[mt] = h_; }
    float P[4][4], H[4][4];
#pragma unroll
    for (int mt = 0; mt < 4; ++mt)
#pragma unroll
        for (int gg = 0; gg < 4; ++gg) { P[mt][gg] = __shfl(ce[mt], fr + 16 * gg); H[mt][gg] = __shfl(he[mt], fr + 16 * gg); }
    PIN8(P[0][0], P[0][1], P[0][2], P[0][3], H[0][0], H[0][1], H[0][2], H[0][3]); PIN8(P[1][0], P[1][1], P[1][2], P[1][3], H[1][0], H[1][1], H[1][2], H[1][3]);
    PIN8(P[2][0], P[2][1], P[2][2], P[2][3], H[2][0], H[2][1], H[2][2], H[2][3]); PIN8(P[3][0], P[3][1], P[3][2], P[3][3], H[3][0], H[3][1], H[3][2], H[3][3]);
    float x = hcar;
#pragma unroll
    for (int mi = 0; mi < 4; ++mi) { const int mt = DIR == 0 ? mi : 3 - mi; float xin = x;
#pragma unroll
        for (int gi = 0; gi < 4; ++gi) { const int gg = DIR == 0 ? gi : 3 - gi; if (g == gg) xin = x; x = P[mt][gg] * x + H[mt][gg]; }
#pragma unroll
        for (int r = 0; r < 4; ++r) *(LAS float*)(Hb + (16 * mt + 4 * g + r) * RS_UF + co * 4) = hl[mt][r] + cm[mt][r] * xin; }
    hcar = x;
}
__device__ __forceinline__ void lru_unit(Frame& F, int l, int b, int kblk, bool need_ctx) {
    LAS unsigned char* Ub = F.lds + LL_UB; LAS unsigned char* Uf = F.lds + LL_UF; LAS unsigned char* Hb = F.lds + LL_HB; LAS float* CW = (LAS float*)(F.lds + LL_CW);
    const int ch0 = 128 * kblk;
    const bf16* Plx = (const bf16*)(F.ws + WS_P) + 7 * PSTR + ch0; const bf16* Ply = (const bf16*)(F.ws + WS_P) + 8 * PSTR + ch0;
    bf16* AC = (bf16*)(F.ws + WS_AA) + 2 * PSTR + ch0;
    PHASE_IDS(); const int w = wave, fr = lane & 15, g = lane >> 4;
    const int rowb = b * SROW;
    __syncthreads();
    for (int i = tid; i < 5 * 128; i += 512) { const int j = i >> 7, c = i & 127; CW[i] = j < 4 ? F.in[I_CONVW][((size_t)l * 4 + j) * 1024 + ch0 + c] : F.in[I_CONVB][(size_t)l * 1024 + ch0 + c]; }
    __syncthreads();
    const int co = 16 * w + fr;
    const int p = tid >> 3, c0 = 16 * (tid & 7);
    for (int pass = 0; pass < 2; ++pass) {
        bf16x8 Bfa[4], Bfx[4];
        { const float* wa = F.in[I_GAW] + ((((size_t)l * 2 + pass) * 8 + kblk) * 128) * 128 + co; const float* wx = F.in[I_GXW] + ((((size_t)l * 2 + pass) * 8 + kblk) * 128) * 128 + co;
#pragma unroll
          for (int ks = 0; ks < 4; ++ks) { float ta[8], tx[8];
#pragma unroll
              for (int e = 0; e < 8; ++e) { const int ci = 32 * ks + 8 * g + e; ta[e] = wa[(size_t)ci * 128]; tx[e] = wx[(size_t)ci * 128]; }
              u32x4 oa, ox; oa.x = pk2(ta[0], ta[1]); oa.y = pk2(ta[2], ta[3]); oa.z = pk2(ta[4], ta[5]); oa.w = pk2(ta[6], ta[7]);
              ox.x = pk2(tx[0], tx[1]); ox.y = pk2(tx[2], tx[3]); ox.z = pk2(tx[4], tx[5]); ox.w = pk2(tx[6], tx[7]);
              Bfa[ks] = __builtin_bit_cast(bf16x8, oa); Bfx[ks] = __builtin_bit_cast(bf16x8, ox); } }
        const size_t vo = ((size_t)l * 2 + pass) * 1024 + ch0 + co;
        const float ba = F.in[I_GAB][vo], bx = F.in[I_GXB][vo]; const float nsp8 = -8.0f * LOG2E * log1pf(expf(-F.in[I_LAM][vo]));
        float hcar = 0.f;
        u32x4 xr[4][2];
#define LRU_LOAD_X(step_) do { bool ic_; int ci_; chunk_of(pass, (step_), ic_, ci_); const int sb_ = rowb + (ic_ ? 0 : CTXL), sl_ = ic_ ? CTXL : SEQ, tb_ = 64 * ci_; \
            _Pragma("unroll") for (int j = 0; j < 4; ++j) { const int tt = tb_ + p + j - 1; if (tt >= 0 && tt < sl_) { const bf16* xp = Plx + (size_t)(sb_ + tt) * 1024 + c0; xr[j][0] = *(const u32x4*)xp; xr[j][1] = *(const u32x4*)(xp + 8); } \
                else { xr[j][0] = (u32x4){0u, 0u, 0u, 0u}; xr[j][1] = (u32x4){0u, 0u, 0u, 0u}; } } } while (0)
        LRU_LOAD_X(0);
        for (int step = 0; step < 36; ++step) {
            bool isctx; int cidx; chunk_of(pass, step, isctx, cidx);
            const int segb = rowb + (isctx ? 0 : CTXL), t0 = 64 * cidx;
            const bool do_out = !isctx || need_ctx;
            const size_t go = (size_t)(segb + t0 + p) * 1024 + c0;
            { float u[16];
#pragma unroll
              for (int e = 0; e < 16; ++e) u[e] = CW[4 * 128 + c0 + e];
#pragma unroll
              for (int j = 0; j < 4; ++j) {
#pragma unroll
                  for (int e = 0; e < 8; ++e) { u[e] += CW[j * 128 + c0 + e] * bfel(xr[j][0], e); u[8 + e] += CW[j * 128 + c0 + 8 + e] * bfel(xr[j][1], e); } }
              u32x4 o0, o1; o0.x = pk2(u[0], u[1]); o0.y = pk2(u[2], u[3]); o0.z = pk2(u[4], u[5]); o0.w = pk2(u[6], u[7]);
              o1.x = pk2(u[8], u[9]); o1.y = pk2(u[10], u[11]); o1.z = pk2(u[12], u[13]); o1.w = pk2(u[14], u[15]);
              *(LAS u32x4*)(Ub + p * RS_Q + c0 * 2) = o0; *(LAS u32x4*)(Ub + p * RS_Q + c0 * 2 + 16) = o1;
#pragma unroll
              for (int q = 0; q < 4; ++q) *(LAS f32x4*)(Uf + p * RS_UF + (c0 + 4 * q) * 4) = (f32x4){u[4 * q], u[4 * q + 1], u[4 * q + 2], u[4 * q + 3]}; }
            if (step + 1 < 36) LRU_LOAD_X(step + 1);
            u32x4 pf0 = (u32x4){0u, 0u, 0u, 0u}, pf1 = pf0, py0 = pf0, py1 = pf0;
            if (pass == 1 && do_out) { pf0 = *(const u32x4*)(AC + go); pf1 = *(const u32x4*)(AC + go + 8); py0 = *(const u32x4*)(Ply + go); py1 = *(const u32x4*)(Ply + go + 8); }
            __syncthreads();
            float av[4][4], bv[4][4];
#pragma unroll
            for (int mh = 0; mh < 2; ++mh) {
                u32x4 af[2][4]; float uu[2][4];
#pragma unroll
                for (int mm = 0; mm < 2; ++mm) {
#pragma unroll
                    for (int ks = 0; ks < 4; ++ks) af[mm][ks] = *(const LAS u32x4*)(Ub + (16 * (2 * mh + mm) + fr) * RS_Q + (32 * ks + 8 * g) * 2);
#pragma unroll
                    for (int r = 0; r < 4; ++r) uu[mm][r] = *(const LAS float*)(Uf + (16 * (2 * mh + mm) + 4 * g + r) * RS_UF + co * 4); }
                PIN8(af[0][0], af[0][1], af[0][2], af[0][3], af[1][0], af[1][1], af[1][2], af[1][3]); PIN8(uu[0][0], uu[0][1], uu[0][2], uu[0][3], uu[1][0], uu[1][1], uu[1][2], uu[1][3]);
#pragma unroll
                for (int mm = 0; mm < 2; ++mm) { const int mt = 2 * mh + mm; f32x4 ga = (f32x4){0.f, 0.f, 0.f, 0.f}, gx = ga;
#pragma unroll
                    for (int ks = 0; ks < 4; ++ks) { const bf16x8 a = __builtin_bit_cast(bf16x8, af[mm][ks]); ga = MFMA16(a, Bfa[ks], ga); gx = MFMA16(a, Bfx[ks], gx); }
#pragma unroll
                    for (int r = 0; r < 4; ++r) { const float rr = fsig(ga[r] + ba), ii = fsig(gx[r] + bx);
                        const float a_ = __builtin_amdgcn_exp2f(nsp8 * rr);
                        av[mt][r] = a_; bv[mt][r] = __builtin_amdgcn_sqrtf(fmaxf(1.0f - a_ * a_, 0.f)) * ii * uu[mm][r]; } } }
            if (pass == 0) lru_scan<0>(av, bv, hcar, Hb, co, fr, g); else lru_scan<1>(av, bv, hcar, Hb, co, fr, g);
            __syncthreads();
            if (do_out) { float hv[16];
#pragma unroll
                for (int q = 0; q < 4; ++q) { const f32x4 t = *(const LAS f32x4*)(Hb + p * RS_UF + (c0 + 4 * q) * 4); hv[4 * q] = t.x; hv[4 * q + 1] = t.y; hv[4 * q + 2] = t.z; hv[4 * q + 3] = t.w; }
                if (pass == 1) {
#pragma unroll
                    for (int e = 0; e < 8; ++e) { hv[e] = (hv[e] + bfel(pf0, e)) * fgelu(bfel(py0, e)); hv[8 + e] = (hv[8 + e] + bfel(pf1, e)) * fgelu(bfel(py1, e)); } }
                u32x4 o0, o1; o0.x = pk2(hv[0], hv[1]); o0.y = pk2(hv[2], hv[3]); o0.z = pk2(hv[4], hv[5]); o0.w = pk2(hv[6], hv[7]);
                o1.x = pk2(hv[8], hv[9]); o1.y = pk2(hv[10], hv[11]); o1.z = pk2(hv[12], hv[13]); o1.w = pk2(hv[14], hv[15]);
                *(u32x4*)(AC + go) = o0; *(u32x4*)(AC + go + 8) = o1; }
        }
#undef LRU_LOAD_X
        __syncthreads();
    }
}

__device__ __forceinline__ int queue_pop(Frame& F, unsigned* q) {
    __syncthreads();
    if (threadIdx.x == 0) F.MISC[0] = atomicAdd(q, 1u);
    __syncthreads();
    return (int)F.MISC[0];
}
#ifndef PHMASK
#define PHMASK 0xffff
#endif
#define PHM(b) ((PHMASK >> (b)) & 1)
__device__ __forceinline__ void p3_convert_chunks(Frame& F, unsigned* qc) {
    for (;;) { const int q = queue_pop(F, qc); if (q >= P0_NCHUNK) break; PHASE_IDS(); p0_convert(F, P0_I2 + q * P0_CHUNK + wave, 8, P0_I2 + (q + 1) * P0_CHUNK, wave, lane); }
}
__device__ __forceinline__ void p3_mixers(Frame& F, int l, bool need_ctx, int rep, int qmask) {
    unsigned* q = F.ctl + CW_Q + (l * 3 + rep * 6) * 64;
    const bool conv = (l == 0 && rep == 0); unsigned* qc = F.ctl + CW_Q + 13 * 64;
    if (PHM(3) && (qmask & 1)) for (;;) { const int u = queue_pop(F, q); if (u >= NB * 8) break; ret_unit(F, l, u >> 3, u & 7, need_ctx); }
    if (PHM(4) && (qmask & 2)) for (;;) { const int u = queue_pop(F, q + 64); if (u >= NB * 8) break; lru_unit(F, l, u >> 3, u & 7, need_ctx); }
    bool cleft = conv;
    if (PHM(5) && (qmask & 4)) for (;;) { const int u = queue_pop(F, q + 128); if (u >= 640) break;
        const int v = u - 384; const int pr = u < 384 ? (u >> 1) : 192 + (v >> 2); const int r0_ = u < 384 ? 8 * (u & 1) : 4 * (v & 3);
        na_unit(F, l, pr >> 4, pr & 15, r0_, u < 384 ? 8 : 4);
        if (cleft && u >= 128) { const int qq = queue_pop(F, qc); if (qq < P0_NCHUNK) { PHASE_IDS(); p0_convert(F, P0_I2 + qq * P0_CHUNK + wave, 8, P0_I2 + (qq + 1) * P0_CHUNK, wave, lane); } else cleft = false; } }
    if (cleft) p3_convert_chunks(F, qc);
}
__global__ void __launch_bounds__(512, 2) fwd_kernel(Args args) {
    extern __shared__ __attribute__((aligned(16))) unsigned char lds[];
    Frame F;
    F.lds = (LAS unsigned char*)lds; F.MISC = (volatile LAS unsigned*)(F.lds + LCTL_OFF);
    F.G = gridDim.x; F.c = blockIdx.x; F.vcu = (F.G % 8 == 0) ? (F.c % 8) * (F.G / 8) + F.c / 8 : F.c;
    F.ws = args.ws; F.ctl = (unsigned*)(args.ws + WS_CTL); F.in = args.in;
    for (int u = threadIdx.x; u < (LDS_BYTES - LCTL_OFF) / 4; u += 512) ((LAS unsigned*)(F.lds + LCTL_OFF))[u] = 0u;
    __syncthreads();
    XcdBarrier bar; bar.bar = F.ctl + CW_BAR; bar.x = 0; bar.st = nullptr;
    if (!MK_PER_PHASE) bar = xcd_barrier_post(F.ctl + CW_BAR, F.MISC + 8);
    const int lo = args.ph_lo, hi = args.ph_hi;
#ifndef PHMASK
#define PHMASK 0xffff
#endif
#define PHM(b) ((PHMASK >> (b)) & 1)
#define IN(k) (lo <= (k) && (k) < hi)
#define SEAM(k) do { if (IN(k) && IN((k) + 1)) xcd_barrier(bar); } while (0)
    volatile LAS int* toff = (volatile LAS int*)(F.lds + LCTL_OFF + 256);

    if (PHM(0) && IN(0)) { p0_prologue(F, 1 + ((REP_MASK >> 2) & 1)); } SEAM(0);
    if (PHM(1) && IN(1)) { p1_norm1(F); } SEAM(1);
    for (int l = 0; l < DEPTH; ++l) {
        const int pb = 2 + 9 * l; const bool last = (l == DEPTH - 1);
        if (PHM(2) && IN(pb + 0)) {
            SchedDense S; S.init(F.ws + WS_H, F.ws + WS_WMIX + (size_t)l * 12288 * 1024 * 2, 1024, 40, false, F.G, F.c, true);
            SchedV8 S8; S8.init(F.ws + WS_H8IN, F.ws + WS_WMIX + (size_t)l * 12288 * 1024 * 2, F.G, F.c);
            EpiProj E{(bf16*)(F.ws + WS_P)};
            for (int rep = 0; rep < 1 + (REP_MASK & 1); ++rep) { pg8::gemm_phase<EpiProj, SchedDense, true>(F.lds, 1024, S, E); pg8::gemm_phase<EpiProj, SchedV8, true>(F.lds, 512, S8, E); }
        } SEAM(pb + 0);
        if (IN(pb + 1)) { constexpr int nrep = 1 + (((REP_MASK >> 3) & 7) ? 1 : 0); for (int rep = 0; rep < nrep; ++rep) { p3_mixers(F, l, !last, rep, rep == 0 ? 7 : ((REP_MASK >> 3) & 7)); if (rep + 1 < nrep) xcd_barrier(bar); } } SEAM(pb + 1);
        if (PHM(6) && IN(pb + 2)) {
            SchedBranch S; S.init(F.ws + WS_AA, F.ws + WS_WBR + (size_t)l * 3 * 1024 * 1024 * 2, last, F.G, F.c);
            EpiBranch E{(const bf16*)(F.ws + WS_P) + 9 * PSTR, (bf16*)(F.ws + WS_MB)};
            for (int rep = 0; rep < 1 + (REP_MASK & 1); ++rep) pg8::gemm_phase<EpiBranch, SchedBranch, true>(F.lds, 1024, S, E);
        } SEAM(pb + 2);
        if (PHM(7) && IN(pb + 3)) {
            SchedDense S; S.init(F.ws + WS_MB, F.ws + WS_WOUT + (size_t)l * 1024 * 1024 * 2, 1024, 4, last, F.G, F.c);
            if (l == 0) { EpiOut<true> E{F.in[I_X], F.in[I_CTX], (bf16*)(F.ws + WS_X), (const float*)(F.ws + WS_MODV)}; pg8::gemm_phase<EpiOut<true>, SchedDense, true>(F.lds, 1024, S, E); }
            else { EpiOut<false> E{F.in[I_X], F.in[I_CTX], (bf16*)(F.ws + WS_X), (const float*)(F.ws + WS_MODV) + (size_t)l * 17 * 6144}; pg8::gemm_phase<EpiOut<false>, SchedDense, true>(F.lds, 1024, S, E); }
        } SEAM(pb + 3);
        if (PHM(8) && IN(pb + 4)) { p6_router(F, l, last); } SEAM(pb + 4);
        if (PHM(10) && IN(pb + 6)) {
            moe_toff(F, l, toff);
            SchedMoE<true> S; S.init(F.ws + WS_H, F.ws + WS_WUP + (size_t)l * 32 * 2048 * 1024, (size_t)2048 * 1024, toff, 8, F.G, F.c, (const int*)(F.ws + WS_ROWMAP));
            EpiUp E{(unsigned char*)(F.ws + WS_ACT), F.in[I_BUP] + (size_t)l * 32 * 2048};
            for (int rep = 0; rep < 1 + (REP_MASK & 1); ++rep) pg8::gemm_phase<EpiUp, SchedMoE<true>, true>(F.lds, 512, S, E);
        } SEAM(pb + 6);
        if (PHM(11) && IN(pb + 7)) {
            moe_toff(F, l, toff);
            SchedMoE<false> S; S.init(F.ws + WS_ACT, F.ws + WS_WDN + (size_t)l * 32 * 1024 * 1024, (size_t)1024 * 1024, toff, 4, F.G, F.c, nullptr);
            EpiDown E{(unsigned char*)(F.ws + WS_H2S), F.in[I_BDN] + (size_t)l * 32 * 1024, (const float*)(F.ws + WS_ROWW)};
            for (int rep = 0; rep < 1 + (REP_MASK & 1); ++rep) pg8::gemm_phase<EpiDown, SchedMoE<false>, true>(F.lds, 512, S, E);
        } SEAM(pb + 7);
        if (PHM(12) && IN(pb + 8)) { p9_combine(F, l, last, args.out); } SEAM(pb + 8);
    }
#undef IN
#undef SEAM
}

extern "C" void kernel_launch(void* const* d_in, const int* in_sizes, int n_in, void* d_out, int out_size, void* d_ws, size_t ws_size, hipStream_t stream) {
    static int grid = 0;
    if (grid == 0) {
        if (n_in != 28 || ws_size < WS_END) { fprintf(stderr, "kernel_launch: expected 28 inputs and >= %zu bytes of workspace; got %d, %zu\n", (size_t)WS_END, n_in, ws_size); grid = -1; return; }
        int dev = 0, cus = 0, per_cu = 0;
        if (hipGetDevice(&dev) != hipSuccess || hipDeviceGetAttribute(&cus, hipDeviceAttributeMultiprocessorCount, dev) != hipSuccess) { grid = -1; return; }
        if (hipFuncSetAttribute((const void*)fwd_kernel, hipFuncAttributeMaxDynamicSharedMemorySize, LDS_BYTES) != hipSuccess) { fprintf(stderr, "kernel_launch: hipFuncSetAttribute failed\n"); grid = -1; return; }
        if (hipOccupancyMaxActiveBlocksPerMultiprocessor(&per_cu, (const void*)fwd_kernel, 512, LDS_BYTES) != hipSuccess || per_cu < 1) fprintf(stderr, "kernel_launch: occupancy query reports %d\n", per_cu);
        (void)hipGetLastError();
        grid = cus > 256 ? 256 : cus;
    }
    if (grid < 0) return;
    if (hipMemsetAsync((char*)d_ws + WS_CTL, 0, CTL_ZERO_BYTES, stream) != hipSuccess) return;
    Args a{};
    for (int i = 0; i < 28; ++i) a.in[i] = (const float*)d_in[i];
    a.out = (float*)d_out; a.ws = (unsigned char*)d_ws;
#if MK_PER_PHASE
    for (int p = 0; p < N_PHASES; ++p) { a.ph_lo = p; a.ph_hi = p + 1; hipLaunchKernelGGL(fwd_kernel, dim3(grid), dim3(512), LDS_BYTES, stream, a); }
#else
    a.ph_lo = 0; a.ph_hi = N_PHASES;
    hipLaunchKernelGGL(fwd_kernel, dim3(grid), dim3(512), LDS_BYTES, stream, a);
#endif
    const hipError_t le = hipPeekAtLastError();
    if (le != hipSuccess) fprintf(stderr, "kernel_launch: launch failed: %s\n", hipGetErrorName(le));
}
```

```cpp
#include <hip/hip_runtime.h>
#include <cstdio>
#include <cstdint>

#define GAS __attribute__((address_space(1)))
#define LAS __attribute__((address_space(3)))
typedef unsigned short bf16;
typedef short bf16x8 __attribute__((ext_vector_type(8)));
typedef float f32x4 __attribute__((ext_vector_type(4)));
typedef float f32x2 __attribute__((ext_vector_type(2)));
typedef unsigned u32x4 __attribute__((ext_vector_type(4)));
typedef unsigned u32x2 __attribute__((ext_vector_type(2)));
typedef GAS unsigned gu32;

constexpr int D = 1024, NB = 16, SEQ = 2048, CTXL = 256, SROW = CTXL + SEQ, NROWS = NB * SROW, DEPTH = 2;
constexpr int INW = 12288, NEXP = 32, DEXP = 1024;
constexpr size_t PSTR = (size_t)NROWS * 1024;
constexpr int MAXSORT = NROWS * 4 + NEXP * 256;
constexpr float NORM_EPS = 1e-6f;
constexpr float LOG2E = 1.4426950408889634f;

constexpr size_t MiB = 1u << 20;
constexpr size_t WS_CTL = 0, CTL_ZERO_BYTES = 1 * MiB;
constexpr size_t WS_MODV = 1 * MiB;
constexpr size_t WS_ROPE = 2 * MiB;
constexpr size_t WS_TOKE = 3 * MiB, WS_TOKP = 4 * MiB, WS_TOKW = 5 * MiB;
constexpr size_t WS_WMIX = 8 * MiB;
constexpr size_t WS_WBR = 56 * MiB;
constexpr size_t WS_WOUT = 68 * MiB;
constexpr size_t WS_WUP = 72 * MiB;
constexpr size_t WS_WDN = 328 * MiB;
constexpr size_t WS_X = 456 * MiB;
constexpr size_t WS_H8IN = 528 * MiB;
constexpr size_t WS_H = 600 * MiB;
constexpr size_t WS_P = 672 * MiB;
constexpr size_t WS_AA = 1536 * MiB;
constexpr size_t WS_END = 1752 * MiB;
constexpr size_t WS_ROWMAP = WS_P + 10 * 72 * MiB;
constexpr size_t WS_ROWW = WS_ROWMAP + 8 * MiB;
constexpr size_t WS_M32 = WS_P;
constexpr size_t WS_MB = WS_P + 2 * 72 * MiB;
constexpr size_t WS_ACT = WS_P;
constexpr size_t WS_H2S = WS_P + 5 * 72 * MiB;
static_assert(PSTR * 2 == 72 * MiB && (size_t)MAXSORT * 2048 == 304 * MiB && WS_H2S + 304 * MiB <= WS_AA, "ws map");
constexpr int CW_TMO = 0, CW_BAR = 4096, CW_Q = 8192, CW_CNT = 10240;
constexpr int LDS_BYTES = 163840, LCTL_OFF = 162816;
constexpr int N_PHASES = 20;
#ifndef REP_MASK
#define REP_MASK 0
#endif
#ifndef MK_PER_PHASE
#define MK_PER_PHASE 0
#endif

__device__ __forceinline__ float bflo(unsigned w) { return __uint_as_float(w << 16); }
__device__ __forceinline__ float bfhi(unsigned w) { return __uint_as_float(w & 0xffff0000u); }
__device__ __forceinline__ float xrow_max(float x) {
    { const auto r = __builtin_amdgcn_permlane16_swap(__float_as_uint(x), __float_as_uint(x), false, false); x = fmaxf(__uint_as_float(r[0]), __uint_as_float(r[1])); }
    { const auto r = __builtin_amdgcn_permlane32_swap(__float_as_uint(x), __float_as_uint(x), false, false); x = fmaxf(__uint_as_float(r[0]), __uint_as_float(r[1])); }
    return x;
}
__device__ __forceinline__ float xrow_sum(float x) {
    { const auto r = __builtin_amdgcn_permlane16_swap(__float_as_uint(x), __float_as_uint(x), false, false); x = __uint_as_float(r[0]) + __uint_as_float(r[1]); }
    { const auto r = __builtin_amdgcn_permlane32_swap(__float_as_uint(x), __float_as_uint(x), false, false); x = __uint_as_float(r[0]) + __uint_as_float(r[1]); }
    return x;
}
#define PIN4(a, b, c, d) asm volatile("" : "+v"(a), "+v"(b), "+v"(c), "+v"(d))
#define PIN8(a, b, c, d, e, f, g, h) asm volatile("" : "+v"(a), "+v"(b), "+v"(c), "+v"(d), "+v"(e), "+v"(f), "+v"(g), "+v"(h))
__device__ __forceinline__ f32x4 bf4(const u32x2& w) { return (f32x4){bflo(w.x), bfhi(w.x), bflo(w.y), bfhi(w.y)}; }
__device__ __forceinline__ float bfel(const u32x4& w, int e) { const unsigned x = w[e >> 1]; return (e & 1) ? bfhi(x) : bflo(x); }
__device__ __forceinline__ unsigned f2bf(float f) { unsigned u = __float_as_uint(f); return (u + 0x7fffu + ((u >> 16) & 1u)) >> 16; }
typedef __bf16 bf16x2_t __attribute__((ext_vector_type(2)));
__device__ __forceinline__ unsigned pk2(float lo, float hi) { const f32x2 v = {lo, hi}; return __builtin_bit_cast(unsigned, __builtin_convertvector(v, bf16x2_t)); }
__device__ __forceinline__ float wave_sum(float v) {
#pragma unroll
    for (int o = 1; o < 64; o <<= 1) v += __shfl_xor(v, o);
    return v;
}
__device__ __forceinline__ float wave_max(float v) {
#pragma unroll
    for (int o = 1; o < 64; o <<= 1) v = fmaxf(v, __shfl_xor(v, o));
    return v;
}
__device__ __forceinline__ float fexp2(float x) { return __builtin_amdgcn_exp2f(x); }
__device__ __forceinline__ float sigmoidf_(float x) { return __builtin_amdgcn_rcpf(1.0f + __builtin_amdgcn_exp2f(-x * LOG2E)); }
__device__ __forceinline__ float gelu_tanh(float y) { const float z = 0.7978845608028654f * (y + 0.044715f * y * y * y); const float t = 1.0f - 2.0f / (__expf(2.0f * z) + 1.0f); return 0.5f * y * (1.0f + t); }
#define LDS_WAIT() asm volatile("s_waitcnt lgkmcnt(0)" ::: "memory")
#define VM_WAIT() asm volatile("s_waitcnt vmcnt(0)" ::: "memory")
#define RLX_AGENT __ATOMIC_RELAXED, __HIP_MEMORY_SCOPE_AGENT
#define MFMA16(a, b, c) __builtin_amdgcn_mfma_f32_16x16x32_bf16((a), (b), (c), 0, 0, 0)
__device__ __forceinline__ int opaque_tid() { int t = threadIdx.x; asm volatile("" : "+v"(t)); return t; }
typedef int i32x4v __attribute__((ext_vector_type(4)));
typedef int i32x8v __attribute__((ext_vector_type(8)));
__device__ __forceinline__ unsigned pk4_fp8(float a, float b, float c, float d) { int p = 0; p = __builtin_amdgcn_cvt_pk_fp8_f32(a, b, p, false); p = __builtin_amdgcn_cvt_pk_fp8_f32(c, d, p, true); return (unsigned)p; }
constexpr float W8_SCALE = 32.0f, ACT8_SCALE = 4.0f, Y8_SCALE = 16.0f;
constexpr int E8_ONE = 0x7F7F7F7F, E8_W = 0x7A7A7A7A, E8_ACT = 0x7D7D7D7D;
#ifndef RELAX_EPI
#define RELAX_EPI 0
#endif
#ifndef STAGGER_TICKS
#define STAGGER_TICKS 0
#endif
namespace pg8 {
#define PG8_LAS __attribute__((address_space(3)))
constexpr int BM = 256, BK = 64, HALF = 128, HTB = HALF * BK * 2, STAGE_BYTES = 8 * HTB, NXCD = 8, WGM = 8;
__host__ __device__ __forceinline__ int lds_byte(int r, int c) { const int st = (r >> 4) * 2 + (c >> 5), rr = r & 15, cc = c & 31, ob = rr * 64 + cc * 2; return st * 1024 + (ob ^ (((ob >> 9) & 1) << 5)); }
__host__ __device__ __forceinline__ void stage_rc(int b, int& R, int& C) { const int st = b / 1024, sb = b % 1024, swz = sb ^ (((sb >> 9) & 1) << 5); R = (st >> 1) * 16 + swz / 64; C = (st & 1) * 32 + (swz % 64) / 2; }
__host__ __device__ __forceinline__ int perm32(int rho) { const int n = rho >> 4, i = rho & 15; return 8 * (i >> 2) + 4 * n + (i & 3); }
struct Unit { int pm, pn, aux, lt; };
struct StaticOrder {
    int nM, nN, nwg, G, c;
    __device__ __forceinline__ void init(int nM_, int nN_, int G_, int c_) { nM = nM_; nN = nN_; nwg = nM * nN; G = G_; c = c_; }
    __device__ __forceinline__ bool next(int i, int& pm, int& pn) const {
        const long L = (long)i * G + c; if (L >= nwg) return false;
        int wgid = (int)L; { const int q = nwg / NXCD, r = nwg % NXCD, xcd = wgid % NXCD, off = wgid / NXCD; wgid = (xcd < r ? xcd * (q + 1) : r * (q + 1) + (xcd - r) * q) + off; }
        const int nig = WGM * nN, gid = wgid / nig, fm = gid * WGM, gsz = (nM - fm) < WGM ? (nM - fm) : WGM;
        pm = fm + ((wgid % nig) % gsz); pn = (wgid % nig) / gsz; return true;
    }
};
template <class Epi, class Sched, bool ALIGN_EPI>
__device__ __forceinline__ void gemm_phase(PG8_LAS unsigned char* lds, const int K, const Sched& S, const Epi& E) {
    const int tid = opaque_tid(), wid = __builtin_amdgcn_readfirstlane(tid >> 6), lane = tid & 63, wr = wid >> 2, wc = wid & 3, fr = lane & 15, fq = lane >> 4;
    const int nt = K / BK;
    constexpr int NE = Epi::NST < 48 ? Epi::NST : 48;
    unsigned voffA[2], voffB[2];
#pragma unroll
    for (int i = 0; i < 2; ++i) { int R, C; stage_rc(tid * 16 + i * 8192, R, C); const int Rb = Epi::PERM ? ((R & ~31) + perm32(R & 31)) : R;
        voffA[i] = (unsigned)(R * K + C) * 2u; voffB[i] = (unsigned)(Rb * K + C) * 2u; }
    unsigned cao[2][2], nao[2][2];
#define PG8_GMAP_ISSUE(u_) do { _Pragma("unroll") for (int h_ = 0; h_ < 2; ++h_) _Pragma("unroll") for (int i_ = 0; i_ < 2; ++i_) \
        { int R_, C_; int t_ = opaque_tid(); stage_rc(t_ * 16 + i_ * 8192, R_, C_); __builtin_amdgcn_global_load_lds((const unsigned*)S.row_ptr((u_), h_ * 128 + R_), (PG8_LAS unsigned*)(lds + Sched::GMAP_OFF + wid * 1024 + (h_ * 2 + i_) * 256), 4, 0, 0); } } while (0)
#define PG8_GMAP_READ(dst, u_) do { _Pragma("unroll") for (int h_ = 0; h_ < 2; ++h_) _Pragma("unroll") for (int i_ = 0; i_ < 2; ++i_) { \
        int R_, C_; int t_ = opaque_tid(); stage_rc(t_ * 16 + i_ * 8192, R_, C_); \
        const unsigned tok_ = *(const volatile PG8_LAS unsigned*)(lds + Sched::GMAP_OFF + wid * 1024 + (h_ * 2 + i_) * 256 + (t_ & 63) * 4); \
        dst[h_][i_] = (S.row_valid((u_), h_ * 128 + R_) ? tok_ : 0u) * (unsigned)(K * 2) + (unsigned)(C_ * 2); } } while (0)
    const size_t kstep = (size_t)(BK * 2);
    const size_t hstep = (size_t)HALF * K * 2;
    const unsigned ldsw = (unsigned)wid * 1024u;
    const int aoff = lds_byte(wr * 64 + fr, fq * 8), boff = lds_byte(wc * 32 + fr, fq * 8);
#define PG8_SA(b, h) (((b) * 2 + (h)) * HTB)
#define PG8_SB(b, h) ((4 + (b) * 2 + (h)) * HTB)
#define PG8_STAGE(bufoff, gbase, voff) do { _Pragma("unroll") for (int _i = 0; _i < 2; ++_i) \
        __builtin_amdgcn_global_load_lds((const unsigned*)((const char*)(gbase) + (voff)[_i]), (PG8_LAS unsigned*)(lds + (bufoff) + ldsw + _i * 8192), 16, 0, 0); } while (0)
#define PG8_LDA(dst, b, h) do { if constexpr (Sched::FP8) { _Pragma("unroll") for (int m = 0; m < 4; ++m) { const i32x4v lo_ = *(const PG8_LAS i32x4v*)(lds + PG8_SA(b, h) + aoff + m * 2048), hi_ = *(const PG8_LAS i32x4v*)(lds + PG8_SA(b, h) + aoff + m * 2048 + 1024); \
            dst##8[m] = __builtin_shufflevector(lo_, hi_, 0, 1, 2, 3, 4, 5, 6, 7); } } \
        else { _Pragma("unroll") for (int m = 0; m < 4; ++m) _Pragma("unroll") for (int k = 0; k < 2; ++k) dst[m][k] = *(const PG8_LAS bf16x8*)(lds + PG8_SA(b, h) + aoff + m * 2048 + k * 1024); } } while (0)
#define PG8_LDB(dst, b, h) do { if constexpr (Sched::FP8) { _Pragma("unroll") for (int n = 0; n < 2; ++n) { const i32x4v lo_ = *(const PG8_LAS i32x4v*)(lds + PG8_SB(b, h) + boff + n * 2048), hi_ = *(const PG8_LAS i32x4v*)(lds + PG8_SB(b, h) + boff + n * 2048 + 1024); \
            dst##8[n] = __builtin_shufflevector(lo_, hi_, 0, 1, 2, 3, 4, 5, 6, 7); } } \
        else { _Pragma("unroll") for (int n = 0; n < 2; ++n) _Pragma("unroll") for (int k = 0; k < 2; ++k) dst[n][k] = *(const PG8_LAS bf16x8*)(lds + PG8_SB(b, h) + boff + n * 2048 + k * 1024); } } while (0)
#define PG8_MMA(ai, bj, At, Bt) do { __builtin_amdgcn_s_setprio(1); \
        if constexpr (Sched::FP8) { _Pragma("unroll") for (int m = 0; m < 4; ++m) _Pragma("unroll") for (int n = 0; n < 2; ++n) \
            asm volatile("v_mfma_scale_f32_16x16x128_f8f6f4 %0, %1, %2, %0, %3, %4 op_sel_hi:[0,0,0]" : "+v"(acc[ai][bj][m][n]) : "v"(Bt##8[n]), "v"(At##8[m]), "v"(e8b_), "v"(e8a_)); } \
        else { _Pragma("unroll") for (int m = 0; m < 4; ++m) _Pragma("unroll") for (int n = 0; n < 2; ++n) _Pragma("unroll") for (int k = 0; k < 2; ++k) \
            acc[ai][bj][m][n] = __builtin_amdgcn_mfma_f32_16x16x32_bf16(Bt[n][k], At[m][k], acc[ai][bj][m][n], 0, 0, 0); } \
        __builtin_amdgcn_s_setprio(0); } while (0)
#define PG8_WAIT_V(n) asm volatile("s_waitcnt vmcnt(" #n ")" ::: "memory")
#define PG8_WAIT_VN(N) asm volatile("s_waitcnt vmcnt(%0)" :: "n"(N) : "memory")
#define PG8_WAIT_L(n) asm volatile("s_waitcnt lgkmcnt(" #n ")" ::: "memory")
#define PG8_BAR __builtin_amdgcn_s_barrier()
#define PG8_SCHED __builtin_amdgcn_sched_barrier(0)
    Unit cur, nxt; int ui = 0;
    if (!S.next(0, cur)) return;
    if (STAGGER_TICKS > 0) {
        const unsigned long long t0 = __builtin_amdgcn_s_memrealtime(); const unsigned long long dl = (unsigned long long)((blockIdx.x >> 3) & 15) * STAGGER_TICKS;
        while (__builtin_amdgcn_s_memrealtime() - t0 < dl) __builtin_amdgcn_s_sleep(16);
    }
    f32x4 acc[2][2][4][2];
#pragma unroll
    for (int a = 0; a < 2; ++a)
#pragma unroll
        for (int b = 0; b < 2; ++b)
#pragma unroll
            for (int m = 0; m < 4; ++m)
#pragma unroll
                for (int n = 0; n < 2; ++n) acc[a][b][m][n] = (f32x4){0.f, 0.f, 0.f, 0.f};
    bf16x8 At[4][2], B0[2][2], B1[2][2]; i32x8v At8[4], B08[2], B18[2]; int e8a_ = 0, e8b_ = 0; if constexpr (Sched::FP8) { e8a_ = S.e8a(cur); e8b_ = S.e8b(cur); } (void)e8a_; (void)e8b_;
    const char* cA = S.a_base(cur); const char* cB = S.b_base(cur);
    if constexpr (Sched::GATHER) { PG8_GMAP_ISSUE(cur); asm volatile("s_waitcnt vmcnt(0)" ::: "memory"); PG8_GMAP_READ(cao, cur); }
#define PG8_STAGE_A(bufoff, h, ptr, kb, useN) do { if constexpr (Sched::GATHER) { unsigned so_[2]; so_[0] = (useN) ? nao[h][0] : cao[h][0]; so_[1] = (useN) ? nao[h][1] : cao[h][1]; PG8_STAGE(bufoff, S.a_gather_base() + (kb), so_); } \
        else { PG8_STAGE(bufoff, ptr, voffA); } } while (0)
    PG8_STAGE(PG8_SB(0, 0), cB, voffB); PG8_STAGE(PG8_SB(0, 1), cB + hstep, voffB); PG8_STAGE_A(PG8_SA(0, 0), 0, cA, 0, false); PG8_STAGE_A(PG8_SA(0, 1), 1, cA + hstep, 0, false);
    if (wr == 1) PG8_BAR;
    PG8_WAIT_V(2); PG8_BAR;
    PG8_STAGE(PG8_SB(1, 0), cB + kstep, voffB); PG8_STAGE_A(PG8_SA(1, 0), 0, cA + kstep, kstep, false); PG8_STAGE(PG8_SB(1, 1), cB + hstep + kstep, voffB);
    PG8_WAIT_V(6); PG8_BAR;
    for (;;) {
        const bool has_next = S.next(ui + 1, nxt);
        const char* nA = has_next ? S.a_base(nxt) : cA; const char* nB = has_next ? S.b_base(nxt) : cB;
        if constexpr (Sched::GATHER) { if (has_next) PG8_GMAP_ISSUE(nxt); }
#pragma nounroll
        for (int t = 0; t < nt; t += 2) {
            const bool last = (t == nt - 2);
            const char* a1 = cA + (size_t)(t + 1) * kstep;
            const char* a2 = last ? nA : cA + (size_t)(t + 2) * kstep; const char* b2 = last ? nB : cB + (size_t)(t + 2) * kstep;
            const char* a3 = a2 + kstep; const char* b3 = b2 + kstep;
            const size_t kb2 = last ? 0 : (size_t)(t + 2) * kstep;
            if constexpr (Sched::GATHER) { if (last) { if (has_next) { PG8_GMAP_READ(nao, nxt); } else {
#pragma unroll
                for (int h_ = 0; h_ < 2; ++h_) { nao[h_][0] = cao[h_][0]; nao[h_][1] = cao[h_][1]; } } } }
            const bool rlx = RELAX_EPI && Epi::RELAX && t == 0 && ui > 0;
            PG8_LDB(B0, 0, 0); PG8_LDB(B1, 0, 1); PG8_SCHED; PG8_LDA(At, 0, 0); if (!rlx) PG8_STAGE_A(PG8_SA(1, 1), 1, a1 + hstep, (size_t)(t + 1) * kstep, false);
            if (rlx) PG8_WAIT_VN(8 + NE); else PG8_WAIT_V(8);
            PG8_WAIT_L(0); PG8_BAR; PG8_MMA(0, 0, At, B0); PG8_MMA(0, 1, At, B1); PG8_BAR; PG8_SCHED;
            PG8_LDA(At, 0, 1); PG8_STAGE(PG8_SB(0, 0), b2, voffB); PG8_STAGE(PG8_SB(0, 1), b2 + hstep, voffB); PG8_STAGE_A(PG8_SA(0, 0), 0, a2, kb2, last);
            if (rlx) PG8_WAIT_VN(14 + NE); else PG8_WAIT_V(8);
            PG8_WAIT_L(0); PG8_BAR; PG8_MMA(1, 0, At, B0); PG8_MMA(1, 1, At, B1); PG8_BAR; PG8_SCHED;
            PG8_LDB(B0, 1, 0); PG8_LDB(B1, 1, 1); PG8_SCHED; PG8_LDA(At, 1, 0); PG8_STAGE_A(PG8_SA(0, 1), 1, a2 + hstep, kb2, last);
            if (rlx) PG8_WAIT_VN(8 + NE); else PG8_WAIT_V(8);
            PG8_WAIT_L(0); PG8_BAR; PG8_MMA(0, 0, At, B0); PG8_MMA(0, 1, At, B1); PG8_BAR; PG8_SCHED;
            PG8_LDA(At, 1, 1); PG8_STAGE(PG8_SB(1, 0), b3, voffB); PG8_STAGE(PG8_SB(1, 1), b3 + hstep, voffB); PG8_STAGE_A(PG8_SA(1, 0), 0, a3, kb2 + kstep, last);
            if (rlx) PG8_WAIT_VN(14 + NE); else PG8_WAIT_V(8);
            PG8_WAIT_L(0); PG8_BAR; PG8_MMA(1, 0, At, B0); PG8_MMA(1, 1, At, B1); PG8_BAR; PG8_SCHED;
        }
        if (RELAX_EPI && Epi::RELAX) { PG8_STAGE(PG8_SA(1, 1), nA + kstep + hstep, voffA); asm volatile("" ::: "memory"); }
        if constexpr (Sched::FP8) { asm volatile("s_nop 15\n\ts_nop 7" ::: "memory"); }
        if constexpr (ALIGN_EPI) { if (wr == 0) PG8_BAR; }
        E(acc, cur, wr, wc, fr, fq);
        if (!has_next) break;
        if constexpr (!Epi::KEEP_ACC)
#pragma unroll
        for (int a = 0; a < 2; ++a)
#pragma unroll
            for (int b = 0; b < 2; ++b)
#pragma unroll
                for (int m = 0; m < 4; ++m)
#pragma unroll
                    for (int n = 0; n < 2; ++n) acc[a][b][m][n] = (f32x4){0.f, 0.f, 0.f, 0.f};
        cur = nxt; cA = nA; cB = nB; ++ui;
        if constexpr (Sched::FP8) { e8a_ = S.e8a(cur); e8b_ = S.e8b(cur); }
        if constexpr (Sched::GATHER) {
#pragma unroll
            for (int h_ = 0; h_ < 2; ++h_) { cao[h_][0] = nao[h_][0]; cao[h_][1] = nao[h_][1]; } }
        if constexpr (ALIGN_EPI) { if (wr == 1) PG8_BAR; }
    }
    PG8_WAIT_V(0);
    if constexpr (!ALIGN_EPI) { if (wr == 0) PG8_BAR; }
    PG8_BAR;
#undef PG8_SA
#undef PG8_STAGE_A
#undef PG8_GMAP_ISSUE
#undef PG8_GMAP_READ
#undef PG8_SB
#undef PG8_STAGE
#undef PG8_LDA
#undef PG8_LDB
#undef PG8_MMA
#undef PG8_WAIT_V
#undef PG8_WAIT_VN
#undef PG8_WAIT_L
#undef PG8_BAR
#undef PG8_SCHED
}
}

struct SchedDense {
    static constexpr bool GATHER = false; static constexpr bool FP8 = false; static constexpr int E8_A = 0, E8_B = 0;
    pg8::StaticOrder so; const char* A; const char* B; int K; bool lat; bool skipv;
    __device__ __forceinline__ void init(const void* A_, const void* B_, int K_, int nN, bool lat_, int G, int c, bool skipv_ = false) { A = (const char*)A_; B = (const char*)B_; K = K_; lat = lat_; skipv = skipv_; so.init(lat_ ? 128 : 144, nN, G, c); }
    __device__ __forceinline__ bool next(int i, pg8::Unit& u) const { int pm, pn; if (!so.next(i, pm, pn)) return false; if (lat) pm = (pm >> 3) * 9 + 1 + (pm & 7); if (skipv) pn = pn < 8 ? pn : (pn < 20 ? pn + 4 : pn + 12); u.pm = pm; u.pn = pn; u.aux = 0; return true; }
    __device__ __forceinline__ const char* a_base(const pg8::Unit& u) const { return A + (size_t)u.pm * 256 * K * 2; }
    __device__ __forceinline__ const char* b_base(const pg8::Unit& u) const { return B + (size_t)u.pn * 256 * K * 2; }
};
struct SchedV8 {
    static constexpr bool GATHER = false; static constexpr bool FP8 = true;
    pg8::StaticOrder so; const char* H8; const char* W;
    __device__ __forceinline__ void init(const void* H8_, const void* Wl_, int G, int c) { H8 = (const char*)H8_; W = (const char*)Wl_; so.init(144, 12, G, G - 1 - c); }
    __device__ __forceinline__ bool next(int i, pg8::Unit& u) const { int pm, pn; if (!so.next(i, pm, pn)) return false; u.pm = pm; u.pn = pn < 4 ? 8 + pn : 20 + pn; u.aux = 0; return true; }
    __device__ __forceinline__ bool swapped(const pg8::Unit& u) const { return (u.pn >> 2) != 7; }
    __device__ __forceinline__ const char* wt(const pg8::Unit& u) const { return W + (size_t)(u.pn >> 2) * 1024 * 2048 + (size_t)(u.pn & 3) * 256 * 1024; }
    __device__ __forceinline__ const char* a_base(const pg8::Unit& u) const { return swapped(u) ? wt(u) : H8 + (size_t)u.pm * 256 * 1024; }
    __device__ __forceinline__ const char* b_base(const pg8::Unit& u) const { return swapped(u) ? H8 + (size_t)u.pm * 256 * 1024 : wt(u); }
    __device__ __forceinline__ int e8a(const pg8::Unit& u) const { return swapped(u) ? E8_W : E8_ONE; }
    __device__ __forceinline__ int e8b(const pg8::Unit& u) const { return swapped(u) ? E8_ONE : E8_W; }
};
struct SchedBranch {
    static constexpr bool GATHER = false; static constexpr bool FP8 = false; static constexpr int E8_A = 0, E8_B = 0;
    pg8::StaticOrder so; const char* A; const char* B; bool lat;
    __device__ __forceinline__ void init(const void* A_, const void* B_, bool lat_, int G, int c) { A = (const char*)A_; B = (const char*)B_; lat = lat_; so.init(lat_ ? 128 : 144, 4, G, c); }
    __device__ __forceinline__ bool next(int i, pg8::Unit& u) const { int pm, pn; const int it = i / 3; if (!so.next(it, pm, pn)) return false; if (lat) pm = (pm >> 3) * 9 + 1 + (pm & 7); u.pm = pm; u.pn = pn; u.aux = i - 3 * it; return true; }
    __device__ __forceinline__ const char* a_base(const pg8::Unit& u) const { return A + (size_t)u.aux * PSTR * 2 + (size_t)u.pm * 256 * 1024 * 2; }
    __device__ __forceinline__ const char* b_base(const pg8::Unit& u) const { return B + (size_t)u.aux * 1024 * 1024 * 2 + (size_t)u.pn * 256 * 1024 * 2; }
};
constexpr int MOE_CAP = NROWS;
template <bool G_> struct SchedMoE {
    static constexpr bool GATHER = G_; static constexpr int GMAP_OFF = 131072;
    static constexpr bool FP8 = true; static constexpr int E8_B = E8_W, E8_A = G_ ? E8_ONE : E8_ACT;
    const volatile LAS int* toff; int TT, npn, xcd, j, nwx, G, c; const char* A; const char* B; size_t bexp; const int* rowmap;
    __device__ __forceinline__ void init(const void* A_, const void* B_, size_t bexp_, const volatile LAS int* toff_, int npn_, int G_g, int c_, const int* rowmap_) {
        A = (const char*)A_; B = (const char*)B_; bexp = bexp_; toff = toff_; TT = toff_[NEXP]; npn = npn_; G = G_g; c = c_; xcd = c_ & 7; j = c_ >> 3; nwx = G_g >> 3; rowmap = rowmap_; }
    __device__ __forceinline__ bool next(int i, pg8::Unit& u) const {
        int tm, pn;
        if ((G & 7) == 0) { const int q = i * nwx + j; const int t = q / npn; tm = xcd + 8 * t; pn = q - t * npn; }
        else { const int L = i * G + c; tm = L / npn; pn = L - tm * npn; }
        if (tm >= TT) return false;
        const int ln = (int)__builtin_amdgcn_mbcnt_hi(~0u, __builtin_amdgcn_mbcnt_lo(~0u, 0u));
        const int tv = toff[ln < NEXP - 1 ? ln + 1 : NEXP];
        const int e = (int)__builtin_popcountll(__ballot(ln < NEXP - 1 && tv <= tm));
        const int tb = __builtin_amdgcn_readlane(tv, e > 0 ? e - 1 : 0);
        u.pm = tm; u.pn = pn; u.aux = e; u.lt = tm - (e > 0 ? tb : 0); return true;
    }
    __device__ __forceinline__ const char* a_base(const pg8::Unit& u) const { return A + (size_t)u.pm * 256 * 1024; }
    __device__ __forceinline__ const char* b_base(const pg8::Unit& u) const { return B + (size_t)u.aux * bexp + (size_t)u.pn * 256 * 1024; }
    __device__ __forceinline__ int e8a(const pg8::Unit&) const { return E8_A; }
    __device__ __forceinline__ int e8b(const pg8::Unit&) const { return E8_B; }
    __device__ __forceinline__ const char* a_gather_base() const { return A; }
    __device__ __forceinline__ const int* row_ptr(const pg8::Unit& u, int lr) const { return rowmap + (size_t)u.aux * MOE_CAP + u.lt * 256 + lr; }
    __device__ __forceinline__ bool row_valid(const pg8::Unit& u, int lr) const { return u.lt * 256 + lr < toff[33 + u.aux]; }
};

typedef f32x4 AccT[2][2][4][2];
struct EpiProj {
    static constexpr bool KEEP_ACC = false; static constexpr bool RELAX = true; static constexpr bool PERM = true; static constexpr int NST = 16; bf16* P;
    __device__ __forceinline__ void operator()(AccT& acc, const pg8::Unit& u, int wr, int wc, int fr, int fq) const {
        const int grp = u.pn >> 2; const bool tr = (grp == 2 || grp == 6);
        const int b = u.pm / 9; const int ld = tr ? SROW : 1024;
        bf16* base = P + (size_t)grp * PSTR + (tr ? (size_t)b * 1024 * SROW + (size_t)(u.pn & 3) * 256 * SROW + (size_t)(u.pm - 9 * b) * 256 : (size_t)u.pm * 256 * 1024 + (size_t)(u.pn & 3) * 256);
        const int row0 = wr * 64 + fr, col0 = wc * 32 + 8 * fq;
#pragma unroll
        for (int ai = 0; ai < 2; ++ai)
#pragma unroll
            for (int m = 0; m < 4; ++m) { bf16* rowp = base + (size_t)(row0 + ai * 128 + m * 16) * ld + col0;
#pragma unroll
                for (int bj = 0; bj < 2; ++bj) { const f32x4 v0 = acc[ai][bj][m][0], v1 = acc[ai][bj][m][1];
                    u32x4 w; w.x = pk2(v0[0], v0[1]); w.y = pk2(v0[2], v0[3]); w.z = pk2(v1[0], v1[1]); w.w = pk2(v1[2], v1[3]);
                    *(u32x4*)(rowp + bj * 128) = w; } }
    }
};
struct EpiBranch {
    static constexpr bool KEEP_ACC = true; static constexpr bool RELAX = false; static constexpr bool PERM = true; static constexpr int NST = 0; const bf16* G; bf16* MB;
    static __device__ __forceinline__ void ratio4(f32x4& v, unsigned g01, unsigned g23, unsigned n01, unsigned n23) {
        const float n0 = 1.0f + fminf(__builtin_amdgcn_exp2f(-bflo(n01) * LOG2E), 1e30f), n1 = 1.0f + fminf(__builtin_amdgcn_exp2f(-bfhi(n01) * LOG2E), 1e30f);
        const float n2 = 1.0f + fminf(__builtin_amdgcn_exp2f(-bflo(n23) * LOG2E), 1e30f), n3 = 1.0f + fminf(__builtin_amdgcn_exp2f(-bfhi(n23) * LOG2E), 1e30f);
        v[0] *= sigmoidf_(bflo(g01)) * n0; v[1] *= sigmoidf_(bfhi(g01)) * n1; v[2] *= sigmoidf_(bflo(g23)) * n2; v[3] *= sigmoidf_(bfhi(g23)) * n3;
    }
    static __device__ __forceinline__ void gate4(f32x4& v, unsigned g01, unsigned g23) { v[0] *= sigmoidf_(bflo(g01)); v[1] *= sigmoidf_(bfhi(g01)); v[2] *= sigmoidf_(bflo(g23)); v[3] *= sigmoidf_(bfhi(g23)); }
    __device__ __forceinline__ void operator()(AccT& acc, const pg8::Unit& u, int wr, int wc, int fr, int fq) const {
        const int j = u.aux; const bf16* gate = G + (size_t)j * PSTR; const bf16* gnext = G + (size_t)(j < 2 ? j + 1 : j) * PSTR;
        int fr_ = fr; asm volatile("" : "+v"(fr_));
        const int row0 = u.pm * 256 + wr * 64 + fr_, col0 = u.pn * 256 + wc * 32 + 8 * fq;
#pragma unroll
        for (int ai = 0; ai < 2; ++ai)
#pragma unroll
        for (int mh = 0; mh < 2; ++mh) { u32x4 gw[2][2], gn[2][2];
#pragma unroll
            for (int mm = 0; mm < 2; ++mm)
#pragma unroll
                for (int bj = 0; bj < 2; ++bj) { const size_t off = (size_t)(row0 + ai * 128 + (2 * mh + mm) * 16) * 1024 + col0 + bj * 128; gw[mm][bj] = *(const u32x4*)(gate + off); gn[mm][bj] = *(const u32x4*)(gnext + off); }
            PIN8(gw[0][0], gw[0][1], gw[1][0], gw[1][1], gn[0][0], gn[0][1], gn[1][0], gn[1][1]);
#pragma unroll
            for (int mm = 0; mm < 2; ++mm) { const int m = 2 * mh + mm;
                if (j < 2) {
#pragma unroll
                    for (int bj = 0; bj < 2; ++bj) { ratio4(acc[ai][bj][m][0], gw[mm][bj].x, gw[mm][bj].y, gn[mm][bj].x, gn[mm][bj].y); ratio4(acc[ai][bj][m][1], gw[mm][bj].z, gw[mm][bj].w, gn[mm][bj].z, gn[mm][bj].w); }
                } else {
#pragma unroll
                    for (int bj = 0; bj < 2; ++bj) { f32x4 v0 = acc[ai][bj][m][0], v1 = acc[ai][bj][m][1];
                        gate4(v0, gw[mm][bj].x, gw[mm][bj].y); gate4(v1, gw[mm][bj].z, gw[mm][bj].w);
                        u32x4 w; w.x = pk2(v0[0], v0[1]); w.y = pk2(v0[2], v0[3]); w.z = pk2(v1[0], v1[1]); w.w = pk2(v1[2], v1[3]);
                        *(u32x4*)(MB + (size_t)(row0 + ai * 128 + m * 16) * 1024 + col0 + bj * 128) = w;
                        acc[ai][bj][m][0] = (f32x4){0.f, 0.f, 0.f, 0.f}; acc[ai][bj][m][1] = (f32x4){0.f, 0.f, 0.f, 0.f}; }
                } } }
    }
};
template <bool FIRST> struct EpiOut {
    static constexpr bool KEEP_ACC = false; static constexpr bool RELAX = false; static constexpr bool PERM = true; static constexpr int NST = 16; const float* xin_x; const float* xin_ctx; bf16* X; const float* modv_l;
    __device__ __forceinline__ void operator()(AccT& acc, const pg8::Unit& u, int wr, int wc, int fr, int fq) const {
        const int b = u.pm / 9, jt = u.pm - 9 * b; const float* g1 = modv_l + (size_t)(jt == 0 ? 16 : b) * 6144 + 2 * 1024;
        const float* src = jt == 0 ? xin_ctx + (size_t)b * CTXL * 1024 : xin_x + ((size_t)b * SEQ + (size_t)(jt - 1) * 256) * 1024;
        bf16* dst = X + (size_t)u.pm * 256 * 1024;
        int fr_ = fr; asm volatile("" : "+v"(fr_));
        const int lr0 = wr * 64 + fr_, col0 = u.pn * 256 + wc * 32 + 8 * fq;
        f32x4 gv[2][2];
#pragma unroll
        for (int bj = 0; bj < 2; ++bj)
#pragma unroll
            for (int n = 0; n < 2; ++n) gv[bj][n] = *(const f32x4*)(g1 + col0 + bj * 128 + n * 4);
        if constexpr (FIRST) {
#pragma unroll
            for (int ai = 0; ai < 2; ++ai)
#pragma unroll
                for (int mh = 0; mh < 2; ++mh) { f32x4 xo[2][2][2];
#pragma unroll
                    for (int mm = 0; mm < 2; ++mm)
#pragma unroll
                        for (int bj = 0; bj < 2; ++bj)
#pragma unroll
                            for (int n = 0; n < 2; ++n) xo[mm][bj][n] = *(const f32x4*)(src + (size_t)(lr0 + ai * 128 + (2 * mh + mm) * 16) * 1024 + col0 + bj * 128 + n * 4);
                    PIN8(xo[0][0][0], xo[0][0][1], xo[0][1][0], xo[0][1][1], xo[1][0][0], xo[1][0][1], xo[1][1][0], xo[1][1][1]);
#pragma unroll
                    for (int mm = 0; mm < 2; ++mm)
#pragma unroll
                        for (int bj = 0; bj < 2; ++bj) { const f32x4 x0 = xo[mm][bj][0] + gv[bj][0] * acc[ai][bj][2 * mh + mm][0], x1 = xo[mm][bj][1] + gv[bj][1] * acc[ai][bj][2 * mh + mm][1];
                            u32x4 w; w.x = pk2(x0[0], x0[1]); w.y = pk2(x0[2], x0[3]); w.z = pk2(x1[0], x1[1]); w.w = pk2(x1[2], x1[3]);
                            *(u32x4*)(dst + (size_t)(lr0 + ai * 128 + (2 * mh + mm) * 16) * 1024 + col0 + bj * 128) = w; } }
        } else {
#pragma unroll
            for (int ai = 0; ai < 2; ++ai) { u32x4 xb[4][2];
#pragma unroll
                for (int m = 0; m < 4; ++m)
#pragma unroll
                    for (int bj = 0; bj < 2; ++bj) xb[m][bj] = *(const u32x4*)(dst + (size_t)(lr0 + ai * 128 + m * 16) * 1024 + col0 + bj * 128);
                PIN8(xb[0][0], xb[0][1], xb[1][0], xb[1][1], xb[2][0], xb[2][1], xb[3][0], xb[3][1]);
#pragma unroll
                for (int m = 0; m < 4; ++m)
#pragma unroll
                    for (int bj = 0; bj < 2; ++bj) { const u32x4 t = xb[m][bj];
                        const f32x4 x0 = (f32x4){bflo(t.x), bfhi(t.x), bflo(t.y), bfhi(t.y)} + gv[bj][0] * acc[ai][bj][m][0], x1 = (f32x4){bflo(t.z), bfhi(t.z), bflo(t.w), bfhi(t.w)} + gv[bj][1] * acc[ai][bj][m][1];
                        u32x4 w; w.x = pk2(x0[0], x0[1]); w.y = pk2(x0[2], x0[3]); w.z = pk2(x1[0], x1[1]); w.w = pk2(x1[2], x1[3]);
                        *(u32x4*)(dst + (size_t)(lr0 + ai * 128 + m * 16) * 1024 + col0 + bj * 128) = w; } }
        }
    }
};
__device__ __forceinline__ float swiglu_(float gl, float li) { gl = fminf(gl, 7.0f); li = fminf(fmaxf(li, -7.0f), 7.0f);
    const float r = __builtin_amdgcn_rcpf(1.0f + __builtin_amdgcn_exp2f(gl * (-1.702f * LOG2E))); return (gl * r) * fmaf(li, ACT8_SCALE, ACT8_SCALE); }
struct EpiUp {
    static constexpr bool KEEP_ACC = false; static constexpr bool RELAX = true; static constexpr bool PERM = true; static constexpr int NST = 16; unsigned char* ACT; const float* bup;
    __device__ __forceinline__ void operator()(AccT& acc, const pg8::Unit& u, int wr, int wc, int fr, int fq) const {
        const float* bias = bup + (size_t)u.aux * 2048; const int row0 = u.pm * 256 + wr * 64 + fr, colb = u.pn * 256 + wc * 32 + 8 * fq;
        f32x4 bv[2][2];
#pragma unroll
        for (int bj = 0; bj < 2; ++bj)
#pragma unroll
            for (int n = 0; n < 2; ++n) bv[bj][n] = *(const f32x4*)(bias + colb + bj * 128 + 4 * n);
#pragma unroll
        for (int ai = 0; ai < 2; ++ai)
#pragma unroll
            for (int m = 0; m < 4; ++m) { unsigned char* rowp = ACT + (size_t)(row0 + ai * 128 + m * 16) * 1024 + (colb >> 1);
#pragma unroll
                for (int bj = 0; bj < 2; ++bj) { const f32x4 v0 = acc[ai][bj][m][0] + bv[bj][0], v1 = acc[ai][bj][m][1] + bv[bj][1];
                    *(unsigned*)(rowp + bj * 64) = pk4_fp8(swiglu_(v0[0], v0[1]), swiglu_(v0[2], v0[3]), swiglu_(v1[0], v1[1]), swiglu_(v1[2], v1[3])); } }
    }
};
struct EpiDown {
    static constexpr bool KEEP_ACC = false; static constexpr bool RELAX = true; static constexpr bool PERM = true; static constexpr int NST = 16; unsigned char* Y; const float* bdn; const float* roww;
    __device__ __forceinline__ void operator()(AccT& acc, const pg8::Unit& u, int wr, int wc, int fr, int fq) const {
        const float* bias = bdn + (size_t)u.aux * 1024; const int row0 = u.pm * 256 + wr * 64 + fr, col0 = u.pn * 256 + wc * 32 + 8 * fq;
        f32x4 bv[2][2];
#pragma unroll
        for (int bj = 0; bj < 2; ++bj)
#pragma unroll
            for (int n = 0; n < 2; ++n) bv[bj][n] = *(const f32x4*)(bias + col0 + bj * 128 + 4 * n);
        float rw[2][4];
#pragma unroll
        for (int ai = 0; ai < 2; ++ai)
#pragma unroll
            for (int m = 0; m < 4; ++m) rw[ai][m] = roww[(size_t)u.aux * MOE_CAP + u.lt * 256 + (wr * 64 + fr + ai * 128 + m * 16)];
        PIN8(rw[0][0], rw[0][1], rw[0][2], rw[0][3], rw[1][0], rw[1][1], rw[1][2], rw[1][3]);
#pragma unroll
        for (int ai = 0; ai < 2; ++ai)
#pragma unroll
            for (int m = 0; m < 4; ++m) { const int row = row0 + ai * 128 + m * 16; const float w8 = rw[ai][m] * Y8_SCALE; unsigned char* rowp = Y + (size_t)row * 1024 + col0;
#pragma unroll
                for (int bj = 0; bj < 2; ++bj) { const f32x4 v0 = (acc[ai][bj][m][0] + bv[bj][0]) * w8, v1 = (acc[ai][bj][m][1] + bv[bj][1]) * w8;
                    u32x2 w; w.x = pk4_fp8(v0[0], v0[1], v0[2], v0[3]); w.y = pk4_fp8(v1[0], v1[1], v1[2], v1[3]);
                    *(u32x2*)(rowp + bj * 128) = w; } }
    }
};
#define XB_TMO      128
#define XB_XCNT(j)  (256  + 64 * (j))
#define XB_XSUB(j)  (1280 + 64 * (j))
#define XB_XGEN(j)  (2304 + 64 * (j))
#define XB_TOP      3328
#define XB_TOPGEN   3392
#define XCD_BAR_WORDS 3456
#define XB_SPIN_CAP (1u << 18)
__device__ __forceinline__ unsigned xb_ld(unsigned* p)              { return __hip_atomic_load(p, __ATOMIC_RELAXED, __HIP_MEMORY_SCOPE_AGENT); }
__device__ __forceinline__ unsigned xb_add(unsigned* p, unsigned v) { return __hip_atomic_fetch_add(p, v, __ATOMIC_RELAXED, __HIP_MEMORY_SCOPE_AGENT); }
__device__ __forceinline__ unsigned xb_xcc_id() { return (unsigned)__builtin_amdgcn_s_getreg((3 << 11) | 20) & 0xFu; }
#define XB_SPIN(cond, bar) do { unsigned _sp = 0; while (cond) { __builtin_amdgcn_s_sleep(1); \
    if ((++_sp & 255u) == 0u) { if (xb_ld(&(bar)[XB_TMO])) break; if (_sp > XB_SPIN_CAP) { atomicAdd(&(bar)[XB_TMO], 1u); break; } } } } while (0)
struct XcdBarrier { unsigned* bar; unsigned x; volatile LAS unsigned* st; };
__device__ __forceinline__ XcdBarrier xcd_barrier_post(unsigned* bar, volatile LAS unsigned* st) {
    XcdBarrier b; b.bar = bar; b.x = xb_xcc_id(); b.st = st;
    if (threadIdx.x == 0) (void)xb_add(&bar[XB_XCNT(b.x)], 1u);
    return b;
}
__device__ __forceinline__ void xcd_barrier_complete(unsigned* bar, unsigned x, unsigned& nloc, unsigned& nx) {
    const unsigned G = gridDim.x * gridDim.y * gridDim.z;
    unsigned sum, cnt, mine, sp = 0u;
    for (;;) {
        sum = 0u; cnt = 0u; mine = 0u;
#pragma unroll
        for (unsigned j = 0; j < 16; ++j) { const unsigned c = xb_ld(&bar[XB_XCNT(j)]); sum += c; cnt += (c > 0u) ? 1u : 0u; mine = (j == x) ? c : mine; }
        if (sum == G) break;
        __builtin_amdgcn_s_sleep(1);
        if ((++sp & 255u) == 0u) { if (xb_ld(&bar[XB_TMO])) break; if (sp > XB_SPIN_CAP) { atomicAdd(&bar[XB_TMO], 1u); break; } }
    }
    nloc = mine > 0u ? mine : 1u; nx = cnt > 0u ? cnt : 1u;
}
__device__ __forceinline__ void xcd_barrier(const XcdBarrier& b) {
    asm volatile("s_waitcnt vmcnt(0)" ::: "memory");
    __syncthreads();
    if (threadIdx.x == 0) {
        unsigned* bar = b.bar;
        __builtin_amdgcn_s_waitcnt(0);
        unsigned nloc = b.st[0], nx = b.st[1];
        if (nloc == 0u) { xcd_barrier_complete(bar, b.x, nloc, nx); b.st[0] = nloc; b.st[1] = nx; }
        const unsigned old = xb_add(&bar[XB_XSUB(b.x)], 1u);
        const unsigned gen = old / nloc;
        if (old + 1u == (gen + 1u) * nloc) {
            __builtin_amdgcn_fence(__ATOMIC_RELEASE, "agent");
            asm volatile("s_waitcnt vmcnt(0)" ::: "memory");
            const unsigned og = xb_add(&bar[XB_TOP], 1u);
            const unsigned tg = og / nx;
            if (og + 1u == (tg + 1u) * nx) xb_add(&bar[XB_TOPGEN], 1u);
            else XB_SPIN(xb_ld(&bar[XB_TOPGEN]) == tg, bar);
            __builtin_amdgcn_fence(__ATOMIC_ACQUIRE, "agent");
            xb_add(&bar[XB_XGEN(b.x)], 1u);
            asm volatile("s_waitcnt vmcnt(0)" ::: "memory");
        } else {
            XB_SPIN(xb_ld(&bar[XB_XGEN(b.x)]) == gen, bar);
            __builtin_amdgcn_fence(__ATOMIC_ACQUIRE, "agent");
            asm volatile("s_waitcnt vmcnt(0)" ::: "memory");
        }
    }
    __syncthreads();
}

struct Args {
    const float* in[28]; float* out; unsigned char* ws; int ph_lo, ph_hi;
};
struct Frame {
    LAS unsigned char* lds; volatile LAS unsigned* MISC; unsigned* ctl; unsigned char* ws;
    int vcu, G, c;
    const float* const* in;
};
#define PHASE_IDS() const int tid = opaque_tid(); const int lane = tid & 63; const int wave = __builtin_amdgcn_readfirstlane(tid >> 6); (void)lane; (void)wave
enum { I_X = 0, I_C, I_CTX, I_CCTX, I_WMOD, I_BMOD, I_N1G, I_N2G, I_WMIX, I_RDF, I_RDB, I_RPB, I_CONVW, I_CONVB, I_GAW, I_GAB, I_GXW, I_GXB, I_LAM, I_WBR, I_WOUT, I_WR, I_BR, I_WUP, I_BUP, I_WDN, I_BDN, I_FNG };

constexpr int P0_I0 = 2 * 3072, P0_I1 = P0_I0 + 6 * 256, P0_I2 = P0_I1 + 2 * 256, P0_I3 = P0_I2 + 64 * 512, P0_I4 = P0_I3 + 64 * 256;
constexpr int P0_CHUNK = 128, P0_NCHUNK = (P0_I4 - P0_I2) / P0_CHUNK;
static_assert((P0_I4 - P0_I2) % P0_CHUNK == 0, "conversion chunks");
__device__ __forceinline__ void p0_decode(Frame& F, int it, const float*& src, unsigned char*& dst, int& N, bool& f8) {
    int kb, nb; const float* W; unsigned char* WT;
    if (it < P0_I0) { const int mi = it / 3072, r = it - mi * 3072; kb = r / 192; nb = r - kb * 192; N = 12288; W = F.in[I_WMIX] + (size_t)mi * 1024 * 12288; WT = F.ws + WS_WMIX + (size_t)mi * 12288 * 2048;
        const int grp = nb >> 4; f8 = (grp == 2 || grp == 6 || grp == 7);
        if (f8) { src = W + (size_t)(64 * kb) * N + 64 * nb; dst = WT + (size_t)grp * 1024 * 2048 + (size_t)(64 * (nb & 15)) * 1024 + 64 * kb; return; } }
    else if (it < P0_I1) { const int q = it - P0_I0, mi = q >> 8, r = q & 255; kb = r >> 4; nb = r & 15; N = 1024; f8 = false; W = F.in[I_WBR] + (size_t)mi * 1024 * 1024; WT = F.ws + WS_WBR + (size_t)mi * 1024 * 2048; }
    else if (it < P0_I2) { const int q = it - P0_I1, mi = q >> 8, r = q & 255; kb = r >> 4; nb = r & 15; N = 1024; f8 = false; W = F.in[I_WOUT] + (size_t)mi * 1024 * 1024; WT = F.ws + WS_WOUT + (size_t)mi * 1024 * 2048; }
    else if (it < P0_I3) { const int q = it - P0_I2, mi = q >> 9, r = q & 511; kb = r >> 5; nb = r & 31; N = 2048; f8 = true; W = F.in[I_WUP] + (size_t)mi * 1024 * 2048; WT = F.ws + WS_WUP + (size_t)mi * 2048 * 1024; }
    else { const int q = it - P0_I3, mi = q >> 8, r = q & 255; kb = r >> 4; nb = r & 15; N = 1024; f8 = true; W = F.in[I_WDN] + (size_t)mi * 1024 * 1024; WT = F.ws + WS_WDN + (size_t)mi * 1024 * 1024; }
    src = W + (size_t)(64 * kb) * N + 64 * nb; dst = WT + ((size_t)(64 * nb) * 1024 + 64 * kb) * (f8 ? 1 : 2);
}
__device__ __forceinline__ void p0_convert(Frame& F, int it0, int stride, int it_end, int wave, int lane) {
    LAS float* scr = (LAS float*)(F.lds + wave * 16640);
    const int lr = lane >> 4, lc = 4 * (lane & 15);
    f32x4 cur[16], nxt[16];
    const float* src; unsigned char* dst; int N; bool f8;
    int it = it0;
    if (it < it_end) { p0_decode(F, it, src, dst, N, f8);
#pragma unroll
        for (int i = 0; i < 16; ++i) cur[i] = *(const f32x4*)(src + (size_t)(4 * i + lr) * N + lc); }
    for (; it < it_end; it += stride) {
        unsigned char* dcur = dst; const bool f8c = f8;
        if (it + stride < it_end) { p0_decode(F, it + stride, src, dst, N, f8);
#pragma unroll
            for (int i = 0; i < 16; ++i) nxt[i] = *(const f32x4*)(src + (size_t)(4 * i + lr) * N + lc); }
#pragma unroll
        for (int i = 0; i < 16; ++i) { LAS float* s = scr + (4 * i + lr) * 65 + lc; s[0] = cur[i].x; s[1] = cur[i].y; s[2] = cur[i].z; s[3] = cur[i].w; }
        LDS_WAIT(); asm volatile("" ::: "memory");
        const int c = lane & 7;
        if (!f8c) {
#pragma unroll
            for (int j = 0; j < 8; ++j) { const int n = (lane >> 3) + 8 * j; const LAS float* s = scr + (8 * c) * 65 + n;
                u32x4 o; o.x = pk2(s[0 * 65], s[1 * 65]); o.y = pk2(s[2 * 65], s[3 * 65]); o.z = pk2(s[4 * 65], s[5 * 65]); o.w = pk2(s[6 * 65], s[7 * 65]);
                *(u32x4*)(dcur + (size_t)n * 2048 + 16 * c) = o; }
        } else {
#pragma unroll
            for (int j = 0; j < 8; ++j) { const int n = (lane >> 3) + 8 * j; const LAS float* s = scr + (8 * c) * 65 + n;
                u32x2 o; o.x = pk4_fp8(s[0 * 65] * W8_SCALE, s[1 * 65] * W8_SCALE, s[2 * 65] * W8_SCALE, s[3 * 65] * W8_SCALE); o.y = pk4_fp8(s[4 * 65] * W8_SCALE, s[5 * 65] * W8_SCALE, s[6 * 65] * W8_SCALE, s[7 * 65] * W8_SCALE);
                *(u32x2*)(dcur + (size_t)n * 1024 + 8 * c) = o; }
        }
        LDS_WAIT(); asm volatile("" ::: "memory");
#pragma unroll
        for (int i = 0; i < 16; ++i) cur[i] = nxt[i];
    }
}
__device__ __forceinline__ void p0_prologue(Frame& F, int nrep) {
    PHASE_IDS();
    {
        float2* rope = (float2*)(F.ws + WS_ROPE);
        const int gt = F.c * 512 + tid;
        if (gt < 96 * 32) { const int pos = gt >> 5, i = gt & 31; const float p = (float)(pos < 32 ? pos : pos - 32); const float inv = powf(10000.0f, -(float)i / 32.0f); const float a = p * inv; rope[gt] = make_float2(cosf(a), sinf(a)); }
    }
    if (F.c < 192) {
        LAS float* sil = (LAS float*)F.lds;
        LAS float* red = (LAS float*)(F.lds + 17 * 1024 * 4);
        { float cv[34];
#pragma unroll
          for (int q = 0; q < 34; ++q) { const int i = tid + 512 * q, b = i >> 10, k = i & 1023; cv[q] = b < 16 ? F.in[I_C][b * 1024 + k] : F.in[I_CCTX][k]; }
          PIN8(cv[0], cv[1], cv[2], cv[3], cv[4], cv[5], cv[6], cv[7]); PIN8(cv[8], cv[9], cv[10], cv[11], cv[12], cv[13], cv[14], cv[15]); PIN8(cv[16], cv[17], cv[18], cv[19], cv[20], cv[21], cv[22], cv[23]);
          PIN8(cv[24], cv[25], cv[26], cv[27], cv[28], cv[29], cv[30], cv[31]); PIN4(cv[32], cv[33], cv[0], cv[1]);
#pragma unroll
          for (int q = 0; q < 34; ++q) sil[tid + 512 * q] = cv[q] * sigmoidf_(cv[q]); }
        __syncthreads();
        const int l = F.c / 96, cg = F.c - 96 * l; const float* wm = F.in[I_WMOD] + (size_t)l * 1024 * 6144 + 64 * cg + lane;
        float acc[17];
#pragma unroll
        for (int b = 0; b < 17; ++b) acc[b] = 0.f;
        const int kb = wave * 128;
#pragma unroll 16
        for (int kk = 0; kk < 128; ++kk) { const float wv = wm[(size_t)(kb + kk) * 6144];
#pragma unroll
            for (int b = 0; b < 17; ++b) acc[b] += sil[b * 1024 + kb + kk] * wv; }
#pragma unroll
        for (int b = 0; b < 17; ++b) red[(wave * 17 + b) * 64 + lane] = acc[b];
        __syncthreads();
        float* modv = (float*)(F.ws + WS_MODV);
        for (int i = tid; i < 17 * 64; i += 512) { const int b = i >> 6, n = i & 63; float s = 0.f;
#pragma unroll
            for (int w = 0; w < 8; ++w) s += red[(w * 17 + b) * 64 + n];
            const int col = 64 * cg + n; modv[((size_t)l * 17 + b) * 6144 + col] = s + F.in[I_BMOD][l * 6144 + col]; }
        __syncthreads();
    }
    for (int rep = 0; rep < nrep; ++rep) p0_convert(F, F.vcu * 8 + wave, F.G * 8, P0_I2, wave, lane);
}

__device__ __forceinline__ float row_rstd(const f32x4 (&v)[4]) {
    float s = 0.f;
#pragma unroll
    for (int j = 0; j < 4; ++j) s += (v[j].x * v[j].x + v[j].y * v[j].y) + (v[j].z * v[j].z + v[j].w * v[j].w);
    return rsqrtf(wave_sum(s) * (1.0f / 1024.0f) + NORM_EPS);
}
template <bool F8 = false, bool BOTH = false> __device__ __forceinline__ void modulate_row_pre(f32x4 (&v)[4], const f32x4 (&g4)[4], const f32x4 (&s4)[4], const f32x4 (&h4)[4], bf16* orow, int lane, unsigned char* orow8 = nullptr) {
    const float rstd = row_rstd(v);
#pragma unroll
    for (int j = 0; j < 4; ++j) { const int col = 4 * lane + 256 * j;
        v[j] = v[j] * rstd * g4[j] * (s4[j] + 1.0f) + h4[j];
        if constexpr (F8) { *(unsigned*)((unsigned char*)orow + col) = pk4_fp8(v[j].x, v[j].y, v[j].z, v[j].w); }
        else { u32x2 w; w.x = pk2(v[j].x, v[j].y); w.y = pk2(v[j].z, v[j].w); *(u32x2*)(orow + col) = w;
            if constexpr (BOTH) *(unsigned*)(orow8 + col) = pk4_fp8(v[j].x, v[j].y, v[j].z, v[j].w); } }
}
template <bool F8 = false, bool BOTH = false> __device__ __forceinline__ void modulate_row(f32x4 (&v)[4], const float* g, const float* sc, const float* sh, bf16* orow, int lane, unsigned char* orow8 = nullptr) {
    f32x4 g4[4], s4[4], h4[4];
#pragma unroll
    for (int j = 0; j < 4; ++j) { const int col = 4 * lane + 256 * j; g4[j] = *(const f32x4*)(g + col); s4[j] = *(const f32x4*)(sc + col); h4[j] = *(const f32x4*)(sh + col); }
    PIN4(g4[0], g4[1], g4[2], g4[3]); PIN8(s4[0], s4[1], s4[2], s4[3], h4[0], h4[1], h4[2], h4[3]);
    modulate_row_pre<F8, BOTH>(v, g4, s4, h4, orow, lane, orow8);
}
__device__ __forceinline__ const float* in_row(const float* x, const float* ctx, int r) { const int b = r / SROW, s = r - b * SROW; return s < CTXL ? ctx + ((size_t)b * CTXL + s) * D : x + ((size_t)b * SEQ + (s - CTXL)) * D; }
__device__ __forceinline__ void p1_norm1(Frame& F) {
    PHASE_IDS();
    const int gw = F.vcu * 8 + wave, NGW = F.G * 8;
    const float* modv = (const float*)(F.ws + WS_MODV); bf16* H = (bf16*)(F.ws + WS_H);
    f32x4 v[4], nv[4];
    if (gw < NROWS) { const float* xr = in_row(F.in[I_X], F.in[I_CTX], gw);
#pragma unroll
        for (int j = 0; j < 4; ++j) v[j] = *(const f32x4*)(xr + 4 * lane + 256 * j); }
    for (int r = gw; r < NROWS; r += NGW) {
        const int b = r / SROW, s = r - b * SROW; const float* mv = modv + (size_t)(s < CTXL ? 16 : b) * 6144;
        const int rn = r + NGW < NROWS ? r + NGW : r; const float* xn = in_row(F.in[I_X], F.in[I_CTX], rn);
#pragma unroll
        for (int j = 0; j < 4; ++j) nv[j] = *(const f32x4*)(xn + 4 * lane + 256 * j);
        modulate_row<false, true>(v, F.in[I_N1G], mv + 1024, mv, H + (size_t)r * 1024, lane, F.ws + WS_H8IN + (size_t)r * 1024);
#pragma unroll
        for (int j = 0; j < 4; ++j) v[j] = nv[j];
    }
}
constexpr int WR_STRIDE = 1028;
constexpr int L6_WR = 0, L6_LCNT = 32 * WR_STRIDE * 4, L6_LBASE = L6_LCNT + 128, L6_TAB = L6_LBASE + 128, L6_MAXROWS = 640;
static_assert(L6_TAB + L6_MAXROWS * 48 <= LCTL_OFF, "router LDS");
__device__ __forceinline__ float tred32(const float (&p)[32], int lane) {
    float q16[16], q8[8], q4[4], q2[2], q1;
    { const bool hi = (lane & 32) != 0;
#pragma unroll
      for (int e = 0; e < 16; ++e) { const float keep = hi ? p[e + 16] : p[e], send = hi ? p[e] : p[e + 16]; q16[e] = keep + __shfl_xor(send, 32); } }
    { const bool hi = (lane & 16) != 0;
#pragma unroll
      for (int e = 0; e < 8; ++e) { const float keep = hi ? q16[e + 8] : q16[e], send = hi ? q16[e] : q16[e + 8]; q8[e] = keep + __shfl_xor(send, 16); } }
    { const bool hi = (lane & 8) != 0;
#pragma unroll
      for (int e = 0; e < 4; ++e) { const float keep = hi ? q8[e + 4] : q8[e], send = hi ? q8[e] : q8[e + 4]; q4[e] = keep + __shfl_xor(send, 8); } }
    { const bool hi = (lane & 4) != 0;
#pragma unroll
      for (int e = 0; e < 2; ++e) { const float keep = hi ? q4[e + 2] : q4[e], send = hi ? q4[e] : q4[e + 2]; q2[e] = keep + __shfl_xor(send, 4); } }
    { const bool hi = (lane & 2) != 0; const float keep = hi ? q2[1] : q2[0], send = hi ? q2[0] : q2[1]; q1 = keep + __shfl_xor(send, 2); }
    return q1 + __shfl_xor(q1, 1);
}
__device__ __forceinline__ void route_row(float val, int el, int lane, volatile LAS int* LCNT, LAS int* TAB, int lr) {
    int te[4]; float tv[4];
#pragma unroll
    for (int k = 0; k < 4; ++k) { const float m = wave_max(val); const unsigned long long mask = __ballot(val == m); const int fl = mask ? (int)__builtin_ctzll(mask) : 0;
        te[k] = (fl >> 1) & 31; tv[k] = m; if (el == te[k]) val = -INFINITY; }
    const float e1 = __expf(tv[1] - tv[0]), e2 = __expf(tv[2] - tv[0]), e3 = __expf(tv[3] - tv[0]); const float inv = 1.0f / (1.0f + e1 + e2 + e3);
    if (lane < 4) { const int ek = lane == 0 ? te[0] : lane == 1 ? te[1] : lane == 2 ? te[2] : te[3]; const float wk = (lane == 0 ? 1.0f : lane == 1 ? e1 : lane == 2 ? e2 : e3) * inv;
        const int pos = atomicAdd((int*)(LCNT + ek), 1);
        LAS int* t = TAB + (lr * 4 + lane) * 3; t[0] = ek; t[1] = pos; t[2] = __float_as_int(wk); }
}
__device__ __forceinline__ void p6_router(Frame& F, int l, bool lat) {
    PHASE_IDS();
    LAS float* WR = (LAS float*)(F.lds + L6_WR);
    volatile LAS int* LCNT = (volatile LAS int*)(F.lds + L6_LCNT); volatile LAS int* LBASE = (volatile LAS int*)(F.lds + L6_LBASE);
    LAS int* TAB = (LAS int*)(F.lds + L6_TAB);
    const float* wr = F.in[I_WR] + (size_t)l * 1024 * 32;
    { f32x4 t[16];
#pragma unroll
      for (int i = 0; i < 16; ++i) t[i] = *(const f32x4*)(wr + 4 * (tid + 512 * i));
      PIN8(t[0], t[1], t[2], t[3], t[4], t[5], t[6], t[7]); PIN8(t[8], t[9], t[10], t[11], t[12], t[13], t[14], t[15]);
#pragma unroll
      for (int i = 0; i < 16; ++i) { const int q = tid + 512 * i, d = q >> 3, e0 = 4 * (q & 7); WR[e0 * WR_STRIDE + d] = t[i].x; WR[(e0 + 1) * WR_STRIDE + d] = t[i].y; WR[(e0 + 2) * WR_STRIDE + d] = t[i].z; WR[(e0 + 3) * WR_STRIDE + d] = t[i].w; } }
    if (tid < 32) LCNT[tid] = 0;
    __syncthreads();
    const int RPW = (NROWS + F.G - 1) / F.G; const int rbeg = F.c * RPW; int nloc = NROWS - rbeg; nloc = nloc < 0 ? 0 : (nloc > RPW ? RPW : nloc);
    const float* modv = (const float*)(F.ws + WS_MODV) + (size_t)l * 17 * 6144; const bf16* X = (const bf16*)(F.ws + WS_X); bf16* H = (bf16*)(F.ws + WS_H);
    const float* n2g = F.in[I_N2G] + l * 1024; const float* brt = F.in[I_BR] + l * 32;
    const int el = (lane >> 1) & 31; const float bre = brt[el];
    for (int lr = wave; lr < nloc; lr += 16) {
        const int lr2 = lr + 8; const bool has2 = lr2 < nloc;
        const int r = rbeg + lr, r2 = has2 ? rbeg + lr2 : r; const int b = r / SROW, s = r - b * SROW, b2 = r2 / SROW, s2 = r2 - b2 * SROW;
        const bool skip1 = lat && s < CTXL, skip2 = !has2 || (lat && s2 < CTXL);
        if (skip1 && lane < 4) TAB[(lr * 4 + lane) * 3] = -1;
        if (has2 && skip2 && lane < 4) TAB[(lr2 * 4 + lane) * 3] = -1;
        if (skip1 && skip2) continue;
        const float* mv = modv + (size_t)(s < CTXL ? 16 : b) * 6144; const float* mv2 = modv + (size_t)(s2 < CTXL ? 16 : b2) * 6144;
        f32x4 v[4], v2[4];
#pragma unroll
        for (int j = 0; j < 4; ++j) { const u32x2 t = *(const u32x2*)(X + (size_t)r * 1024 + 4 * lane + 256 * j), t2 = *(const u32x2*)(X + (size_t)r2 * 1024 + 4 * lane + 256 * j); v[j] = bf4(t); v2[j] = bf4(t2); }
        if (!skip1) modulate_row<true>(v, n2g, mv + 4 * 1024, mv + 3 * 1024, (bf16*)((unsigned char*)H + (size_t)r * 1024), lane);
        if (!skip2) modulate_row<true>(v2, n2g, mv2 + 4 * 1024, mv2 + 3 * 1024, (bf16*)((unsigned char*)H + (size_t)r2 * 1024), lane);
        float p[32], p2[32];
#pragma unroll
        for (int e = 0; e < 32; ++e) { float a = 0.f, a2 = 0.f;
#pragma unroll
            for (int j = 0; j < 4; ++j) { const f32x4 w4 = *(const LAS f32x4*)(WR + e * WR_STRIDE + 256 * j + 4 * lane);
                a += (v[j].x * w4.x + v[j].y * w4.y) + (v[j].z * w4.z + v[j].w * w4.w); a2 += (v2[j].x * w4.x + v2[j].y * w4.y) + (v2[j].z * w4.z + v2[j].w * w4.w); }
            p[e] = a; p2[e] = a2; }
        const float val = tred32(p, lane) + bre, val2 = tred32(p2, lane) + bre;
        if (!skip1) route_row(val, el, lane, LCNT, TAB, lr);
        if (!skip2) route_row(val2, el, lane, LCNT, TAB, lr2);
    }
    __syncthreads();
    unsigned* cnt = F.ctl + CW_CNT + l * 64;
    if (tid < 32) LBASE[tid] = (int)atomicAdd(cnt + tid, (unsigned)LCNT[tid]);
    __syncthreads();
    int* toke = (int*)(F.ws + WS_TOKE); int* tokp = (int*)(F.ws + WS_TOKP); int* rowmap = (int*)(F.ws + WS_ROWMAP); float* roww = (float*)(F.ws + WS_ROWW);
    for (int idx = tid; idx < nloc * 4; idx += 512) { const LAS int* t = TAB + idx * 3; const int e = t[0]; const size_t o = (size_t)rbeg * 4 + idx;
        toke[o] = e; if (e >= 0) { const int pos = LBASE[e] + t[1]; tokp[o] = pos; rowmap[(size_t)e * NROWS + pos] = rbeg + (idx >> 2); roww[(size_t)e * NROWS + pos] = __int_as_float(t[2]); } }
    __syncthreads();
}
__device__ __forceinline__ void moe_toff(Frame& F, int l, volatile LAS int* toff) {
    PHASE_IDS();
    if (wave == 0) { unsigned* cnt = F.ctl + CW_CNT + l * 64;
        const int c = lane < NEXP ? (int)__hip_atomic_load(cnt + lane, RLX_AGENT) : 0; const int t = (c + 255) >> 8; int incl = t;
#pragma unroll
        for (int d = 1; d < 32; d <<= 1) { const int o = __shfl_up(incl, d); if (lane >= d) incl += o; }
        if (lane < NEXP) { toff[lane] = incl - t; toff[33 + lane] = c; }
        if (lane == NEXP - 1) toff[NEXP] = incl; }
    __syncthreads();
}
__device__ __forceinline__ void p9_combine(Frame& F, int l, bool last, float* out) {
    PHASE_IDS();
    const int gw = F.vcu * 8 + wave, NGW = F.G * 8;
    volatile LAS int* toff = (volatile LAS int*)(F.lds + LCTL_OFF + 256);
    moe_toff(F, l, toff);
    const int* toke = (const int*)(F.ws + WS_TOKE); const int* tokp = (const int*)(F.ws + WS_TOKP); const unsigned char* Y = (const unsigned char*)(F.ws + WS_H2S);
    bf16* X = (bf16*)(F.ws + WS_X); bf16* H = (bf16*)(F.ws + WS_H);
    const float* modv = (const float*)(F.ws + WS_MODV) + (size_t)l * 17 * 6144;
    f32x4 fg[4];
#pragma unroll
    for (int j = 0; j < 4; ++j) fg[j] = *(const f32x4*)(F.in[I_FNG] + 4 * lane + 256 * j);
    int r = gw; while (r < NROWS && last && (r % SROW) < CTXL) r += NGW;
    i32x4v te = (i32x4v){0, 0, 0, 0}, tp = te;
    if (r < NROWS) { te = *(const i32x4v*)(toke + (size_t)r * 4); tp = *(const i32x4v*)(tokp + (size_t)r * 4); }
    while (r < NROWS) {
        int rn = r + NGW; while (rn < NROWS && last && (rn % SROW) < CTXL) rn += NGW;
        const int b = r / SROW, s = r - b * SROW;
        const int mb = s < CTXL ? 16 : b; const float* g2 = modv + (size_t)mb * 6144 + 5 * 1024;
        const float* mv = (const float*)(F.ws + WS_MODV) + ((size_t)(last ? l : l + 1) * 17 + mb) * 6144; const float* n1g = F.in[I_N1G] + (last ? l : l + 1) * 1024;
        int slot[4];
#pragma unroll
        for (int k = 0; k < 4; ++k) slot[k] = toff[te[k]] * 256 + tp[k];
        f32x4 v[4], gg[4], g4[4], s4[4], h4[4]; int yw[4][4]; u32x2 xb[4];
#pragma unroll
        for (int j = 0; j < 4; ++j) { const int col = 4 * lane + 256 * j; xb[j] = *(const u32x2*)(X + (size_t)r * 1024 + col); gg[j] = *(const f32x4*)(g2 + col);
            g4[j] = *(const f32x4*)(n1g + col); s4[j] = *(const f32x4*)(mv + 1024 + col); h4[j] = *(const f32x4*)(mv + col); }
#pragma unroll
        for (int k = 0; k < 4; ++k)
#pragma unroll
            for (int j = 0; j < 4; ++j) yw[k][j] = *(const int*)(Y + (size_t)slot[k] * 1024 + 4 * lane + 256 * j);
        i32x4v ten = te, tpn = tp;
        if (rn < NROWS) { ten = *(const i32x4v*)(toke + (size_t)rn * 4); tpn = *(const i32x4v*)(tokp + (size_t)rn * 4); }
        PIN8(xb[0], xb[1], xb[2], xb[3], gg[0], gg[1], gg[2], gg[3]); PIN8(g4[0], g4[1], g4[2], g4[3], s4[0], s4[1], s4[2], s4[3]); PIN4(h4[0], h4[1], h4[2], h4[3]);
        PIN8(yw[0][0], yw[0][1], yw[0][2], yw[0][3], yw[1][0], yw[1][1], yw[1][2], yw[1][3]); PIN8(yw[2][0], yw[2][1], yw[2][2], yw[2][3], yw[3][0], yw[3][1], yw[3][2], yw[3][3]);
        f32x4 ys[4];
#pragma unroll
        for (int j = 0; j < 4; ++j) ys[j] = (f32x4){0.f, 0.f, 0.f, 0.f};
#pragma unroll
        for (int k = 0; k < 4; ++k)
#pragma unroll
            for (int j = 0; j < 4; ++j) { const int w = yw[k][j]; const f32x2 lo = __builtin_amdgcn_cvt_pk_f32_fp8(w, false), hi = __builtin_amdgcn_cvt_pk_f32_fp8(w, true); ys[j].x += lo.x; ys[j].y += lo.y; ys[j].z += hi.x; ys[j].w += hi.y; }
#pragma unroll
        for (int j = 0; j < 4; ++j) v[j] = bf4(xb[j]) + gg[j] * (ys[j] * (1.0f / Y8_SCALE));
        if (!last) {
#pragma unroll
            for (int j = 0; j < 4; ++j) { u32x2 w; w.x = pk2(v[j].x, v[j].y); w.y = pk2(v[j].z, v[j].w); *(u32x2*)(X + (size_t)r * 1024 + 4 * lane + 256 * j) = w; }
            modulate_row_pre<false, true>(v, g4, s4, h4, H + (size_t)r * 1024, lane, F.ws + WS_H8IN + (size_t)r * 1024);
        } else {
            const float rstd = row_rstd(v); float* orow = out + ((size_t)b * SEQ + (s - CTXL)) * 1024;
#pragma unroll
            for (int j = 0; j < 4; ++j) { const int col = 4 * lane + 256 * j; *(f32x4*)(orow + col) = v[j] * rstd * fg[j]; }
        }
        te = ten; tp = tpn; r = rn;
    }
}
__device__ __forceinline__ void chunk_of(int pass, int step, bool& isctx, int& cidx) { isctx = step < 4; cidx = pass == 0 ? (isctx ? step : step - 4) : (isctx ? 3 - step : 35 - step); }

#define LDF(p_) (*(const LAS u32x4*)(p_))
#define BF8(x_) __builtin_bit_cast(bf16x8, (x_))
constexpr int RS_Q = 272, RS_T = 144;
constexpr int LR_QS = 0, LR_KS = LR_QS + 64 * RS_Q, LR_KT = LR_KS + 64 * RS_Q, LR_VT = LR_KT + 128 * RS_T, LR_ST = LR_VT + 128 * RS_T, LR_SC = LR_ST + 128 * RS_Q, LR_ROPE = LR_SC + 64 * RS_T, LR_YS = LR_ROPE + 96 * 32 * 8, LR_END = LR_YS + 64 * RS_Q;
static_assert(LR_END <= LCTL_OFF, "retention LDS");
__device__ __forceinline__ void ret_unit(Frame& F, int l, int b, int h, bool need_ctx) {
    LAS unsigned char* Qs = F.lds + LR_QS; LAS unsigned char* Ks = F.lds + LR_KS; LAS unsigned char* KT = F.lds + LR_KT; LAS unsigned char* VT = F.lds + LR_VT;
    LAS unsigned char* ST = F.lds + LR_ST; LAS unsigned char* Sc = F.lds + LR_SC; LAS unsigned char* Ys = F.lds + LR_YS;
    LAS f32x2* ROPE = (LAS f32x2*)(F.lds + LR_ROPE);
    const bf16* Pq = (const bf16*)(F.ws + WS_P) + 0 * PSTR + h * 128; const bf16* Pk = (const bf16*)(F.ws + WS_P) + 1 * PSTR + h * 128;
    const bf16* VTR = (const bf16*)(F.ws + WS_P) + 2 * PSTR + (size_t)(b * 1024 + h * 128) * SROW;
    const bf16* Pg = (const bf16*)(F.ws + WS_P) + 3 * PSTR + h * 128;
    bf16* AA = (bf16*)(F.ws + WS_AA) + h * 128;
    const float xf = F.in[I_RDF][l * 8 + h], xb = F.in[I_RDB][l * 8 + h];
    const float lf2 = -log1pf(expf(-xf)) * LOG2E, lb2 = -log1pf(expf(-xb)) * LOG2E;
    PHASE_IDS(); const int w = wave, fr = lane & 15, g = lane >> 4;
    const int rowb = b * SROW;
    __syncthreads();
    { const f32x2* rg_ = (const f32x2*)(F.ws + WS_ROPE); for (int i = tid; i < 96 * 32; i += 512) ROPE[i] = rg_[i]; }
    const int p = tid >> 3, sub = tid & 7, hf = sub >> 2, ig = sub & 3, d0 = 64 * hf + 8 * ig;
    const int sg = tid & 7;
    for (int pass = 0; pass < 2; ++pass) {
        const float lg2 = pass ? lb2 : lf2; const float gC = fexp2(64.0f * lg2);
        f32x4 Sacc[8];
#pragma unroll
        for (int nd = 0; nd < 8; ++nd) Sacc[nd] = (f32x4){0.f, 0.f, 0.f, 0.f};
        __syncthreads();
        for (int i = tid; i < 128 * RS_Q / 4; i += 512) ((LAS unsigned*)ST)[i] = 0u;
        u32x4 qa, qb, ka, kb, vv[2];
#define RET_LOAD(step_) do { bool ic_; int ci_; chunk_of(pass, (step_), ic_, ci_); const int s0_ = ic_ ? 64 * ci_ : CTXL + 64 * ci_; const size_t ro_ = (size_t)(rowb + s0_ + p) * 1024 + d0; \
            ka = *(const u32x4*)(Pk + ro_); kb = *(const u32x4*)(Pk + ro_ + 32); qa = *(const u32x4*)(Pq + ro_); qb = *(const u32x4*)(Pq + ro_ + 32); \
            _Pragma("unroll") for (int i2 = 0; i2 < 2; ++i2) { const int it_ = tid + 512 * i2; vv[i2] = *(const u32x4*)(VTR + (size_t)(it_ >> 3) * SROW + s0_ + 8 * (it_ & 7)); } } while (0)
        RET_LOAD(0);
        for (int step = 0; step < 36; ++step) {
            bool isctx; int cidx; chunk_of(pass, step, isctx, cidx);
            const int row0 = rowb + (isctx ? 64 * cidx : CTXL + 64 * cidx);
            const bool do_out = !isctx || need_ctx;
            const size_t go = (size_t)(row0 + p) * 1024 + 16 * sg;
            {
                float cs[8], sn[8];
                if (!isctx) { const LAS f32x2* tab = ROPE + (hf ? (32 + p) * 32 : cidx * 32) + 8 * ig;
#pragma unroll
                    for (int e = 0; e < 8; ++e) { const f32x2 t = tab[e]; cs[e] = t.x; sn[e] = t.y; } }
                else {
#pragma unroll
                    for (int e = 0; e < 8; ++e) { cs[e] = 1.f; sn[e] = 0.f; } }
                float q1[8], q2[8], k1[8], k2[8];
#pragma unroll
                for (int e = 0; e < 8; ++e) { const float a = bfel(qa, e), c = bfel(qb, e); q1[e] = a * cs[e] - c * sn[e]; q2[e] = a * sn[e] + c * cs[e];
                    const float ak = bfel(ka, e), ck = bfel(kb, e); k1[e] = (ak * cs[e] - ck * sn[e]) * 0.08838834764831845f; k2[e] = (ak * sn[e] + ck * cs[e]) * 0.08838834764831845f; }
                if (do_out) {
                    u32x4 w1, w2;
                    w1.x = pk2(q1[0], q1[1]); w1.y = pk2(q1[2], q1[3]); w1.z = pk2(q1[4], q1[5]); w1.w = pk2(q1[6], q1[7]);
                    w2.x = pk2(q2[0], q2[1]); w2.y = pk2(q2[2], q2[3]); w2.z = pk2(q2[4], q2[5]); w2.w = pk2(q2[6], q2[7]);
                    *(LAS u32x4*)(Qs + p * RS_Q + d0 * 2) = w1; *(LAS u32x4*)(Qs + p * RS_Q + (d0 + 32) * 2) = w2;
                }
                u32x4 x1, x2;
                x1.x = pk2(k1[0], k1[1]); x1.y = pk2(k1[2], k1[3]); x1.z = pk2(k1[4], k1[5]); x1.w = pk2(k1[6], k1[7]);
                x2.x = pk2(k2[0], k2[1]); x2.y = pk2(k2[2], k2[3]); x2.z = pk2(k2[4], k2[5]); x2.w = pk2(k2[6], k2[7]);
                if (pass == 0 && do_out) { *(LAS u32x4*)(Ks + p * RS_Q + d0 * 2) = x1; *(LAS u32x4*)(Ks + p * RS_Q + (d0 + 32) * 2) = x2; }
#pragma unroll
                for (int e = 0; e < 8; ++e) { const unsigned a = x1[e >> 1], c = x2[e >> 1];
                    *(LAS unsigned short*)(KT + (d0 + e) * RS_T + p * 2) = (unsigned short)((e & 1) ? (a >> 16) : (a & 0xffffu));
                    *(LAS unsigned short*)(KT + (d0 + 32 + e) * RS_T + p * 2) = (unsigned short)((e & 1) ? (c >> 16) : (c & 0xffffu)); }
#pragma unroll
                for (int i2 = 0; i2 < 2; ++i2) { const int it = tid + 512 * i2; *(LAS u32x4*)(VT + (it >> 3) * RS_T + (it & 7) * 16) = vv[i2]; }
            }
            if (step + 1 < 36) RET_LOAD(step + 1);
            u32x4 f0 = (u32x4){0u, 0u, 0u, 0u}, f1 = f0, g0 = f0, g1 = f0;
            if (pass == 1 && do_out) { f0 = *(const u32x4*)(AA + go); f1 = *(const u32x4*)(AA + go + 8); g0 = *(const u32x4*)(Pg + go); g1 = *(const u32x4*)(Pg + go + 8); }
            __syncthreads();
            if (pass == 0 && do_out) {
                const int mi = w >> 1;
                u32x4 qq[4];
#pragma unroll
                for (int ks = 0; ks < 4; ++ks) qq[ks] = LDF(Qs + (16 * mi + fr) * RS_Q + (32 * ks + 8 * g) * 2);
#pragma unroll
                for (int t = 0; t < 2; ++t) { const int nj = 2 * (w & 1) + t; f32x4 acc = (f32x4){0.f, 0.f, 0.f, 0.f}; u32x4 kk[4];
#pragma unroll
                    for (int ks = 0; ks < 4; ++ks) kk[ks] = LDF(Ks + (16 * nj + fr) * RS_Q + (32 * ks + 8 * g) * 2);
                    if (t == 0) PIN8(qq[0], qq[1], qq[2], qq[3], kk[0], kk[1], kk[2], kk[3]); else PIN4(kk[0], kk[1], kk[2], kk[3]);
#pragma unroll
                    for (int ks = 0; ks < 4; ++ks) acc = MFMA16(BF8(kk[ks]), BF8(qq[ks]), acc);
                    const int i = 16 * mi + fr; float dv_[4];
#pragma unroll
                    for (int r = 0; r < 4; ++r) { const int j = 16 * nj + 4 * g + r, dd = i - j; dv_[r] = acc[r] * fexp2(dd >= 0 ? (float)dd * lf2 : (float)(-dd) * lb2); }
                    u32x2 o; o.x = pk2(dv_[0], dv_[1]); o.y = pk2(dv_[2], dv_[3]); *(LAS u32x2*)(Sc + i * RS_T + (16 * nj + 4 * g) * 2) = o; }
            }
            if (pass == 0 && do_out) __syncthreads();
            if (do_out) {
                const int mi = w >> 1, nd0 = 4 * (w & 1);
                f32x4 a1[4], a2[4];
#pragma unroll
                for (int t = 0; t < 4; ++t) { a1[t] = (f32x4){0.f, 0.f, 0.f, 0.f}; a2[t] = (f32x4){0.f, 0.f, 0.f, 0.f}; }
                if (pass == 0) {
#pragma unroll
                    for (int ks = 0; ks < 2; ++ks) { u32x4 sc, vf[4]; sc = LDF(Sc + (16 * mi + fr) * RS_T + (32 * ks + 8 * g) * 2);
#pragma unroll
                        for (int t = 0; t < 4; ++t) vf[t] = LDF(VT + (16 * (nd0 + t) + fr) * RS_T + (32 * ks + 8 * g) * 2);
                        PIN4(vf[0], vf[1], vf[2], vf[3]);
#pragma unroll
                        for (int t = 0; t < 4; ++t) a1[t] = MFMA16(BF8(vf[t]), BF8(sc), a1[t]); }
                }
#pragma unroll
                for (int ks = 0; ks < 4; ++ks) { u32x4 qq, sf[4]; qq = LDF(Qs + (16 * mi + fr) * RS_Q + (32 * ks + 8 * g) * 2);
#pragma unroll
                    for (int t = 0; t < 4; ++t) sf[t] = LDF(ST + (16 * (nd0 + t) + fr) * RS_Q + (32 * ks + 8 * g) * 2);
                    PIN4(sf[0], sf[1], sf[2], sf[3]);
#pragma unroll
                    for (int t = 0; t < 4; ++t) a2[t] = MFMA16(BF8(sf[t]), BF8(qq), a2[t]); }
                const int il = 16 * mi + fr; const float xi = fexp2(pass == 0 ? (float)(il + 1) * lf2 : (float)(64 - il) * lb2);
#pragma unroll
                for (int t = 0; t < 4; ++t) { u32x2 o; o.x = pk2(a1[t][0] + xi * a2[t][0], a1[t][1] + xi * a2[t][1]); o.y = pk2(a1[t][2] + xi * a2[t][2], a1[t][3] + xi * a2[t][3]);
                    *(LAS u32x2*)(Ys + il * RS_Q + (16 * (nd0 + t) + 4 * g) * 2) = o; }
            }
            {
                bf16x8 af[2]; u32x4 kt[2];
#pragma unroll
                for (int ks = 0; ks < 2; ++ks) kt[ks] = LDF(KT + (16 * w + fr) * RS_T + (32 * ks + 8 * g) * 2);
#pragma unroll
                for (int nh = 0; nh < 4; ++nh) { u32x4 bb[2][2];
#pragma unroll
                    for (int n2 = 0; n2 < 2; ++n2)
#pragma unroll
                        for (int ks = 0; ks < 2; ++ks) bb[n2][ks] = LDF(VT + (16 * (2 * nh + n2) + fr) * RS_T + (32 * ks + 8 * g) * 2);
                    PIN4(bb[0][0], bb[0][1], bb[1][0], bb[1][1]);
                    if (nh == 0) {
#pragma unroll
                        for (int ks = 0; ks < 2; ++ks) { const u32x4 kk = kt[ks]; float z[8];
#pragma unroll
                            for (int e = 0; e < 8; ++e) { const int tok = 32 * ks + 8 * g + e; z[e] = bfel(kk, e) * fexp2(pass == 0 ? (float)(63 - tok) * lf2 : (float)tok * lb2); }
                            u32x4 o; o.x = pk2(z[0], z[1]); o.y = pk2(z[2], z[3]); o.z = pk2(z[4], z[5]); o.w = pk2(z[6], z[7]); af[ks] = __builtin_bit_cast(bf16x8, o); } }
#pragma unroll
                    for (int n2 = 0; n2 < 2; ++n2) { const int nd = 2 * nh + n2; Sacc[nd] = Sacc[nd] * gC;
#pragma unroll
                        for (int ks = 0; ks < 2; ++ks) Sacc[nd] = MFMA16(af[ks], BF8(bb[n2][ks]), Sacc[nd]); } }
            }
            __syncthreads();
#pragma unroll
            for (int nd = 0; nd < 8; ++nd) { u32x2 o; o.x = pk2(Sacc[nd][0], Sacc[nd][1]); o.y = pk2(Sacc[nd][2], Sacc[nd][3]); *(LAS u32x2*)(ST + (16 * nd + fr) * RS_Q + (16 * w + 4 * g) * 2) = o; }
            if (do_out) {
                const u32x4 y0 = *(const LAS u32x4*)(Ys + p * RS_Q + 32 * sg), y1 = *(const LAS u32x4*)(Ys + p * RS_Q + 32 * sg + 16);
                if (pass == 0) { *(u32x4*)(AA + go) = y0; *(u32x4*)(AA + go + 8) = y1; }
                else {
                    float tv[16]; float ss = 0.f;
#pragma unroll
                    for (int e = 0; e < 8; ++e) { tv[e] = bfel(y0, e) + bfel(f0, e); tv[8 + e] = bfel(y1, e) + bfel(f1, e); ss += tv[e] * tv[e] + tv[8 + e] * tv[8 + e]; }
                    ss += __shfl_xor(ss, 1); ss += __shfl_xor(ss, 2); ss += __shfl_xor(ss, 4);
                    const float rstd = rsqrtf(ss * (1.0f / 128.0f) + NORM_EPS);
#pragma unroll
                    for (int e = 0; e < 8; ++e) { const float ga = bfel(g0, e), gb = bfel(g1, e); tv[e] *= rstd * ga * sigmoidf_(ga); tv[8 + e] *= rstd * gb * sigmoidf_(gb); }
                    u32x4 o0, o1;
                    o0.x = pk2(tv[0], tv[1]); o0.y = pk2(tv[2], tv[3]); o0.z = pk2(tv[4], tv[5]); o0.w = pk2(tv[6], tv[7]);
                    o1.x = pk2(tv[8], tv[9]); o1.y = pk2(tv[10], tv[11]); o1.z = pk2(tv[12], tv[13]); o1.w = pk2(tv[14], tv[15]);
                    *(u32x4*)(AA + go) = o0; *(u32x4*)(AA + go + 8) = o1;
                }
            }
        }
#undef RET_LOAD
    }
}
constexpr int NA_SC = 528, NA_SL = 1168;
constexpr int LN_VC = 0, LN_VL = LN_VC + 64 * NA_SC, LN_RPB = LN_VL + 64 * NA_SL, LN_END = LN_RPB + 512 * 4;
static_assert(LN_END <= LCTL_OFF, "NA LDS");
__device__ __forceinline__ int clampi(int v, int lo, int hi) { return v < lo ? lo : (v > hi ? hi : v); }
__device__ __forceinline__ void na_block(float (&s)[8], float& m, float& lsum, f32x4 (&O)[4], const u32x2 (&v)[4][2]) {
    const float mb = xrow_max(fmaxf(fmaxf(fmaxf(s[0], s[1]), fmaxf(s[2], s[3])), fmaxf(fmaxf(s[4], s[5]), fmaxf(s[6], s[7]))));
    const float mn = fmaxf(m, mb); const float alpha = fexp2(m - mn); m = mn;
    float ps = 0.f;
#pragma unroll
    for (int e = 0; e < 8; ++e) { s[e] = fexp2(s[e] - mn); ps += s[e]; }
    lsum = lsum * alpha + ps;
#pragma unroll
    for (int dt = 0; dt < 4; ++dt) O[dt] = O[dt] * alpha;
    u32x4 pw; pw.x = pk2(s[0], s[1]); pw.y = pk2(s[2], s[3]); pw.z = pk2(s[4], s[5]); pw.w = pk2(s[6], s[7]);
    const bf16x8 pf = __builtin_bit_cast(bf16x8, pw);
#pragma unroll
    for (int dt = 0; dt < 4; ++dt) { u32x4 vw; vw.x = v[dt][0].x; vw.y = v[dt][0].y; vw.z = v[dt][1].x; vw.w = v[dt][1].y; O[dt] = MFMA16(__builtin_bit_cast(bf16x8, vw), pf, O[dt]); }
}
__device__ __forceinline__ void na_block_loc(const float (&sv)[4], const bool (&sel)[4], float& m, float& lsum, f32x4 (&O)[4], const u32x2 (&v)[4][2]) {
    const float mb = xrow_max(fmaxf(fmaxf(sv[0], sv[1]), fmaxf(sv[2], sv[3])));
    const float mn = fmaxf(m, mb); const float alpha = fexp2(m - mn); m = mn;
    float e[4]; float ps = 0.f;
#pragma unroll
    for (int r = 0; r < 4; ++r) { e[r] = fexp2(sv[r] - mn); ps += e[r]; }
    lsum = lsum * alpha + ps;
#pragma unroll
    for (int dt = 0; dt < 4; ++dt) O[dt] = O[dt] * alpha;
    u32x4 pw; pw.x = pk2(sel[0] ? e[0] : 0.f, sel[1] ? e[1] : 0.f); pw.y = pk2(sel[2] ? e[2] : 0.f, sel[3] ? e[3] : 0.f);
    pw.z = pk2(sel[0] ? 0.f : e[0], sel[1] ? 0.f : e[1]); pw.w = pk2(sel[2] ? 0.f : e[2], sel[3] ? 0.f : e[3]);
    const bf16x8 pf = __builtin_bit_cast(bf16x8, pw);
#pragma unroll
    for (int dt = 0; dt < 4; ++dt) { u32x4 vw; vw.x = v[dt][0].x; vw.y = v[dt][0].y; vw.z = v[dt][1].x; vw.w = v[dt][1].y; O[dt] = MFMA16(__builtin_bit_cast(bf16x8, vw), pf, O[dt]); }
}
constexpr int LN_KC = LN_RPB + 512 * 4, LN2_END = LN_KC + 256 * 144;
static_assert(LN2_END <= LCTL_OFF, "NA LDS");
__device__ __forceinline__ int na_hi(int rp) { return clampi(2 * rp - 3, 0, 24) + 7; }
__device__ __forceinline__ void na_unit(Frame& F, int l, int b, int h, int rp0, int nrp) {
    LAS unsigned char* VC = F.lds + LN_VC; LAS unsigned char* VL = F.lds + LN_VL; LAS float* RPB = (LAS float*)(F.lds + LN_RPB); LAS unsigned char* KC = F.lds + LN_KC;
    const bf16* Pq = (const bf16*)(F.ws + WS_P) + 4 * PSTR + h * 64; const bf16* Pk = (const bf16*)(F.ws + WS_P) + 5 * PSTR + h * 64;
    const bf16* VTG = (const bf16*)(F.ws + WS_P) + 6 * PSTR + (size_t)(b * 16 + h) * 64 * SROW;
    bf16* AB = (bf16*)(F.ws + WS_AA) + PSTR + h * 64;
    PHASE_IDS(); const int w = wave, fr = lane & 15, g = lane >> 4;
    const int rowb = b * SROW;
    __syncthreads();
    const int sdh = tid >> 3, sch = tid & 7;
    const int rlo0 = clampi(2 * rp0 - 4, 0, 24);
    { u32x4 tk[4], tv[4], tl[9]; float rb = 0.f;
#pragma unroll
      for (int i = 0; i < 4; ++i) { const int it = tid + 512 * i; tk[i] = *(const u32x4*)(Pk + (size_t)(rowb + (it >> 3)) * 1024 + 8 * (it & 7)); tv[i] = *(const u32x4*)(VTG + (size_t)(it >> 5) * SROW + 8 * (it & 31)); }
#pragma unroll
      for (int i = 0; i < 9; ++i) tl[i] = *(const u32x4*)(VTG + (size_t)sdh * SROW + CTXL + (rlo0 + i) * 64 + 8 * sch);
      if (tid < 465) rb = F.in[I_RPB][((size_t)l * 16 + h) * 465 + tid];
      PIN8(tk[0], tk[1], tk[2], tk[3], tv[0], tv[1], tv[2], tv[3]); PIN8(tl[0], tl[1], tl[2], tl[3], tl[4], tl[5], tl[6], tl[7]); PIN4(tl[8], rb, tk[0], tk[1]);
#pragma unroll
      for (int i = 0; i < 4; ++i) { const int it = tid + 512 * i; *(LAS u32x4*)(KC + (it >> 3) * 144 + (it & 7) * 16) = tk[i]; *(LAS u32x4*)(VC + (it >> 5) * NA_SC + (it & 31) * 16) = tv[i]; }
#pragma unroll
      for (int i = 0; i < 9; ++i) *(LAS u32x4*)(VL + sdh * NA_SL + ((rlo0 + i) % 9) * 128 + sch * 16) = tl[i];
      if (tid < 465) RPB[tid] = rb * LOG2E; }
    const float qs = 0.125f * LOG2E;
    bf16x8 qfn[2], kn[4];
#define NA_LOADK(dst, R_) do { _Pragma("unroll") for (int t = 0; t < 2; ++t) { const bf16* kp = Pk + (size_t)(rowb + CTXL + (R_) * 64 + cspan + 16 * t + fr) * 1024 + 8 * g; dst[2 * t] = *(const bf16x8*)kp; dst[2 * t + 1] = *(const bf16x8*)(kp + 32); } } while (0)
    { const int q0 = 16 * (w & 3), cspan = clampi(q0 - 8, 0, 32), qr = 2 * rp0 + (w >> 2);
      NA_LOADK(kn, clampi(qr - 4, 0, 24));
#pragma unroll
      for (int ks = 0; ks < 2; ++ks) qfn[ks] = *(const bf16x8*)(Pq + (size_t)(rowb + CTXL + qr * 64 + q0 + fr) * 1024 + 32 * ks + 8 * g); }
    for (int rp = rp0; rp < rp0 + nrp; ++rp) {
        u32x4 nr0 = (u32x4){0u, 0u, 0u, 0u}, nr1 = nr0; const int hcur = na_hi(rp), hnxt = rp < rp0 + nrp - 1 ? na_hi(rp + 1) : hcur;
        if (hnxt > hcur) nr0 = *(const u32x4*)(VTG + (size_t)sdh * SROW + CTXL + (hcur + 1) * 64 + 8 * sch);
        if (hnxt > hcur + 1) nr1 = *(const u32x4*)(VTG + (size_t)sdh * SROW + CTXL + (hcur + 2) * 64 + 8 * sch);
        __syncthreads();
        const int ra = 2 * rp;
        const int qr = ra + (w >> 2), q0 = 16 * (w & 3); const int qrow = rowb + CTXL + qr * 64 + q0 + fr;
        bf16x8 qf[2]; qf[0] = qfn[0]; qf[1] = qfn[1];
        float m = -INFINITY, lsum = 0.f; f32x4 O[4]; float m2 = -INFINITY, lsum2 = 0.f; f32x4 O2[4];
#pragma unroll
        for (int dt = 0; dt < 4; ++dt) { O[dt] = (f32x4){0.f, 0.f, 0.f, 0.f}; O2[dt] = (f32x4){0.f, 0.f, 0.f, 0.f}; }
        const int r0 = clampi(qr - 4, 0, 24), cspan = clampi(q0 - 8, 0, 32); const int cq = q0 + fr, wst = clampi(cq - 8, 0, 48);
        bool sel[4]; int cixs[4];
#pragma unroll
        for (int r = 0; r < 4; ++r) { const int c0 = cspan + 4 * g + r; sel[r] = c0 >= wst; cixs[r] = clampi((sel[r] ? c0 : c0 + 16) - cq + 15, 0, 30); }
#pragma unroll
        for (int kb = 0; kb < 8; ++kb) {
            const int R = r0 + kb;
            u32x4 kc[2][2]; u32x2 vc[4][2], vl[4][2]; float rb[4];
#pragma unroll
            for (int t = 0; t < 2; ++t) { const LAS unsigned char* kp = KC + (32 * kb + 16 * t + fr) * 144 + 16 * g; kc[t][0] = *(const LAS u32x4*)kp; kc[t][1] = *(const LAS u32x4*)(kp + 64); }
#pragma unroll
            for (int r = 0; r < 4; ++r) rb[r] = RPB[(R - qr + 7) * 31 + cixs[r]];
#pragma unroll
            for (int dt = 0; dt < 4; ++dt) { const LAS unsigned char* vp = VC + (16 * dt + fr) * NA_SC + (32 * kb + 4 * g) * 2; vc[dt][0] = *(const LAS u32x2*)vp; vc[dt][1] = *(const LAS u32x2*)(vp + 32); }
            __builtin_amdgcn_sched_barrier(0);
            float s[8];
#pragma unroll
            for (int t = 0; t < 2; ++t) { f32x4 a = (f32x4){0.f, 0.f, 0.f, 0.f};
                a = MFMA16(__builtin_bit_cast(bf16x8, kc[t][0]), qf[0], a); a = MFMA16(__builtin_bit_cast(bf16x8, kc[t][1]), qf[1], a);
#pragma unroll
                for (int r = 0; r < 4; ++r) s[4 * t + r] = a[r] * qs; }
            float sv[4];
            { f32x4 a0 = (f32x4){0.f, 0.f, 0.f, 0.f}, a1 = a0;
              a0 = MFMA16(kn[0], qf[0], a0); a0 = MFMA16(kn[1], qf[1], a0); a1 = MFMA16(kn[2], qf[0], a1); a1 = MFMA16(kn[3], qf[1], a1);
#pragma unroll
              for (int r = 0; r < 4; ++r) sv[r] = (sel[r] ? a0[r] : a1[r]) * qs + rb[r]; }
            if (kb < 7) NA_LOADK(kn, R + 1);
            else if (rp + 1 < rp0 + nrp) { const int qrn = ra + 2 + (w >> 2);
                NA_LOADK(kn, clampi(qrn - 4, 0, 24));
                int fr_p = fr, g_p = g; asm volatile("" : "+v"(fr_p), "+v"(g_p));
#pragma unroll
                for (int ks = 0; ks < 2; ++ks) qfn[ks] = *(const bf16x8*)(Pq + (size_t)(rowb + CTXL + qrn * 64 + q0 + fr_p) * 1024 + 32 * ks + 8 * g_p); }
#pragma unroll
            for (int dt = 0; dt < 4; ++dt) { const LAS unsigned char* vq = VL + (16 * dt + fr) * NA_SL + ((R % 9) * 64 + cspan + 4 * g) * 2; vl[dt][0] = *(const LAS u32x2*)vq; vl[dt][1] = *(const LAS u32x2*)(vq + 32); }
            __builtin_amdgcn_sched_barrier(0);
            na_block(s, m, lsum, O, vc);
            na_block_loc(sv, sel, m2, lsum2, O2, vl);
        }
        { const float mm = fmaxf(m, m2); const float c1 = fexp2(m - mm), c2 = fexp2(m2 - mm); lsum = lsum * c1 + lsum2 * c2;
#pragma unroll
          for (int dt = 0; dt < 4; ++dt) O[dt] = O[dt] * c1 + O2[dt] * c2; }
        lsum = xrow_sum(lsum);
        const float inv = 1.0f / lsum;
        int fr_o = fr; asm volatile("" : "+v"(fr_o)); const int qrow_o = rowb + CTXL + qr * 64 + q0 + fr_o;
#pragma unroll
        for (int dt = 0; dt < 4; ++dt) { u32x2 o; o.x = pk2(O[dt][0] * inv, O[dt][1] * inv); o.y = pk2(O[dt][2] * inv, O[dt][3] * inv); *(u32x2*)(AB + (size_t)qrow_o * 1024 + 16 * dt + 4 * g) = o; }
        __syncthreads();
        if (hnxt > hcur) *(LAS u32x4*)(VL + sdh * NA_SL + ((hcur + 1) % 9) * 128 + sch * 16) = nr0;
        if (hnxt > hcur + 1) *(LAS u32x4*)(VL + sdh * NA_SL + ((hcur + 2) % 9) * 128 + sch * 16) = nr1;
    }
#undef NA_LOADK
    __syncthreads();
}
constexpr int RS_UF = 528;
constexpr int LL_UB = 0, LL_UF = LL_UB + 64 * RS_Q, LL_HB = LL_UF + 64 * RS_UF, LL_CW = LL_HB + 64 * RS_UF, LL_END = LL_CW + 5 * 128 * 4;
static_assert(LL_END <= LCTL_OFF, "LRU LDS");
__device__ __forceinline__ float fsig(float x) { return __builtin_amdgcn_rcpf(1.0f + __builtin_amdgcn_exp2f(-x * LOG2E)); }
__device__ __forceinline__ float fgelu(float y) { const float z = 0.7978845608028654f * (y + 0.044715f * y * y * y); const float t = 1.0f - 2.0f * __builtin_amdgcn_rcpf(__builtin_amdgcn_exp2f(2.0f * LOG2E * z) + 1.0f); return 0.5f * y * (1.0f + t); }
template <int DIR> __device__ __forceinline__ void lru_scan(const float (&av)[4][4], const float (&bv)[4][4], float& hcar, LAS unsigned char* Hb, int co, int fr, int g) {
    float hl[4][4], cm[4][4], ce[4], he[4];
#pragma unroll
    for (int mt = 0; mt < 4; ++mt) { float h_ = 0.f, c_ = 1.f;
#pragma unroll
        for (int ri = 0; ri < 4; ++ri) { const int r = DIR == 0 ? ri : 3 - ri; h_ = av[mt][r] * h_ + bv[mt][r]; c_ *= av[mt][r]; hl[mt][r] = h_; cm[mt][r] = c_; }
        ce[mt] = c_; he[mt] = h_; }
    float P[4][4], H[4][4];
#pragma unroll
    for (int mt = 0; mt < 4; ++mt)
#pragma unroll
        for (int gg = 0; gg < 4; ++gg) { P[mt][gg] = __shfl(ce[mt], fr + 16 * gg); H[mt][gg] = __shfl(he[mt], fr + 16 * gg); }
    PIN8(P[0][0], P[0][1], P[0][2], P[0][3], H[0][0], H[0][1], H[0][2], H[0][3]); PIN8(P[1][0], P[1][1], P[1][2], P[1][3], H[1][0], H[1][1], H[1][2], H[1][3]);
    PIN8(P[2][0], P[2][1], P[2][2], P[2][3], H[2][0], H[2][1], H[2][2], H[2][3]); PIN8(P[3][0], P[3][1], P[3][2], P[3][3], H[3][0], H[3][1], H[3][2], H[3][3]);
    float x = hcar;
#pragma unroll
    for (int mi = 0; mi < 4; ++mi) { const int mt = DIR == 0 ? mi : 3 - mi; float xin = x;
#pragma unroll
        for (int gi = 0; gi < 4; ++gi) { const int gg = DIR == 0 ? gi : 3 - gi; if (g == gg) xin = x; x = P[mt][gg] * x + H[mt][gg]; }
#pragma unroll
        for (int r = 0; r < 4; ++r) *(LAS float*)(Hb + (16 * mt + 4 * g + r) * RS_UF + co * 4) = hl[mt][r] + cm[mt][r] * xin; }
    hcar = x;
}
__device__ __forceinline__ void lru_unit(Frame& F, int l, int b, int kblk, bool need_ctx) {
    LAS unsigned char* Ub = F.lds + LL_UB; LAS unsigned char* Uf = F.lds + LL_UF; LAS unsigned char* Hb = F.lds + LL_HB; LAS float* CW = (LAS float*)(F.lds + LL_CW);
    const int ch0 = 128 * kblk;
    const bf16* Plx = (const bf16*)(F.ws + WS_P) + 7 * PSTR + ch0; const bf16* Ply = (const bf16*)(F.ws + WS_P) + 8 * PSTR + ch0;
    bf16* AC = (bf16*)(F.ws + WS_AA) + 2 * PSTR + ch0;
    PHASE_IDS(); const int w = wave, fr = lane & 15, g = lane >> 4;
    const int rowb = b * SROW;
    __syncthreads();
    for (int i = tid; i < 5 * 128; i += 512) { const int j = i >> 7, c = i & 127; CW[i] = j < 4 ? F.in[I_CONVW][((size_t)l * 4 + j) * 1024 + ch0 + c] : F.in[I_CONVB][(size_t)l * 1024 + ch0 + c]; }
    __syncthreads();
    const int co = 16 * w + fr;
    const int p = tid >> 3, c0 = 16 * (tid & 7);
    for (int pass = 0; pass < 2; ++pass) {
        bf16x8 Bfa[4], Bfx[4];
        { const float* wa = F.in[I_GAW] + ((((size_t)l * 2 + pass) * 8 + kblk) * 128) * 128 + co; const float* wx = F.in[I_GXW] + ((((size_t)l * 2 + pass) * 8 + kblk) * 128) * 128 + co;
#pragma unroll
          for (int ks = 0; ks < 4; ++ks) { float ta[8], tx[8];
#pragma unroll
              for (int e = 0; e < 8; ++e) { const int ci = 32 * ks + 8 * g + e; ta[e] = wa[(size_t)ci * 128]; tx[e] = wx[(size_t)ci * 128]; }
              u32x4 oa, ox; oa.x = pk2(ta[0], ta[1]); oa.y = pk2(ta[2], ta[3]); oa.z = pk2(ta[4], ta[5]); oa.w = pk2(ta[6], ta[7]);
              ox.x = pk2(tx[0], tx[1]); ox.y = pk2(tx[2], tx[3]); ox.z = pk2(tx[4], tx[5]); ox.w = pk2(tx[6], tx[7]);
              Bfa[ks] = __builtin_bit_cast(bf16x8, oa); Bfx[ks] = __builtin_bit_cast(bf16x8, ox); } }
        const size_t vo = ((size_t)l * 2 + pass) * 1024 + ch0 + co;
        const float ba = F.in[I_GAB][vo], bx = F.in[I_GXB][vo]; const float nsp8 = -8.0f * LOG2E * log1pf(expf(-F.in[I_LAM][vo]));
        float hcar = 0.f;
        u32x4 xr[4][2];
#define LRU_LOAD_X(step_) do { bool ic_; int ci_; chunk_of(pass, (step_), ic_, ci_); const int sb_ = rowb + (ic_ ? 0 : CTXL), sl_ = ic_ ? CTXL : SEQ, tb_ = 64 * ci_; \
            _Pragma("unroll") for (int j = 0; j < 4; ++j) { const int tt = tb_ + p + j - 1; if (tt >= 0 && tt < sl_) { const bf16* xp = Plx + (size_t)(sb_ + tt) * 1024 + c0; xr[j][0] = *(const u32x4*)xp; xr[j][1] = *(const u32x4*)(xp + 8); } \
                else { xr[j][0] = (u32x4){0u, 0u, 0u, 0u}; xr[j][1] = (u32x4){0u, 0u, 0u, 0u}; } } } while (0)
        LRU_LOAD_X(0);
        for (int step = 0; step < 36; ++step) {
            bool isctx; int cidx; chunk_of(pass, step, isctx, cidx);
            const int segb = rowb + (isctx ? 0 : CTXL), t0 = 64 * cidx;
            const bool do_out = !isctx || need_ctx;
            const size_t go = (size_t)(segb + t0 + p) * 1024 + c0;
            { float u[16];
#pragma unroll
              for (int e = 0; e < 16; ++e) u[e] = CW[4 * 128 + c0 + e];
#pragma unroll
              for (int j = 0; j < 4; ++j) {
#pragma unroll
                  for (int e = 0; e < 8; ++e) { u[e] += CW[j * 128 + c0 + e] * bfel(xr[j][0], e); u[8 + e] += CW[j * 128 + c0 + 8 + e] * bfel(xr[j][1], e); } }
              u32x4 o0, o1; o0.x = pk2(u[0], u[1]); o0.y = pk2(u[2], u[3]); o0.z = pk2(u[4], u[5]); o0.w = pk2(u[6], u[7]);
              o1.x = pk2(u[8], u[9]); o1.y = pk2(u[10], u[11]); o1.z = pk2(u[12], u[13]); o1.w = pk2(u[14], u[15]);
              *(LAS u32x4*)(Ub + p * RS_Q + c0 * 2) = o0; *(LAS u32x4*)(Ub + p * RS_Q + c0 * 2 + 16) = o1;
#pragma unroll
              for (int q = 0; q < 4; ++q) *(LAS f32x4*)(Uf + p * RS_UF + (c0 + 4 * q) * 4) = (f32x4){u[4 * q], u[4 * q + 1], u[4 * q + 2], u[4 * q + 3]}; }
            if (step + 1 < 36) LRU_LOAD_X(step + 1);
            u32x4 pf0 = (u32x4){0u, 0u, 0u, 0u}, pf1 = pf0, py0 = pf0, py1 = pf0;
            if (pass == 1 && do_out) { pf0 = *(const u32x4*)(AC + go); pf1 = *(const u32x4*)(AC + go + 8); py0 = *(const u32x4*)(Ply + go); py1 = *(const u32x4*)(Ply + go + 8); }
            __syncthreads();
            float av[4][4], bv[4][4];
#pragma unroll
            for (int mh = 0; mh < 2; ++mh) {
                u32x4 af[2][4]; float uu[2][4];
#pragma unroll
                for (int mm = 0; mm < 2; ++mm) {
#pragma unroll
                    for (int ks = 0; ks < 4; ++ks) af[mm][ks] = *(const LAS u32x4*)(Ub + (16 * (2 * mh + mm) + fr) * RS_Q + (32 * ks + 8 * g) * 2);
#pragma unroll
                    for (int r = 0; r < 4; ++r) uu[mm][r] = *(const LAS float*)(Uf + (16 * (2 * mh + mm) + 4 * g + r) * RS_UF + co * 4); }
                PIN8(af[0][0], af[0][1], af[0][2], af[0][3], af[1][0], af[1][1], af[1][2], af[1][3]); PIN8(uu[0][0], uu[0][1], uu[0][2], uu[0][3], uu[1][0], uu[1][1], uu[1][2], uu[1][3]);
#pragma unroll
                for (int mm = 0; mm < 2; ++mm) { const int mt = 2 * mh + mm; f32x4 ga = (f32x4){0.f, 0.f, 0.f, 0.f}, gx = ga;
#pragma unroll
                    for (int ks = 0; ks < 4; ++ks) { const bf16x8 a = __builtin_bit_cast(bf16x8, af[mm][ks]); ga = MFMA16(a, Bfa[ks], ga); gx = MFMA16(a, Bfx[ks], gx); }
#pragma unroll
                    for (int r = 0; r < 4; ++r) { const float rr = fsig(ga[r] + ba), ii = fsig(gx[r] + bx);
                        const float a_ = __builtin_amdgcn_exp2f(nsp8 * rr);
                        av[mt][r] = a_; bv[mt][r] = __builtin_amdgcn_sqrtf(fmaxf(1.0f - a_ * a_, 0.f)) * ii * uu[mm][r]; } } }
            if (pass == 0) lru_scan<0>(av, bv, hcar, Hb, co, fr, g); else lru_scan<1>(av, bv, hcar, Hb, co, fr, g);
            __syncthreads();
            if (do_out) { float hv[16];
#pragma unroll
                for (int q = 0; q < 4; ++q) { const f32x4 t = *(const LAS f32x4*)(Hb + p * RS_UF + (c0 + 4 * q) * 4); hv[4 * q] = t.x; hv[4 * q + 1] = t.y; hv[4 * q + 2] = t.z; hv[4 * q + 3] = t.w; }
                if (pass == 1) {
#pragma unroll
                    for (int e = 0; e < 8; ++e) { hv[e] = (hv[e] + bfel(pf0, e)) * fgelu(bfel(py0, e)); hv[8 + e] = (hv[8 + e] + bfel(pf1, e)) * fgelu(bfel(py1, e)); } }
                u32x4 o0, o1; o0.x = pk2(hv[0], hv[1]); o0.y = pk2(hv[2], hv[3]); o0.z = pk2(hv[4], hv[5]); o0.w = pk2(hv[6], hv[7]);
                o1.x = pk2(hv[8], hv[9]); o1.y = pk2(hv[10], hv[11]); o1.z = pk2(hv[12], hv[13]); o1.w = pk2(hv[14], hv[15]);
                *(u32x4*)(AC + go) = o0; *(u32x4*)(AC + go + 8) = o1; }
        }
#undef LRU_LOAD_X
        __syncthreads();
    }
}

__device__ __forceinline__ int queue_pop(Frame& F, unsigned* q) {
    __syncthreads();
    if (threadIdx.x == 0) F.MISC[0] = atomicAdd(q, 1u);
    __syncthreads();
    return (int)F.MISC[0];
}
#ifndef PHMASK
#define PHMASK 0xffff
#endif
#define PHM(b) ((PHMASK >> (b)) & 1)
__device__ __forceinline__ void p3_convert_chunks(Frame& F, unsigned* qc) {
    for (;;) { const int q = queue_pop(F, qc); if (q >= P0_NCHUNK) break; PHASE_IDS(); p0_convert(F, P0_I2 + q * P0_CHUNK + wave, 8, P0_I2 + (q + 1) * P0_CHUNK, wave, lane); }
}
__device__ __forceinline__ void p3_mixers(Frame& F, int l, bool need_ctx, int rep, int qmask) {
    unsigned* q = F.ctl + CW_Q + (l * 3 + rep * 6) * 64;
    const bool conv = (l == 0 && rep == 0); unsigned* qc = F.ctl + CW_Q + 13 * 64;
    if (PHM(3) && (qmask & 1)) for (;;) { const int u = queue_pop(F, q); if (u >= NB * 8) break; ret_unit(F, l, u >> 3, u & 7, need_ctx); }
    if (PHM(4) && (qmask & 2)) for (;;) { const int u = queue_pop(F, q + 64); if (u >= NB * 8) break; lru_unit(F, l, u >> 3, u & 7, need_ctx); }
    bool cleft = conv;
    if (PHM(5) && (qmask & 4)) for (;;) { const int u = queue_pop(F, q + 128); if (u >= 640) break;
        const int v = u - 384; const int pr = u < 384 ? (u >> 1) : 192 + (v >> 2); const int r0_ = u < 384 ? 8 * (u & 1) : 4 * (v & 3);
        na_unit(F, l, pr >> 4, pr & 15, r0_, u < 384 ? 8 : 4);
        if (cleft && u >= 128) { const int qq = queue_pop(F, qc); if (qq < P0_NCHUNK) { PHASE_IDS(); p0_convert(F, P0_I2 + qq * P0_CHUNK + wave, 8, P0_I2 + (qq + 1) * P0_CHUNK, wave, lane); } else cleft = false; } }
    if (cleft) p3_convert_chunks(F, qc);
}
__global__ void __launch_bounds__(512, 2) fwd_kernel(Args args) {
    extern __shared__ __attribute__((aligned(16))) unsigned char lds[];
    Frame F;
    F.lds = (LAS unsigned char*)lds; F.MISC = (volatile LAS unsigned*)(F.lds + LCTL_OFF);
    F.G = gridDim.x; F.c = blockIdx.x; F.vcu = (F.G % 8 == 0) ? (F.c % 8) * (F.G / 8) + F.c / 8 : F.c;
    F.ws = args.ws; F.ctl = (unsigned*)(args.ws + WS_CTL); F.in = args.in;
    for (int u = threadIdx.x; u < (LDS_BYTES - LCTL_OFF) / 4; u += 512) ((LAS unsigned*)(F.lds + LCTL_OFF))[u] = 0u;
    __syncthreads();
    XcdBarrier bar; bar.bar = F.ctl + CW_BAR; bar.x = 0; bar.st = nullptr;
    if (!MK_PER_PHASE) bar = xcd_barrier_post(F.ctl + CW_BAR, F.MISC + 8);
    const int lo = args.ph_lo, hi = args.ph_hi;
#ifndef PHMASK
#define PHMASK 0xffff
#endif
#define PHM(b) ((PHMASK >> (b)) & 1)
#define IN(k) (lo <= (k) && (k) < hi)
#define SEAM(k) do { if (IN(k) && IN((k) + 1)) xcd_barrier(bar); } while (0)
    volatile LAS int* toff = (volatile LAS int*)(F.lds + LCTL_OFF + 256);

    if (PHM(0) && IN(0)) { p0_prologue(F, 1 + ((REP_MASK >> 2) & 1)); } SEAM(0);
    if (PHM(1) && IN(1)) { p1_norm1(F); } SEAM(1);
    for (int l = 0; l < DEPTH; ++l) {
        const int pb = 2 + 9 * l; const bool last = (l == DEPTH - 1);
        if (PHM(2) && IN(pb + 0)) {
            SchedDense S; S.init(F.ws + WS_H, F.ws + WS_WMIX + (size_t)l * 12288 * 1024 * 2, 1024, 36, false, F.G, F.c, true);
            SchedV8 S8; S8.init(F.ws + WS_H8IN, F.ws + WS_WMIX + (size_t)l * 12288 * 1024 * 2, F.G, F.c);
            EpiProj E{(bf16*)(F.ws + WS_P)};
            for (int rep = 0; rep < 1 + (REP_MASK & 1); ++rep) { pg8::gemm_phase<EpiProj, SchedDense, true>(F.lds, 1024, S, E); pg8::gemm_phase<EpiProj, SchedV8, true>(F.lds, 512, S8, E); }
        } SEAM(pb + 0);
        if (IN(pb + 1)) { constexpr int nrep = 1 + (((REP_MASK >> 3) & 7) ? 1 : 0); for (int rep = 0; rep < nrep; ++rep) { p3_mixers(F, l, !last, rep, rep == 0 ? 7 : ((REP_MASK >> 3) & 7)); if (rep + 1 < nrep) xcd_barrier(bar); } } SEAM(pb + 1);
        if (PHM(6) && IN(pb + 2)) {
            SchedBranch S; S.init(F.ws + WS_AA, F.ws + WS_WBR + (size_t)l * 3 * 1024 * 1024 * 2, last, F.G, F.c);
            EpiBranch E{(const bf16*)(F.ws + WS_P) + 9 * PSTR, (bf16*)(F.ws + WS_MB)};
            for (int rep = 0; rep < 1 + (REP_MASK & 1); ++rep) pg8::gemm_phase<EpiBranch, SchedBranch, true>(F.lds, 1024, S, E);
        } SEAM(pb + 2);
        if (PHM(7) && IN(pb + 3)) {
            SchedDense S; S.init(F.ws + WS_MB, F.ws + WS_WOUT + (size_t)l * 1024 * 1024 * 2, 1024, 4, last, F.G, F.c);
            if (l == 0) { EpiOut<true> E{F.in[I_X], F.in[I_CTX], (bf16*)(F.ws + WS_X), (const float*)(F.ws + WS_MODV)}; pg8::gemm_phase<EpiOut<true>, SchedDense, true>(F.lds, 1024, S, E); }
            else { EpiOut<false> E{F.in[I_X], F.in[I_CTX], (bf16*)(F.ws + WS_X), (const float*)(F.ws + WS_MODV) + (size_t)l * 17 * 6144}; pg8::gemm_phase<EpiOut<false>, SchedDense, true>(F.lds, 1024, S, E); }
        } SEAM(pb + 3);
        if (PHM(8) && IN(pb + 4)) { p6_router(F, l, last); } SEAM(pb + 4);
        if (PHM(10) && IN(pb + 6)) {
            moe_toff(F, l, toff);
            SchedMoE<true> S; S.init(F.ws + WS_H, F.ws + WS_WUP + (size_t)l * 32 * 2048 * 1024, (size_t)2048 * 1024, toff, 8, F.G, F.c, (const int*)(F.ws + WS_ROWMAP));
            EpiUp E{(unsigned char*)(F.ws + WS_ACT), F.in[I_BUP] + (size_t)l * 32 * 2048};
            for (int rep = 0; rep < 1 + (REP_MASK & 1); ++rep) pg8::gemm_phase<EpiUp, SchedMoE<true>, true>(F.lds, 512, S, E);
        } SEAM(pb + 6);
        if (PHM(11) && IN(pb + 7)) {
            moe_toff(F, l, toff);
            SchedMoE<false> S; S.init(F.ws + WS_ACT, F.ws + WS_WDN + (size_t)l * 32 * 1024 * 1024, (size_t)1024 * 1024, toff, 4, F.G, F.c, nullptr);
            EpiDown E{(unsigned char*)(F.ws + WS_H2S), F.in[I_BDN] + (size_t)l * 32 * 1024, (const float*)(F.ws + WS_ROWW)};
            for (int rep = 0; rep < 1 + (REP_MASK & 1); ++rep) pg8::gemm_phase<EpiDown, SchedMoE<false>, true>(F.lds, 512, S, E);
        } SEAM(pb + 7);
        if (PHM(12) && IN(pb + 8)) { p9_combine(F, l, last, args.out); } SEAM(pb + 8);
    }
#undef IN
#undef SEAM
}

extern "C" void kernel_launch(void* const* d_in, const int* in_sizes, int n_in, void* d_out, int out_size, void* d_ws, size_t ws_size, hipStream_t stream) {
    static int grid = 0;
    if (grid == 0) {
        if (n_in != 28 || ws_size < WS_END) { fprintf(stderr, "kernel_launch: expected 28 inputs and >= %zu bytes of workspace; got %d, %zu\n", (size_t)WS_END, n_in, ws_size); grid = -1; return; }
        int dev = 0, cus = 0, per_cu = 0;
        if (hipGetDevice(&dev) != hipSuccess || hipDeviceGetAttribute(&cus, hipDeviceAttributeMultiprocessorCount, dev) != hipSuccess) { grid = -1; return; }
        if (hipFuncSetAttribute((const void*)fwd_kernel, hipFuncAttributeMaxDynamicSharedMemorySize, LDS_BYTES) != hipSuccess) { fprintf(stderr, "kernel_launch: hipFuncSetAttribute failed\n"); grid = -1; return; }
        if (hipOccupancyMaxActiveBlocksPerMultiprocessor(&per_cu, (const void*)fwd_kernel, 512, LDS_BYTES) != hipSuccess || per_cu < 1) fprintf(stderr, "kernel_launch: occupancy query reports %d\n", per_cu);
        (void)hipGetLastError();
        grid = cus > 256 ? 256 : cus;
    }
    if (grid < 0) return;
    if (hipMemsetAsync((char*)d_ws + WS_CTL, 0, CTL_ZERO_BYTES, stream) != hipSuccess) return;
    Args a{};
    for (int i = 0; i < 28; ++i) a.in[i] = (const float*)d_in[i];
    a.out = (float*)d_out; a.ws = (unsigned char*)d_ws;
#if MK_PER_PHASE
    for (int p = 0; p < N_PHASES; ++p) { a.ph_lo = p; a.ph_hi = p + 1; hipLaunchKernelGGL(fwd_kernel, dim3(grid), dim3(512), LDS_BYTES, stream, a); }
#else
    a.ph_lo = 0; a.ph_hi = N_PHASES;
    hipLaunchKernelGGL(fwd_kernel, dim3(grid), dim3(512), LDS_BYTES, stream, a);
#endif
    const hipError_t le = hipPeekAtLastError();
    if (le != hipSuccess) fprintf(stderr, "kernel_launch: launch failed: %s\n", hipGetErrorName(le));
}
```
